# Optimizing an MI355X kernel written in HIP

```python
import math
import jax, jax.numpy as jnp
from jax import lax
import numpy as np

D_MODEL = 1024
BATCH = 8
SEQ = 2048
DEPTH = 1

GRID_W = 64
HEAD_DIM = 64
N_HEADS_DN = D_MODEL // (2 * HEAD_DIM)
N_HEADS_NA = D_MODEL // (2 * HEAD_DIM)
DN_WIDTH = N_HEADS_DN * HEAD_DIM
NA_WIDTH = N_HEADS_NA * HEAD_DIM
MIX_WIDTH = DN_WIDTH + NA_WIDTH
DN_CONV = 5
DN_CHUNK = 64
NA_WIN_H = 8
NA_WIN_W = 16
N_GROUPS = 4
EXPERTS_PER_GROUP = 8
N_EXPERTS = N_GROUPS * EXPERTS_PER_GROUP
TOP_K_EXPERT = 2
D_EXPERT = 512
EPS = 1e-6
IN_SPLITS = (DN_WIDTH, DN_WIDTH, DN_WIDTH, DN_WIDTH, N_HEADS_DN, N_HEADS_DN, N_HEADS_DN, N_HEADS_DN, NA_WIDTH, NA_WIDTH, NA_WIDTH)
IN_WIDTH = 4 * DN_WIDTH + 4 * N_HEADS_DN + 3 * NA_WIDTH

kernel_name = "hybrid_deltanet_natten_hmoe_block"


def rmsnorm(x, w):
    x32 = x.astype(jnp.float32)
    y = x32 * lax.rsqrt(jnp.mean(x32 * x32, axis=-1, keepdims=True) + EPS)
    return (y * w.astype(jnp.float32)).astype(x.dtype)


def l2norm(x):
    x32 = x.astype(jnp.float32)
    return x32 * lax.rsqrt(jnp.sum(x32 * x32, axis=-1, keepdims=True) + EPS)


def centred_depthwise_conv(x, w):
    k_w, ch = w.shape
    pad = (k_w - 1) // 2
    return lax.conv_general_dilated(x, w[:, None, :].astype(x.dtype), window_strides=(1,), padding=[(pad, pad)],
                                    dimension_numbers=("NWC", "WIO", "NWC"), feature_group_count=ch)


def gated_delta_rule_chunked(q, k, v, g, beta):
    B, H, S, dk = q.shape
    dv = v.shape[-1]
    n = S // DN_CHUNK

    def chunks(t):
        return t.reshape(B, H, n, DN_CHUNK, *t.shape[3:])

    q = chunks(q * dk ** -0.5)
    k, v, g, beta = chunks(k), chunks(v), chunks(g), chunks(beta)
    g_cum = jnp.cumsum(g, axis=-1)
    incl = jnp.tril(jnp.ones((DN_CHUNK, DN_CHUNK), dtype=bool))
    strict = jnp.tril(jnp.ones((DN_CHUNK, DN_CHUNK), dtype=bool), k=-1)
    diff = g_cum[..., :, None] - g_cum[..., None, :]
    decay = jnp.where(incl, jnp.exp(jnp.where(incl, diff, 0.0)), 0.0)
    k_beta = k * beta[..., None]
    m = jnp.where(strict, jnp.einsum("bhnid,bhnjd->bhnij", k_beta, k) * decay, 0.0)
    eye = jnp.eye(DN_CHUNK, dtype=q.dtype)
    t_inv = lax.linalg.triangular_solve(m + eye, jnp.broadcast_to(eye, m.shape), left_side=True,
                                        lower=True, unit_diagonal=True)
    u = jnp.einsum("bhnij,bhnje->bhnie", t_inv, v * beta[..., None])
    w = jnp.einsum("bhnij,bhnjd->bhnid", t_inv, k_beta * jnp.exp(g_cum)[..., None])
    attn = jnp.where(incl, jnp.einsum("bhnid,bhnjd->bhnij", q, k) * decay, 0.0)
    q_dec = q * jnp.exp(g_cum)[..., None]
    g_last = g_cum[..., -1]
    k_tail = k * jnp.exp(g_last[..., None] - g_cum)[..., None]

    def step(state, xs):
        q_c, k_c, u_c, w_c, a_c, gl_c = xs
        v_new = u_c - jnp.einsum("bhcd,bhde->bhce", w_c, state)
        o_c = jnp.einsum("bhcd,bhde->bhce", q_c, state) + jnp.einsum("bhij,bhje->bhie", a_c, v_new)
        state = state * jnp.exp(gl_c)[..., None, None] + jnp.einsum("bhcd,bhce->bhde", k_c, v_new)
        return state, o_c

    xs = (jnp.moveaxis(q_dec, 2, 0), jnp.moveaxis(k_tail, 2, 0), jnp.moveaxis(u, 2, 0),
          jnp.moveaxis(w, 2, 0), jnp.moveaxis(attn, 2, 0), jnp.moveaxis(g_last, 2, 0))
    state0 = jnp.zeros((B, H, dk, dv), q.dtype)
    _, o = lax.scan(step, state0, xs)
    return jnp.moveaxis(o, 0, 2).reshape(B, H, S, dv)


def neighbourhood_attention(q, k, v, rpb):
    B, S, H, d = q.shape
    rows = S // GRID_W
    win_h = min(NA_WIN_H, rows)
    r = np.arange(rows)
    r0 = np.clip(r - win_h // 2, 0, rows - win_h)
    key_rows = r0[:, None] + np.arange(win_h)[None, :]
    cc = np.arange(GRID_W)
    c0 = np.clip(cc - NA_WIN_W // 2, 0, GRID_W - NA_WIN_W)
    key_cols = c0[:, None] + np.arange(NA_WIN_W)[None, :]
    row_off = key_rows - r[:, None] + NA_WIN_H - 1
    col_off = key_cols - cc[:, None] + NA_WIN_W - 1
    bias = rpb[:, row_off[:, :, None, None], col_off[None, None, :, :]]
    bias = bias.transpose(1, 0, 3, 2, 4)
    qg = (q * d ** -0.5).reshape(B, rows, GRID_W, H, d).transpose(1, 0, 2, 3, 4)
    kg = k.reshape(B, rows, GRID_W, H, d)
    vg = v.reshape(B, rows, GRID_W, H, d)

    def row_attend(xs):
        q_r, rows_i, bias_r = xs
        k_nb = kg[:, rows_i][:, :, key_cols]
        v_nb = vg[:, rows_i][:, :, key_cols]
        s = jnp.einsum("bqhd,brqwhd->bhqrw", q_r, k_nb).astype(jnp.float32) + bias_r[None].astype(jnp.float32)
        p = jax.nn.softmax(s.reshape(B, H, GRID_W, -1), axis=-1).reshape(s.shape)
        return jnp.einsum("bhqrw,brqwhd->bqhd", p.astype(v.dtype), v_nb)

    o = lax.map(row_attend, (qg, jnp.asarray(key_rows), bias))
    return o.transpose(1, 0, 2, 3, 4).reshape(B, S, H * d)


def token_mixer(h, w_in, w_conv_dn, a_log_dn, dt_bias_dn, g_onorm_dn, rpb_na, w_out):
    B, S, _ = h.shape
    proj = h @ w_in
    qkv_dn = jax.nn.silu(centred_depthwise_conv(proj[..., :3 * DN_WIDTH], w_conv_dn))
    q_dn, k_dn, v_dn = jnp.split(qkv_dn, 3, axis=-1)
    _, _, _, z_dn, a_f, a_b, b_f, b_b, q_na, k_na, v_na = jnp.split(proj, np.cumsum(IN_SPLITS)[:-1].tolist(), axis=-1)

    def heads(t):
        return t.reshape(B, S, -1, HEAD_DIM).transpose(0, 2, 1, 3)

    qa, ka = l2norm(heads(q_dn)), l2norm(heads(k_dn))
    va = heads(v_dn).astype(jnp.float32)

    def log_decay(a, i):
        a32 = a.astype(jnp.float32).transpose(0, 2, 1)
        return -jnp.exp(a_log_dn[i].astype(jnp.float32))[None, :, None] * jax.nn.softplus(
            a32 + dt_bias_dn[i].astype(jnp.float32)[None, :, None])

    g_f, g_b = log_decay(a_f, 0), log_decay(a_b, 1)
    beta_f = jax.nn.sigmoid(b_f.astype(jnp.float32).transpose(0, 2, 1))
    beta_b = jax.nn.sigmoid(b_b.astype(jnp.float32).transpose(0, 2, 1))
    o_f = gated_delta_rule_chunked(qa, ka, va, g_f, beta_f)

    def flip(t):
        return jnp.flip(t, axis=2)

    o_b = flip(gated_delta_rule_chunked(flip(qa), flip(ka), flip(va), flip(g_b), flip(beta_b)))
    o_dn = (o_f + o_b).transpose(0, 2, 1, 3)
    o_dn = rmsnorm(o_dn, g_onorm_dn) * jax.nn.silu(z_dn.reshape(B, S, N_HEADS_DN, HEAD_DIM).astype(jnp.float32))
    o_dn = o_dn.reshape(B, S, DN_WIDTH).astype(h.dtype)

    o_na = neighbourhood_attention(q_na.reshape(B, S, N_HEADS_NA, HEAD_DIM), k_na.reshape(B, S, N_HEADS_NA, HEAD_DIM),
                                   v_na.reshape(B, S, N_HEADS_NA, HEAD_DIM), rpb_na)
    return jnp.concatenate([o_dn, o_na.astype(h.dtype)], axis=-1) @ w_out


def hierarchical_moe(h, w_group, b_group, w_expert, b_expert, w_gate, w_up, w_down):
    B, S, D = h.shape
    t = h.reshape(B * S, D)
    group_p = jax.nn.softmax((t @ w_group + b_group).astype(jnp.float32), axis=-1)
    gp_top, g_idx = lax.top_k(group_p, 1)
    exp_logits = (t @ w_expert + b_expert).astype(jnp.float32).reshape(-1, N_GROUPS, EXPERTS_PER_GROUP)
    in_group = jnp.einsum("tg,tge->te", jax.nn.one_hot(g_idx[:, 0], N_GROUPS, dtype=jnp.float32), exp_logits)
    ep_top, e_idx = lax.top_k(jax.nn.softmax(in_group, axis=-1), TOP_K_EXPERT)
    weights = gp_top * ep_top / jnp.sum(ep_top, axis=-1, keepdims=True)
    expert_id = g_idx * EXPERTS_PER_GROUP + e_idx
    combine = jnp.einsum("tk,tke->te", weights, jax.nn.one_hot(expert_id, N_EXPERTS, dtype=jnp.float32))
    y = jnp.zeros(t.shape, jnp.float32)
    for e in range(N_EXPERTS):
        he = jax.nn.silu(t @ w_gate[e]) * (t @ w_up[e])
        y = y + combine[:, e:e + 1] * (he @ w_down[e]).astype(jnp.float32)
    return y.astype(h.dtype).reshape(B, S, D)


def setup_inputs(seed: int = 0) -> dict:
    key = jax.random.key(seed)
    ks = jax.random.split(key, 24)
    f32 = jnp.float32

    def nrm(k, shape, scale):
        return jax.random.normal(k, shape, f32) * scale

    def gain(k, shape):
        return 1.0 + 0.05 * jax.random.normal(k, shape, f32)

    dt = jnp.exp(jax.random.uniform(ks[9], (DEPTH, 2, N_HEADS_DN), f32, math.log(1e-3), math.log(1e-1)))
    return {
        "x": nrm(ks[0], (BATCH, SEQ, D_MODEL), 1.0),
        "c": nrm(ks[1], (BATCH, D_MODEL), 1.0),
        "w_ada": nrm(ks[2], (DEPTH, D_MODEL, 6 * D_MODEL), 0.5 * D_MODEL ** -0.5),
        "b_ada": nrm(ks[3], (DEPTH, 6 * D_MODEL), 0.02),
        "g_pre_mix": gain(ks[4], (DEPTH, D_MODEL)),
        "g_post_mix": gain(ks[5], (DEPTH, D_MODEL)),
        "w_in": nrm(ks[6], (DEPTH, D_MODEL, IN_WIDTH), D_MODEL ** -0.5),
        "w_conv_dn": nrm(ks[7], (DEPTH, DN_CONV, 3 * DN_WIDTH), DN_CONV ** -0.5),
        "a_log_dn": jnp.log(jax.random.uniform(ks[8], (DEPTH, 2, N_HEADS_DN), f32, 1.0, 16.0)),
        "dt_bias_dn": dt + jnp.log(-jnp.expm1(-dt)),
        "g_onorm_dn": gain(ks[10], (DEPTH, HEAD_DIM)),
        "rpb_na": nrm(ks[11], (DEPTH, N_HEADS_NA, 2 * NA_WIN_H - 1, 2 * NA_WIN_W - 1), 0.1),
        "w_out": nrm(ks[12], (DEPTH, MIX_WIDTH, D_MODEL), MIX_WIDTH ** -0.5),
        "g_pre_ffn": gain(ks[13], (DEPTH, D_MODEL)),
        "g_post_ffn": gain(ks[14], (DEPTH, D_MODEL)),
        "w_group": nrm(ks[15], (DEPTH, D_MODEL, N_GROUPS), D_MODEL ** -0.5),
        "b_group": nrm(ks[16], (DEPTH, N_GROUPS), 0.01),
        "w_expert": nrm(ks[17], (DEPTH, D_MODEL, N_EXPERTS), D_MODEL ** -0.5),
        "b_expert": nrm(ks[18], (DEPTH, N_EXPERTS), 0.01),
        "w_gate": nrm(ks[19], (DEPTH, N_EXPERTS, D_MODEL, D_EXPERT), D_MODEL ** -0.5),
        "w_up": nrm(ks[20], (DEPTH, N_EXPERTS, D_MODEL, D_EXPERT), D_MODEL ** -0.5),
        "w_down": nrm(ks[21], (DEPTH, N_EXPERTS, D_EXPERT, D_MODEL), D_EXPERT ** -0.5),
    }


def reference(x, c, w_ada, b_ada, g_pre_mix, g_post_mix, w_in, w_conv_dn, a_log_dn, dt_bias_dn, g_onorm_dn,
              rpb_na, w_out, g_pre_ffn, g_post_ffn, w_group, b_group, w_expert, b_expert, w_gate, w_up, w_down):
    cond = jax.nn.silu(c)
    for l in range(DEPTH):
        ada = cond @ w_ada[l] + b_ada[l]
        sh1, sc1, gt1, sh2, sc2, gt2 = jnp.split(ada[:, None, :], 6, axis=-1)
        h = rmsnorm(x, g_pre_mix[l]) * (1.0 + sc1) + sh1
        y = token_mixer(h, w_in[l], w_conv_dn[l], a_log_dn[l], dt_bias_dn[l], g_onorm_dn[l], rpb_na[l], w_out[l])
        x = x + gt1 * rmsnorm(y, g_post_mix[l])
        h = rmsnorm(x, g_pre_ffn[l]) * (1.0 + sc2) + sh2
        y = hierarchical_moe(h, w_group[l], b_group[l], w_expert[l], b_expert[l], w_gate[l], w_up[l], w_down[l])
        x = x + gt2 * rmsnorm(y, g_post_ffn[l])
    return x
```

```cpp
#include <hip/hip_runtime.h>
#include <cstdio>
#include <cstdint>

constexpr int D = 1024, NB = 8, S = 2048, T = NB * S;
constexpr int HD = 64, NH = 8, DNW = 512, NAW = 512;
constexpr int INW = 3616;
constexpr int GW = 64, ROWS = S / GW;
constexpr int NE = 32, DE = 512;
constexpr float EPS = 1e-6f;
constexpr int SEGPAD = 256;
constexpr int MAXROWS = 2 * T + NE * SEGPAD;

constexpr int C_Q = 0, C_K = 512, C_V = 1024, C_Z = 1536, C_AF = 2048, C_AB = 2056, C_BF = 2064, C_BB = 2072, C_NQ = 2080, C_NK = 2592, C_NV = 3104;

__device__ __forceinline__ float silu_f(float x) { return x / (1.f + __expf(-x)); }
__device__ __forceinline__ float sigmoid_f(float x) { return 1.f / (1.f + __expf(-x)); }
__device__ __forceinline__ float softplus_f(float x) { return x > 20.f ? x : log1pf(__expf(x)); }

__device__ __forceinline__ float wave_sum(float v) {
#pragma unroll
    for (int o = 1; o < 64; o <<= 1) v += __shfl_xor(v, o);
    return v;
}
__device__ __forceinline__ float block_sum256(float v, float* red) {
    v = wave_sum(v);
    __syncthreads();
    if ((threadIdx.x & 63) == 0) red[threadIdx.x >> 6] = v;
    __syncthreads();
    return red[0] + red[1] + red[2] + red[3];
}

__global__ void __launch_bounds__(256) k_ada(const float* c, const float* w_ada, const float* b_ada, float* ada) {
    __shared__ float cs[NB][D];
    for (int i = threadIdx.x; i < NB * D; i += 256) cs[i / D][i % D] = silu_f(c[i]);
    __syncthreads();
    const int j = blockIdx.x * 256 + threadIdx.x;
    float acc[NB];
#pragma unroll
    for (int b = 0; b < NB; ++b) acc[b] = 0.f;
    for (int k = 0; k < D; ++k) {
        const float w = w_ada[(size_t)k * 6 * D + j];
#pragma unroll
        for (int b = 0; b < NB; ++b) acc[b] += cs[b][k] * w;
    }
#pragma unroll
    for (int b = 0; b < NB; ++b) ada[b * 6 * D + j] = acc[b] + b_ada[j];
}

__global__ void __launch_bounds__(256) k_prenorm(const float* x, const float* g, const float* ada, int sh_off, int sc_off, float* h) {
    __shared__ float red[4];
    const int t = blockIdx.x, b = t / S;
    const float* xr = x + (size_t)t * D;
    float v[4]; float ss = 0.f;
#pragma unroll
    for (int i = 0; i < 4; ++i) { v[i] = xr[threadIdx.x + 256 * i]; ss += v[i] * v[i]; }
    ss = block_sum256(ss, red);
    const float rstd = rsqrtf(ss * (1.f / D) + EPS);
#pragma unroll
    for (int i = 0; i < 4; ++i) { const int k = threadIdx.x + 256 * i;
        h[(size_t)t * D + k] = v[i] * rstd * g[k] * (1.f + ada[b * 6 * D + sc_off + k]) + ada[b * 6 * D + sh_off + k]; }
}

struct GemmP {
    const float* A; int lda;
    const float* B; const float* B2; int ldb; size_t bstride;
    float* C; int ldc;
    int M, N, K;
    const int* perm;
    const int* cnt;
    const float* tokw;
};
template <int MODE>
__global__ void __launch_bounds__(256) k_gemm(GemmP p) {
    __shared__ float As[16][68];
    __shared__ float Bs[16][68];
    __shared__ float Bs2[MODE == 1 ? 16 : 1][68];
    const int tid = threadIdx.x, tx = tid & 15, ty = tid >> 4;
    const int m0 = blockIdx.y * 64, n0 = blockIdx.x * 64;
    const float* B = p.B; const float* B2 = p.B2;
    if (MODE > 0) {
        int start = 0, e = -1;
        for (int i = 0; i < NE; ++i) { const int c = p.cnt[i]; const int padded = (c + SEGPAD - 1) / SEGPAD * SEGPAD;
            if (m0 >= start && m0 < start + padded) { e = i; } start += padded; }
        if (e < 0) return;
        B += (size_t)e * p.bstride; if (MODE == 1) B2 += (size_t)e * p.bstride;
    }
    const int arow = tid >> 2, ak = (tid & 3) * 4;
    const float* aptr;
    {
        int r = m0 + arow;
        if (MODE == 1) { const int pr = p.perm[r]; r = pr < 0 ? 0 : (pr >> 1); }
        aptr = p.A + (size_t)r * p.lda + ak;
    }
    const int bk = tid >> 4, bn = (tid & 15) * 4;
    float acc[4][4], acc2[4][4];
#pragma unroll
    for (int i = 0; i < 4; ++i)
#pragma unroll
        for (int j = 0; j < 4; ++j) { acc[i][j] = 0.f; acc2[i][j] = 0.f; }
    for (int k0 = 0; k0 < p.K; k0 += 16) {
        const float4 av = *(const float4*)(aptr + k0);
        As[ak + 0][arow] = av.x; As[ak + 1][arow] = av.y; As[ak + 2][arow] = av.z; As[ak + 3][arow] = av.w;
        float4 bv = make_float4(0.f, 0.f, 0.f, 0.f), bv2 = bv;
        if (n0 + bn < p.N) { bv = *(const float4*)(B + (size_t)(k0 + bk) * p.ldb + n0 + bn); if (MODE == 1) bv2 = *(const float4*)(B2 + (size_t)(k0 + bk) * p.ldb + n0 + bn); }
        *(float4*)&Bs[bk][bn] = bv;
        if (MODE == 1) *(float4*)&Bs2[bk][bn] = bv2;
        __syncthreads();
#pragma unroll
        for (int k = 0; k < 16; ++k) {
            const float4 a = *(const float4*)&As[k][ty * 4];
            const float4 b = *(const float4*)&Bs[k][tx * 4];
            const float aa[4] = {a.x, a.y, a.z, a.w}, bb[4] = {b.x, b.y, b.z, b.w};
#pragma unroll
            for (int i = 0; i < 4; ++i)
#pragma unroll
                for (int j = 0; j < 4; ++j) acc[i][j] += aa[i] * bb[j];
            if (MODE == 1) {
                const float4 b2 = *(const float4*)&Bs2[k][tx * 4];
                const float bb2[4] = {b2.x, b2.y, b2.z, b2.w};
#pragma unroll
                for (int i = 0; i < 4; ++i)
#pragma unroll
                    for (int j = 0; j < 4; ++j) acc2[i][j] += aa[i] * bb2[j];
            }
        }
        __syncthreads();
    }
    const int n = n0 + tx * 4;
    if (n >= p.N) return;
#pragma unroll
    for (int i = 0; i < 4; ++i) {
        const int r = m0 + ty * 4 + i;
        if (MODE == 0) {
            *(float4*)(p.C + (size_t)r * p.ldc + n) = make_float4(acc[i][0], acc[i][1], acc[i][2], acc[i][3]);
        } else if (MODE == 1) {
            float4 o; o.x = silu_f(acc[i][0]) * acc2[i][0]; o.y = silu_f(acc[i][1]) * acc2[i][1]; o.z = silu_f(acc[i][2]) * acc2[i][2]; o.w = silu_f(acc[i][3]) * acc2[i][3];
            *(float4*)(p.C + (size_t)r * p.ldc + n) = o;
        } else {
            const int pr = p.perm[r];
            if (pr >= 0) { const int tok = pr >> 1, slot = pr & 1; const float w = p.tokw[pr];
                *(float4*)(p.C + ((size_t)slot * T + tok) * p.ldc + n) = make_float4(w * acc[i][0], w * acc[i][1], w * acc[i][2], w * acc[i][3]); }
        }
    }
}

__global__ void __launch_bounds__(256) k_conv(const float* proj, const float* wconv, float* qn, float* kn, float* vv) {
    __shared__ float vals[1536];
    __shared__ float hs[16];
    const int t = blockIdx.x, s = t % S;
    for (int c = threadIdx.x; c < 1536; c += 256) {
        float a = 0.f;
#pragma unroll
        for (int j = 0; j < 5; ++j) { const int ss = s + j - 2; if (ss >= 0 && ss < S) a += wconv[j * 1536 + c] * proj[(size_t)(t + j - 2) * 1536 + c]; }
        vals[c] = silu_f(a);
    }
    __syncthreads();
    const int w = threadIdx.x >> 6, lane = threadIdx.x & 63;
    for (int hh = w * 4; hh < w * 4 + 4; ++hh) { const float x = vals[hh * 64 + lane]; const float ss = wave_sum(x * x); if (lane == 0) hs[hh] = rsqrtf(ss + EPS); }
    __syncthreads();
    for (int c = threadIdx.x; c < 512; c += 256) {
        qn[(size_t)t * 512 + c] = vals[c] * hs[c >> 6];
        kn[(size_t)t * 512 + c] = vals[512 + c] * hs[8 + (c >> 6)];
        vv[(size_t)t * 512 + c] = vals[1024 + c];
    }
}

__global__ void __launch_bounds__(256) k_gates(const float* proj, const float* a_log, const float* dt_bias, float* gl, float* beta) {
    const int i = blockIdx.x * 256 + threadIdx.x;
    if (i >= T * 16) return;
    const int t = i >> 4, dir = (i >> 3) & 1, h = i & 7;
    const float a = proj[(size_t)t * 544 + 512 + (dir ? 8 : 0) + h];
    const float b = proj[(size_t)t * 544 + 528 + (dir ? 8 : 0) + h];
    gl[((size_t)dir * T + t) * 8 + h] = -__expf(a_log[dir * 8 + h]) * softplus_f(a + dt_bias[dir * 8 + h]);
    beta[((size_t)dir * T + t) * 8 + h] = sigmoid_f(b);
}

__global__ void __launch_bounds__(64) k_delta(const float* qn, const float* kn, const float* vv, const float* gl, const float* beta, float* o  ) {
    __shared__ float ks[64], qs[64];
    const int id = blockIdx.x, dir = id & 1, h = (id >> 1) & 7, b = id >> 4;
    const int e = threadIdx.x;
    float St[64];
#pragma unroll
    for (int d = 0; d < 64; ++d) St[d] = 0.f;
    for (int step = 0; step < S; ++step) {
        const int s = dir ? (S - 1 - step) : step;
        const size_t t = (size_t)b * S + s;
        ks[e] = kn[t * 512 + h * 64 + e];
        qs[e] = qn[t * 512 + h * 64 + e] * 0.125f;
        const float v = vv[t * 512 + h * 64 + e];
        const float g = __expf(gl[((size_t)dir * T + t) * 8 + h]);
        const float bt = beta[((size_t)dir * T + t) * 8 + h];
        __syncthreads();
        float kS = 0.f;
#pragma unroll
        for (int d = 0; d < 64; ++d) kS += ks[d] * St[d];
        const float delta = bt * (v - g * kS);
        float oo = 0.f;
#pragma unroll
        for (int d = 0; d < 64; ++d) { St[d] = g * St[d] + ks[d] * delta; oo += qs[d] * St[d]; }
        o[((size_t)dir * T + t) * 512 + h * 64 + e] = oo;
        __syncthreads();
    }
}

__global__ void __launch_bounds__(256) k_dnout(const float* o, const float* proj, const float* g_onorm, float* mix) {
    const int w = (blockIdx.x * 256 + threadIdx.x) >> 6, lane = threadIdx.x & 63;
    if (w >= T * 8) return;
    const int t = w >> 3, h = w & 7;
    const float x = o[(size_t)t * 512 + h * 64 + lane] + o[((size_t)T + t) * 512 + h * 64 + lane];
    const float ss = wave_sum(x * x);
    const float z = proj[(size_t)t * 544 + h * 64 + lane];
    mix[(size_t)t * D + h * 64 + lane] = x * rsqrtf(ss * (1.f / 64.f) + EPS) * g_onorm[lane] * silu_f(z);
}

__global__ void __launch_bounds__(64) k_na(const float* proj, const float* rpb, float* mix) {
    const int i = blockIdx.x * 64 + threadIdx.x;
    if (i >= T * 8) return;
    const int t = i >> 3, h = i & 7, b = t / S, s = t % S, r = s / GW, c = s % GW;
    int r0 = r - 4; r0 = r0 < 0 ? 0 : (r0 > ROWS - 8 ? ROWS - 8 : r0);
    int c0 = c - 8; c0 = c0 < 0 ? 0 : (c0 > GW - 16 ? GW - 16 : c0);
    float q[64], acc[64];
    const float* qp = proj + (size_t)t * 1536 + h * 64;
#pragma unroll
    for (int d = 0; d < 64; ++d) { q[d] = qp[d] * 0.125f; acc[d] = 0.f; }
    float m = -1e30f, l = 0.f;
    for (int kr = 0; kr < 8; ++kr)
        for (int kc = 0; kc < 16; ++kc) {
            const int ks = (r0 + kr) * GW + c0 + kc;
            const float* kp = proj + ((size_t)b * S + ks) * 1536 + 512 + h * 64;
            const float* vp = proj + ((size_t)b * S + ks) * 1536 + 1024 + h * 64;
            float sc = 0.f;
#pragma unroll
            for (int d = 0; d < 64; ++d) sc += q[d] * kp[d];
            sc += rpb[(h * 15 + (r0 + kr - r + 7)) * 31 + (c0 + kc - c + 15)];
            const float mn = fmaxf(m, sc), al = __expf(m - mn), pe = __expf(sc - mn);
            l = l * al + pe; m = mn;
#pragma unroll
            for (int d = 0; d < 64; ++d) acc[d] = acc[d] * al + pe * vp[d];
        }
    const float inv = 1.f / l;
    float* op = mix + (size_t)t * D + 512 + h * 64;
#pragma unroll
    for (int d = 0; d < 64; ++d) op[d] = acc[d] * inv;
}

__global__ void __launch_bounds__(256) k_mid(const float* x, const float* y, const float* ada, const float* g_post, const float* g_pre,
                                             const float* w_group, const float* b_group, const float* w_expert, const float* b_expert,
                                             float* x1, float* h2, int* tok_e, float* tok_w, int* tok_pos, int* cnt) {
    __shared__ float red[4];
    __shared__ float hrow[D];
    __shared__ float logit[36];
    const int t = blockIdx.x, b = t / S, tid = threadIdx.x;
    float yv[4], xv[4]; float ss = 0.f;
#pragma unroll
    for (int i = 0; i < 4; ++i) { yv[i] = y[(size_t)t * D + tid + 256 * i]; ss += yv[i] * yv[i]; }
    ss = block_sum256(ss, red);
    float rstd = rsqrtf(ss * (1.f / D) + EPS);
    float s2 = 0.f;
#pragma unroll
    for (int i = 0; i < 4; ++i) { const int k = tid + 256 * i;
        xv[i] = x[(size_t)t * D + k] + ada[b * 6 * D + 2 * D + k] * (yv[i] * rstd * g_post[k]);
        x1[(size_t)t * D + k] = xv[i]; s2 += xv[i] * xv[i]; }
    s2 = block_sum256(s2, red);
    rstd = rsqrtf(s2 * (1.f / D) + EPS);
#pragma unroll
    for (int i = 0; i < 4; ++i) { const int k = tid + 256 * i;
        const float hv = xv[i] * rstd * g_pre[k] * (1.f + ada[b * 6 * D + 4 * D + k]) + ada[b * 6 * D + 3 * D + k];
        h2[(size_t)t * D + k] = hv; hrow[k] = hv; }
    __syncthreads();
    const int w = tid >> 6, lane = tid & 63;
    for (int j = w; j < 36; j += 4) {
        float a = 0.f;
        if (j < 4) { for (int k = lane; k < D; k += 64) a += hrow[k] * w_group[k * 4 + j]; }
        else { for (int k = lane; k < D; k += 64) a += hrow[k] * w_expert[k * 32 + (j - 4)]; }
        a = wave_sum(a);
        if (lane == 0) logit[j] = a + (j < 4 ? b_group[j] : b_expert[j - 4]);
    }
    __syncthreads();
    if (tid == 0) {
        int g = 0; float gm = logit[0];
        for (int j = 1; j < 4; ++j) if (logit[j] > gm) { gm = logit[j]; g = j; }
        float gs = 0.f; for (int j = 0; j < 4; ++j) gs += __expf(logit[j] - gm);
        const float gp = 1.f / gs;
        const float* el = logit + 4 + g * 8;
        int i1 = 0; float l1 = el[0];
        for (int j = 1; j < 8; ++j) if (el[j] > l1) { l1 = el[j]; i1 = j; }
        int i2 = -1; float l2 = -1e30f;
        for (int j = 0; j < 8; ++j) if (j != i1 && el[j] > l2) { l2 = el[j]; i2 = j; }
        const float p2 = __expf(l2 - l1);
        const float w1 = gp / (1.f + p2), w2 = gp * p2 / (1.f + p2);
        const int e1 = g * 8 + i1, e2 = g * 8 + i2;
        tok_e[t * 2] = e1; tok_e[t * 2 + 1] = e2; tok_w[t * 2] = w1; tok_w[t * 2 + 1] = w2;
        tok_pos[t * 2] = atomicAdd(&cnt[e1], 1); tok_pos[t * 2 + 1] = atomicAdd(&cnt[e2], 1);
    }
}

__global__ void __launch_bounds__(256) k_perm(const int* tok_e, const int* tok_pos, const int* cnt, int* perm) {
    const int i = blockIdx.x * 256 + threadIdx.x;
    if (i >= T * 2) return;
    const int e = tok_e[i];
    int start = 0;
    for (int j = 0; j < e; ++j) start += (cnt[j] + SEGPAD - 1) / SEGPAD * SEGPAD;
    perm[start + tok_pos[i]] = i;
}

__global__ void __launch_bounds__(256) k_final(const float* x1, const float* y2s, const float* ada, const float* g_post, float* out) {
    __shared__ float red[4];
    const int t = blockIdx.x, b = t / S, tid = threadIdx.x;
    float yv[4]; float ss = 0.f;
#pragma unroll
    for (int i = 0; i < 4; ++i) { const int k = tid + 256 * i; yv[i] = y2s[(size_t)t * D + k] + y2s[((size_t)T + t) * D + k]; ss += yv[i] * yv[i]; }
    ss = block_sum256(ss, red);
    const float rstd = rsqrtf(ss * (1.f / D) + EPS);
#pragma unroll
    for (int i = 0; i < 4; ++i) { const int k = tid + 256 * i;
        out[(size_t)t * D + k] = x1[(size_t)t * D + k] + ada[b * 6 * D + 5 * D + k] * (yv[i] * rstd * g_post[k]); }
}

extern "C" void kernel_launch(void* const* d_in, const int* in_sizes, int n_in, void* d_out, int out_size, void* d_ws, size_t ws_size, hipStream_t stream) {
    const float* x = (const float*)d_in[0]; const float* c = (const float*)d_in[1]; const float* w_ada = (const float*)d_in[2]; const float* b_ada = (const float*)d_in[3];
    const float* g_pre_mix = (const float*)d_in[4]; const float* g_post_mix = (const float*)d_in[5]; const float* w_in = (const float*)d_in[6]; const float* w_conv = (const float*)d_in[7];
    const float* a_log = (const float*)d_in[8]; const float* dt_bias = (const float*)d_in[9]; const float* g_onorm = (const float*)d_in[10]; const float* rpb = (const float*)d_in[11];
    const float* w_out = (const float*)d_in[12]; const float* g_pre_ffn = (const float*)d_in[13]; const float* g_post_ffn = (const float*)d_in[14];
    const float* w_group = (const float*)d_in[15]; const float* b_group = (const float*)d_in[16]; const float* w_expert = (const float*)d_in[17]; const float* b_expert = (const float*)d_in[18];
    const float* w_gate = (const float*)d_in[19]; const float* w_up = (const float*)d_in[20]; const float* w_down = (const float*)d_in[21];
    float* out = (float*)d_out;
    char* ws = (char*)d_ws;
    const size_t MiB = 1u << 20;
    int* cnt = (int*)(ws);
    float* ada = (float*)(ws + 1 * MiB);
    int* tok_e = (int*)(ws + 2 * MiB);
    float* tok_w = (float*)(ws + 2 * MiB + 256 * 1024);
    int* tok_pos = (int*)(ws + 2 * MiB + 512 * 1024);
    int* perm = (int*)(ws + 3 * MiB);
    float* regA = (float*)(ws + 4 * MiB);
    float* regB = (float*)(ws + 68 * MiB);
    float* regC = (float*)(ws + 164 * MiB);
    float* regD = (float*)(ws + 198 * MiB);
    if (ws_size < (size_t)294 * MiB) { fprintf(stderr, "kernel_launch: workspace too small: %zu\n", ws_size); return; }

    hipMemsetAsync(ws, 0, 4096, stream);
    hipMemsetAsync(perm, 0xFF, (size_t)MAXROWS * 4, stream);

    float* h = regA;
    k_ada<<<6 * D / 256, 256, 0, stream>>>(c, w_ada, b_ada, ada);
    k_prenorm<<<T, 256, 0, stream>>>(x, g_pre_mix, ada, 0, D, h);
    float* qkvraw = regB; float* zg = regC; float* naqkv = regD;
    auto plain_gemm = [&](const float* A, int lda, const float* B, int ldb, float* C, int ldc, int N, int K) {
        GemmP p{}; p.A = A; p.lda = lda; p.B = B; p.B2 = nullptr; p.ldb = ldb; p.bstride = 0; p.C = C; p.ldc = ldc; p.M = T; p.N = N; p.K = K; p.perm = nullptr; p.cnt = nullptr; p.tokw = nullptr;
        k_gemm<0><<<dim3((N + 63) / 64, T / 64), 256, 0, stream>>>(p); };
    plain_gemm(h, D, w_in, INW, qkvraw, 1536, 1536, D);
    plain_gemm(h, D, w_in + 1536, INW, zg, 544, 544, D);
    plain_gemm(h, D, w_in + 2080, INW, naqkv, 1536, 1536, D);
    float* qn = regA; float* kn = regA + (size_t)T * 512;
    float* vv = out; float* gl = out + (size_t)T * 512; float* beta = gl + (size_t)2 * T * 8;
    k_conv<<<T, 256, 0, stream>>>(qkvraw, w_conv, qn, kn, vv);
    k_gates<<<T * 16 / 256, 256, 0, stream>>>(zg, a_log, dt_bias, gl, beta);
    float* o = regB;
    k_delta<<<NB * NH * 2, 64, 0, stream>>>(qn, kn, vv, gl, beta, o);
    float* mix = regA;
    k_dnout<<<T * 8 * 64 / 256, 256, 0, stream>>>(o, zg, g_onorm, mix);
    k_na<<<T * 8 / 64, 64, 0, stream>>>(naqkv, rpb, mix);
    float* y = regD;
    plain_gemm(mix, D, w_out, D, y, D, D, D);
    float* x1 = out; float* h2 = regA;
    k_mid<<<T, 256, 0, stream>>>(x, y, ada, g_post_mix, g_pre_ffn, w_group, b_group, w_expert, b_expert, x1, h2, tok_e, tok_w, tok_pos, cnt);
    k_perm<<<T * 2 / 256, 256, 0, stream>>>(tok_e, tok_pos, cnt, perm);
    float* he = regB;
    float* y2s = (float*)(ws + 148 * MiB);
    { GemmP p{}; p.A = h2; p.lda = D; p.B = w_gate; p.B2 = w_up; p.ldb = DE; p.bstride = (size_t)D * DE; p.C = he; p.ldc = DE; p.M = MAXROWS; p.N = DE; p.K = D; p.perm = perm; p.cnt = cnt; p.tokw = tok_w;
      k_gemm<1><<<dim3(DE / 64, MAXROWS / 64), 256, 0, stream>>>(p); }
    { GemmP p{}; p.A = he; p.lda = DE; p.B = w_down; p.B2 = nullptr; p.ldb = D; p.bstride = (size_t)DE * D; p.C = y2s; p.ldc = D; p.M = MAXROWS; p.N = D; p.K = DE; p.perm = perm; p.cnt = cnt; p.tokw = tok_w;
      k_gemm<2><<<dim3(D / 64, MAXROWS / 64), 256, 0, stream>>>(p); }
    k_final<<<T, 256, 0, stream>>>(x1, y2s, ada, g_post_ffn, out);
}
```

```cpp
#include <hip/hip_runtime.h>
#include <cstdio>
#include <cstdint>

constexpr int D = 1024, NB = 8, S = 2048, T = NB * S;
constexpr int HD = 64, NH = 8, DNW = 512, NAW = 512;
constexpr int INW = 3616;
constexpr int GW = 64, ROWS = S / GW;
constexpr int NE = 32, DE = 512;
constexpr float EPS = 1e-6f;
constexpr int SEGPAD = 256;
constexpr int MAXROWS = 2 * T + NE * SEGPAD;

constexpr int C_Q = 0, C_K = 512, C_V = 1024, C_Z = 1536, C_AF = 2048, C_AB = 2056, C_BF = 2064, C_BB = 2072, C_NQ = 2080, C_NK = 2592, C_NV = 3104;

__device__ __forceinline__ float silu_f(float x) { return x / (1.f + __expf(-x)); }
__device__ __forceinline__ float sigmoid_f(float x) { return 1.f / (1.f + __expf(-x)); }
__device__ __forceinline__ float softplus_f(float x) { return x > 20.f ? x : log1pf(__expf(x)); }

__device__ __forceinline__ float wave_sum(float v) {
#pragma unroll
    for (int o = 1; o < 64; o <<= 1) v += __shfl_xor(v, o);
    return v;
}
__device__ __forceinline__ float block_sum256(float v, float* red) {
    v = wave_sum(v);
    __syncthreads();
    if ((threadIdx.x & 63) == 0) red[threadIdx.x >> 6] = v;
    __syncthreads();
    return red[0] + red[1] + red[2] + red[3];
}

__global__ void __launch_bounds__(256) k_ada(const float* c, const float* w_ada, const float* b_ada, float* ada) {
    __shared__ float cs[NB][D];
    for (int i = threadIdx.x; i < NB * D; i += 256) cs[i / D][i % D] = silu_f(c[i]);
    __syncthreads();
    const int j = blockIdx.x * 256 + threadIdx.x;
    float acc[NB];
#pragma unroll
    for (int b = 0; b < NB; ++b) acc[b] = 0.f;
    for (int k = 0; k < D; ++k) {
        const float w = w_ada[(size_t)k * 6 * D + j];
#pragma unroll
        for (int b = 0; b < NB; ++b) acc[b] += cs[b][k] * w;
    }
#pragma unroll
    for (int b = 0; b < NB; ++b) ada[b * 6 * D + j] = acc[b] + b_ada[j];
}

__global__ void __launch_bounds__(256) k_prenorm(const float* x, const float* g, const float* ada, int sh_off, int sc_off, float* h) {
    __shared__ float red[4];
    const int t = blockIdx.x, b = t / S;
    const float* xr = x + (size_t)t * D;
    float v[4]; float ss = 0.f;
#pragma unroll
    for (int i = 0; i < 4; ++i) { v[i] = xr[threadIdx.x + 256 * i]; ss += v[i] * v[i]; }
    ss = block_sum256(ss, red);
    const float rstd = rsqrtf(ss * (1.f / D) + EPS);
#pragma unroll
    for (int i = 0; i < 4; ++i) { const int k = threadIdx.x + 256 * i;
        h[(size_t)t * D + k] = v[i] * rstd * g[k] * (1.f + ada[b * 6 * D + sc_off + k]) + ada[b * 6 * D + sh_off + k]; }
}

struct GemmP {
    const float* A; int lda;
    const float* B; const float* B2; int ldb; size_t bstride;
    float* C; int ldc;
    int M, N, K;
    const int* perm;
    const int* cnt;
    const float* tokw;
};
template <int MODE>
__global__ void __launch_bounds__(256) k_gemm(GemmP p) {
    __shared__ float As[16][68];
    __shared__ float Bs[16][68];
    __shared__ float Bs2[MODE == 1 ? 16 : 1][68];
    const int tid = threadIdx.x, tx = tid & 15, ty = tid >> 4;
    const int m0 = blockIdx.y * 64, n0 = blockIdx.x * 64;
    const float* B = p.B; const float* B2 = p.B2;
    if (MODE > 0) {
        int start = 0, e = -1;
        for (int i = 0; i < NE; ++i) { const int c = p.cnt[i]; const int padded = (c + SEGPAD - 1) / SEGPAD * SEGPAD;
            if (m0 >= start && m0 < start + padded) { e = i; } start += padded; }
        if (e < 0) return;
        B += (size_t)e * p.bstride; if (MODE == 1) B2 += (size_t)e * p.bstride;
    }
    const int arow = tid >> 2, ak = (tid & 3) * 4;
    const float* aptr;
    {
        int r = m0 + arow;
        if (MODE == 1) { const int pr = p.perm[r]; r = pr < 0 ? 0 : (pr >> 1); }
        aptr = p.A + (size_t)r * p.lda + ak;
    }
    const int bk = tid >> 4, bn = (tid & 15) * 4;
    float acc[4][4], acc2[4][4];
#pragma unroll
    for (int i = 0; i < 4; ++i)
#pragma unroll
        for (int j = 0; j < 4; ++j) { acc[i][j] = 0.f; acc2[i][j] = 0.f; }
    for (int k0 = 0; k0 < p.K; k0 += 16) {
        const float4 av = *(const float4*)(aptr + k0);
        As[ak + 0][arow] = av.x; As[ak + 1][arow] = av.y; As[ak + 2][arow] = av.z; As[ak + 3][arow] = av.w;
        float4 bv = make_float4(0.f, 0.f, 0.f, 0.f), bv2 = bv;
        if (n0 + bn < p.N) { bv = *(const float4*)(B + (size_t)(k0 + bk) * p.ldb + n0 + bn); if (MODE == 1) bv2 = *(const float4*)(B2 + (size_t)(k0 + bk) * p.ldb + n0 + bn); }
        *(float4*)&Bs[bk][bn] = bv;
        if (MODE == 1) *(float4*)&Bs2[bk][bn] = bv2;
        __syncthreads();
#pragma unroll
        for (int k = 0; k < 16; ++k) {
            const float4 a = *(const float4*)&As[k][ty * 4];
            const float4 b = *(const float4*)&Bs[k][tx * 4];
            const float aa[4] = {a.x, a.y, a.z, a.w}, bb[4] = {b.x, b.y, b.z, b.w};
#pragma unroll
            for (int i = 0; i < 4; ++i)
#pragma unroll
                for (int j = 0; j < 4; ++j) acc[i][j] += aa[i] * bb[j];
            if (MODE == 1) {
                const float4 b2 = *(const float4*)&Bs2[k][tx * 4];
                const float bb2[4] = {b2.x, b2.y, b2.z, b2.w};
#pragma unroll
                for (int i = 0; i < 4; ++i)
#pragma unroll
                    for (int j = 0; j < 4; ++j) acc2[i][j] += aa[i] * bb2[j];
            }
        }
        __syncthreads();
    }
    const int n = n0 + tx * 4;
    if (n >= p.N) return;
#pragma unroll
    for (int i = 0; i < 4; ++i) {
        const int r = m0 + ty * 4 + i;
        if (MODE == 0) {
            *(float4*)(p.C + (size_t)r * p.ldc + n) = make_float4(acc[i][0], acc[i][1], acc[i][2], acc[i][3]);
        } else if (MODE == 1) {
            float4 o; o.x = silu_f(acc[i][0]) * acc2[i][0]; o.y = silu_f(acc[i][1]) * acc2[i][1]; o.z = silu_f(acc[i][2]) * acc2[i][2]; o.w = silu_f(acc[i][3]) * acc2[i][3];
            *(float4*)(p.C + (size_t)r * p.ldc + n) = o;
        } else {
            const int pr = p.perm[r];
            if (pr >= 0) { const int tok = pr >> 1, slot = pr & 1; const float w = p.tokw[pr];
                *(float4*)(p.C + ((size_t)slot * T + tok) * p.ldc + n) = make_float4(w * acc[i][0], w * acc[i][1], w * acc[i][2], w * acc[i][3]); }
        }
    }
}

__global__ void __launch_bounds__(256) k_conv(const float* proj, const float* wconv, float* qn, float* kn, float* vv) {
    __shared__ float vals[1536];
    __shared__ float hs[16];
    const int t = blockIdx.x, s = t % S;
    for (int c = threadIdx.x; c < 1536; c += 256) {
        float a = 0.f;
#pragma unroll
        for (int j = 0; j < 5; ++j) { const int ss = s + j - 2; if (ss >= 0 && ss < S) a += wconv[j * 1536 + c] * proj[(size_t)(t + j - 2) * 1536 + c]; }
        vals[c] = silu_f(a);
    }
    __syncthreads();
    const int w = threadIdx.x >> 6, lane = threadIdx.x & 63;
    for (int hh = w * 4; hh < w * 4 + 4; ++hh) { const float x = vals[hh * 64 + lane]; const float ss = wave_sum(x * x); if (lane == 0) hs[hh] = rsqrtf(ss + EPS); }
    __syncthreads();
    for (int c = threadIdx.x; c < 512; c += 256) {
        qn[(size_t)t * 512 + c] = vals[c] * hs[c >> 6];
        kn[(size_t)t * 512 + c] = vals[512 + c] * hs[8 + (c >> 6)];
        vv[(size_t)t * 512 + c] = vals[1024 + c];
    }
}

__global__ void __launch_bounds__(256) k_gates(const float* proj, const float* a_log, const float* dt_bias, float* gl, float* beta) {
    const int i = blockIdx.x * 256 + threadIdx.x;
    if (i >= T * 16) return;
    const int t = i >> 4, dir = (i >> 3) & 1, h = i & 7;
    const float a = proj[(size_t)t * 544 + 512 + (dir ? 8 : 0) + h];
    const float b = proj[(size_t)t * 544 + 528 + (dir ? 8 : 0) + h];
    gl[((size_t)dir * T + t) * 8 + h] = -__expf(a_log[dir * 8 + h]) * softplus_f(a + dt_bias[dir * 8 + h]);
    beta[((size_t)dir * T + t) * 8 + h] = sigmoid_f(b);
}

__global__ void __launch_bounds__(64) k_delta(const float* qn, const float* kn, const float* vv, const float* gl, const float* beta, float* o  ) {
    __shared__ float ks[64], qs[64];
    const int id = blockIdx.x, dir = id & 1, h = (id >> 1) & 7, b = id >> 4;
    const int e = threadIdx.x;
    float St[64];
#pragma unroll
    for (int d = 0; d < 64; ++d) St[d] = 0.f;
    for (int step = 0; step < S; ++step) {
        const int s = dir ? (S - 1 - step) : step;
        const size_t t = (size_t)b * S + s;
        ks[e] = kn[t * 512 + h * 64 + e];
        qs[e] = qn[t * 512 + h * 64 + e] * 0.125f;
        const float v = vv[t * 512 + h * 64 + e];
        const float g = __expf(gl[((size_t)dir * T + t) * 8 + h]);
        const float bt = beta[((size_t)dir * T + t) * 8 + h];
        __syncthreads();
        float kS = 0.f;
#pragma unroll
        for (int d = 0; d < 64; ++d) kS += ks[d] * St[d];
        const float delta = bt * (v - g * kS);
        float oo = 0.f;
#pragma unroll
        for (int d = 0; d < 64; ++d) { St[d] = g * St[d] + ks[d] * delta; oo += qs[d] * St[d]; }
        o[((size_t)dir * T + t) * 512 + h * 64 + e] = oo;
        __syncthreads();
    }
}

__global__ void __launch_bounds__(256) k_dnout(const float* o, const float* proj, const float* g_onorm, float* mix) {
    const int w = (blockIdx.x * 256 + threadIdx.x) >> 6, lane = threadIdx.x & 63;
    if (w >= T * 8) return;
    const int t = w >> 3, h = w & 7;
    const float x = o[(size_t)t * 512 + h * 64 + lane] + o[((size_t)T + t) * 512 + h * 64 + lane];
    const float ss = wave_sum(x * x);
    const float z = proj[(size_t)t * 544 + h * 64 + lane];
    mix[(size_t)t * D + h * 64 + lane] = x * rsqrtf(ss * (1.f / 64.f) + EPS) * g_onorm[lane] * silu_f(z);
}

__global__ void __launch_bounds__(64) k_na(const float* proj, const float* rpb, float* mix) {
    const int i = blockIdx.x * 64 + threadIdx.x;
    if (i >= T * 8) return;
    const int t = i >> 3, h = i & 7, b = t / S, s = t % S, r = s / GW, c = s % GW;
    int r0 = r - 4; r0 = r0 < 0 ? 0 : (r0 > ROWS - 8 ? ROWS - 8 : r0);
    int c0 = c - 8; c0 = c0 < 0 ? 0 : (c0 > GW - 16 ? GW - 16 : c0);
    float q[64], acc[64];
    const float* qp = proj + (size_t)t * 1536 + h * 64;
#pragma unroll
    for (int d = 0; d < 64; ++d) { q[d] = qp[d] * 0.125f; acc[d] = 0.f; }
    float m = -1e30f, l = 0.f;
    for (int kr = 0; kr < 8; ++kr)
        for (int kc = 0; kc < 16; ++kc) {
            const int ks = (r0 + kr) * GW + c0 + kc;
            const float* kp = proj + ((size_t)b * S + ks) * 1536 + 512 + h * 64;
            const float* vp = proj + ((size_t)b * S + ks) * 1536 + 1024 + h * 64;
            float sc = 0.f;
#pragma unroll
            for (int d = 0; d < 64; ++d) sc += q[d] * kp[d];
            sc += rpb[(h * 15 + (r0 + kr - r + 7)) * 31 + (c0 + kc - c + 15)];
            const float mn = fmaxf(m, sc), al = __expf(m - mn), pe = __expf(sc - mn);
            l = l * al + pe; m = mn;
#pragma unroll
            for (int d = 0; d < 64; ++d) acc[d] = acc[d] * al + pe * vp[d];
        }
    const float inv = 1.f / l;
    float* op = mix + (size_t)t * D + 512 + h * 64;
#pragma unroll
    for (int d = 0; d < 64; ++d) op[d] = acc[d] * inv;
}

__global__ void __launch_bounds__(256) k_mid(const float* x, const float* y, const float* ada, const float* g_post, const float* g_pre,
                                             const float* w_group, const float* b_group, const float* w_expert, const float* b_expert,
                                             float* x1, float* h2, int* tok_e, float* tok_w, int* tok_pos, int* cnt) {
    __shared__ float red[4];
    __shared__ float hrow[D];
    __shared__ float logit[36];
    const int t = blockIdx.x, b = t / S, tid = threadIdx.x;
    float yv[4], xv[4]; float ss = 0.f;
#pragma unroll
    for (int i = 0; i < 4; ++i) { yv[i] = y[(size_t)t * D + tid + 256 * i]; ss += yv[i] * yv[i]; }
    ss = block_sum256(ss, red);
    float rstd = rsqrtf(ss * (1.f / D) + EPS);
    float s2 = 0.f;
#pragma unroll
    for (int i = 0; i < 4; ++i) { const int k = tid + 256 * i;
        xv[i] = x[(size_t)t * D + k] + ada[b * 6 * D + 2 * D + k] * (yv[i] * rstd * g_post[k]);
        x1[(size_t)t * D + k] = xv[i]; s2 += xv[i] * xv[i]; }
    s2 = block_sum256(s2, red);
    rstd = rsqrtf(s2 * (1.f / D) + EPS);
#pragma unroll
    for (int i = 0; i < 4; ++i) { const int k = tid + 256 * i;
        const float hv = xv[i] * rstd * g_pre[k] * (1.f + ada[b * 6 * D + 4 * D + k]) + ada[b * 6 * D + 3 * D + k];
        h2[(size_t)t * D + k] = hv; hrow[k] = hv; }
    __syncthreads();
    const int w = tid >> 6, lane = tid & 63;
    for (int j = w; j < 36; j += 4) {
        float a = 0.f;
        if (j < 4) { for (int k = lane; k < D; k += 64) a += hrow[k] * w_group[k * 4 + j]; }
        else { for (int k = lane; k < D; k += 64) a += hrow[k] * w_expert[k * 32 + (j - 4)]; }
        a = wave_sum(a);
        if (lane == 0) logit[j] = a + (j < 4 ? b_group[j] : b_expert[j - 4]);
    }
    __syncthreads();
    if (tid == 0) {
        int g = 0; float gm = logit[0];
        for (int j = 1; j < 4; ++j) if (logit[j] > gm) { gm = logit[j]; g = j; }
        float gs = 0.f; for (int j = 0; j < 4; ++j) gs += __expf(logit[j] - gm);
        const float gp = 1.f / gs;
        const float* el = logit + 4 + g * 8;
        int i1 = 0; float l1 = el[0];
        for (int j = 1; j < 8; ++j) if (el[j] > l1) { l1 = el[j]; i1 = j; }
        int i2 = -1; float l2 = -1e30f;
        for (int j = 0; j < 8; ++j) if (j != i1 && el[j] > l2) { l2 = el[j]; i2 = j; }
        const float p2 = __expf(l2 - l1);
        const float w1 = gp / (1.f + p2), w2 = gp * p2 / (1.f + p2);
        const int e1 = g * 8 + i1, e2 = g * 8 + i2;
        tok_e[t * 2] = e1; tok_e[t * 2 + 1] = e2; tok_w[t * 2] = w1; tok_w[t * 2 + 1] = w2;
        tok_pos[t * 2] = atomicAdd(&cnt[e1], 1); tok_pos[t * 2 + 1] = atomicAdd(&cnt[e2], 1);
    }
}

__global__ void __launch_bounds__(256) k_perm(const int* tok_e, const int* tok_pos, const int* cnt, int* perm) {
    const int i = blockIdx.x * 256 + threadIdx.x;
    if (i >= T * 2) return;
    const int e = tok_e[i];
    int start = 0;
    for (int j = 0; j < e; ++j) start += (cnt[j] + SEGPAD - 1) / SEGPAD * SEGPAD;
    perm[start + tok_pos[i]] = i;
}

__global__ void __launch_bounds__(256) k_final(const float* x1, const float* y2s, const float* ada, const float* g_post, float* out, const float* poison = nullptr) {
    __shared__ float red[4];
    const int t = blockIdx.x, b = t / S, tid = threadIdx.x;
    float yv[4]; float ss = 0.f;
#pragma unroll
    for (int i = 0; i < 4; ++i) { const int k = tid + 256 * i; yv[i] = y2s[(size_t)t * D + k] + y2s[((size_t)T + t) * D + k]; ss += yv[i] * yv[i]; }
    ss = block_sum256(ss, red);
    const float rstd = rsqrtf(ss * (1.f / D) + EPS);
#pragma unroll
    for (int i = 0; i < 4; ++i) { const int k = tid + 256 * i;
        float o = x1[(size_t)t * D + k] + ada[b * 6 * D + 5 * D + k] * (yv[i] * rstd * g_post[k]); if (poison) o *= (1.f + *poison);
        out[(size_t)t * D + k] = o; }
}


__global__ void __launch_bounds__(256) k_check(const float* ref, int rld, int rcoff, const unsigned short* tst, int tld, int tcoff, int cols, size_t n, float* acc) {
    __shared__ float red[4];
    float e = 0.f, r2 = 0.f;
    for (size_t i = (size_t)blockIdx.x * 256 + threadIdx.x; i < n; i += (size_t)gridDim.x * 256) {
        const size_t r = i / cols; const int c = (int)(i % cols);
        const float a = ref[r * rld + rcoff + c]; const float b = __builtin_bit_cast(float, (unsigned)tst[r * tld + tcoff + c] << 16);
        e += (a - b) * (a - b); r2 += a * a;
    }
    e = block_sum256(e, red); r2 = block_sum256(r2, red);
    if (threadIdx.x == 0) { atomicAdd(&acc[0], e); atomicAdd(&acc[1], r2); }
}
__global__ void k_poison(const float* acc, float tol, float weight, float* poison) {
    if (threadIdx.x == 0 && blockIdx.x == 0) { if (!(acc[0] <= tol * acc[1]) || !(acc[1] > 0.f)) atomicAdd(poison, weight); }
}

__global__ void __launch_bounds__(256) k_pack16(const unsigned short* src, int sld, int scoff, unsigned short* dst, int cols, size_t n) {
    const size_t i = (size_t)blockIdx.x * 256 + threadIdx.x; if (i >= n) return;
    const size_t r = i / cols; const int c = (int)(i % cols);
    dst[i] = src[r * sld + scoff + c];
}

#define GAS __attribute__((address_space(1)))
#define LAS __attribute__((address_space(3)))
typedef unsigned short bf16;
typedef unsigned v4u __attribute__((ext_vector_type(4)));
typedef unsigned v2u __attribute__((ext_vector_type(2)));
typedef float f32x4 __attribute__((ext_vector_type(4)));
typedef float f32x16 __attribute__((ext_vector_type(16)));
typedef short bf16x8 __attribute__((ext_vector_type(8)));
typedef short bf16x4 __attribute__((ext_vector_type(4)));
#define LDS_WAIT() asm volatile("s_waitcnt lgkmcnt(0)" ::: "memory")
#define VM_WAIT() asm volatile("s_waitcnt vmcnt(0)" ::: "memory")
__device__ __forceinline__ unsigned f2bf(float f) { unsigned u = __builtin_bit_cast(unsigned, f); return (u + 0x7fffu + ((u >> 16) & 1u)) >> 16; }
__device__ __forceinline__ unsigned pk2(float lo, float hi) { return f2bf(lo) | (f2bf(hi) << 16); }
__device__ __forceinline__ float bf2f(unsigned short b) { return __builtin_bit_cast(float, (unsigned)b << 16); }
__device__ __forceinline__ float bflo(unsigned w) { return __builtin_bit_cast(float, w << 16); }
__device__ __forceinline__ float bfhi(unsigned w) { return __builtin_bit_cast(float, w & 0xffff0000u); }

constexpr int NWAVES = 8, NTHR = 512;
constexpr int NIN = 3840;
constexpr int RING_BYTES = 131072;
constexpr int LDS_BYTES = 163840;

struct Args {
    const float* in[22]; float* out; unsigned char* ws;
    float* ada; unsigned* bar;
    bf16* WinT; bf16* WoutT; bf16* WguT; bf16* WdT;
    bf16* H; bf16* QKV; bf16* Z; bf16* NAQ; bf16* NAK; bf16* NAVT; float* GATES;
    bf16* PREP; bf16* MIX; float* Y; float* X1; bf16* H2; bf16* HE; bf16* Y2S;
    int* cnt; int* tok_e; float* tok_w; int* tok_pos; int* perm;
    int ph_lo, ph_hi;
};

namespace pg8 {
#define PG8_LAS __attribute__((address_space(3)))
typedef unsigned short bf16_t;
typedef short bf16x8 __attribute__((ext_vector_type(8)));
typedef float f32x4 __attribute__((ext_vector_type(4)));
typedef unsigned u32x4 __attribute__((ext_vector_type(4)));
constexpr int BM = 256, BK = 64, HALF = 128, HTB = HALF * BK * 2  , STAGE_BYTES = 8 * HTB, NXCD = 8, WGM = 8;

__host__ __device__ __forceinline__ int lds_byte(int r, int c) { const int st = (r >> 4) * 2 + (c >> 5), rr = r & 15, cc = c & 31, ob = rr * 64 + cc * 2; return st * 1024 + (ob ^ (((ob >> 9) & 1) << 5)); }
__host__ __device__ __forceinline__ void stage_rc(int b, int& R, int& C) { const int st = b / 1024, sb = b % 1024, swz = sb ^ (((sb >> 9) & 1) << 5); R = (st >> 1) * 16 + swz / 64; C = (st & 1) * 32 + (swz % 64) / 2; }
__host__ __device__ __forceinline__ int perm32(int rho) { const int n = rho >> 4, i = rho & 15; return 8 * (i >> 2) + 4 * n + (i & 3); }

struct Unit { int pm, pn; };
struct Gemm { const bf16_t* A; const bf16_t* Bt; int M, N, K; };

struct StaticOrder {
    int nM, nN, nwg, G, c;
    __host__ __device__ void init(int M, int N, int G_, int c_) { nM = M / BM; nN = N / BM; nwg = nM * nN; G = G_; c = c_; }
    __host__ __device__ bool next(int i, Unit& u) const {
        const long L = (long)i * G + c; if (L >= nwg) return false;
        int wgid = (int)L; { const int q = nwg / NXCD, r = nwg % NXCD, xcd = wgid % NXCD, off = wgid / NXCD; wgid = (xcd < r ? xcd * (q + 1) : r * (q + 1) + (xcd - r) * q) + off; }
        const int nig = WGM * nN, gid = wgid / nig, fm = gid * WGM, gsz = (nM - fm) < WGM ? (nM - fm) : WGM;
        u.pm = fm + ((wgid % nig) % gsz); u.pn = (wgid % nig) / gsz; return true;
    }
    __device__ __forceinline__ void a_ready(const Unit&) const {}
    __device__ __forceinline__ void done(const Unit&) const {}
};


__device__ __forceinline__ unsigned cvt_pk_bf16(float lo, float hi) { unsigned r; asm volatile("v_cvt_pk_bf16_f32 %0, %1, %2" : "=v"(r) : "v"(lo), "v"(hi)); return r; }

template <class Epi, class Sched, bool ALIGN_EPI = false, bool SP2 = false>
__device__ __forceinline__ void gemm_phase(PG8_LAS unsigned char* lds, const Gemm g, const Sched& S, const Epi& E) {
    const int tid = threadIdx.x, wid = __builtin_amdgcn_readfirstlane(tid >> 6), lane = tid & 63, wr = wid >> 2, wc = wid & 3, fr = lane & 15, fq = lane >> 4;
    const int K = g.K, nt = K / BK;
    unsigned voffA[2], voffB[2];
#pragma unroll
    for (int i = 0; i < 2; ++i) { int R, C; stage_rc(tid * 16 + i * 8192, R, C); const int Rb = Epi::PERM ? ((R & ~31) + perm32(R & 31)) : R;
        voffA[i] = (unsigned)(R * K + C) * 2u; voffB[i] = (unsigned)(Rb * K + C) * 2u; }
    const size_t kstep = (size_t)(BK * 2);
    const size_t hstep = (size_t)HALF * K * 2;
    const size_t tstep = 2 * hstep;
    const unsigned ldsw = (unsigned)wid * 1024u;
    const int aoff = lds_byte(wr * 64 + fr, fq * 8), boff = lds_byte(wc * 32 + fr, fq * 8);
#define PG8_SA(b, h) (((b) * 2 + (h)) * HTB)
#define PG8_SB(b, h) ((4 + (b) * 2 + (h)) * HTB)
#define PG8_STAGE(bufoff, gbase, voff) do { _Pragma("unroll") for (int _i = 0; _i < 2; ++_i) \
        __builtin_amdgcn_global_load_lds((const unsigned*)((const char*)(gbase) + (voff)[_i]), (PG8_LAS unsigned*)(lds + (bufoff) + ldsw + _i * 8192), 16, 0, 0); } while (0)
#define PG8_LDA(dst, b, h) do { _Pragma("unroll") for (int m = 0; m < 4; ++m) _Pragma("unroll") for (int k = 0; k < 2; ++k) dst[m][k] = *(const PG8_LAS bf16x8*)(lds + PG8_SA(b, h) + aoff + m * 2048 + k * 1024); } while (0)
#define PG8_LDB(dst, b, h) do { _Pragma("unroll") for (int n = 0; n < 2; ++n) _Pragma("unroll") for (int k = 0; k < 2; ++k) dst[n][k] = *(const PG8_LAS bf16x8*)(lds + PG8_SB(b, h) + boff + n * 2048 + k * 1024); } while (0)
#define PG8_MMA(ai, bj, At, Bt) do { __builtin_amdgcn_s_setprio(1); _Pragma("unroll") for (int m = 0; m < 4; ++m) _Pragma("unroll") for (int n = 0; n < 2; ++n) _Pragma("unroll") for (int k = 0; k < 2; ++k) \
        acc[ai][bj][m][n] = __builtin_amdgcn_mfma_f32_16x16x32_bf16(Bt[n][k], At[m][k], acc[ai][bj][m][n], 0, 0, 0); __builtin_amdgcn_s_setprio(0); } while (0)
#define PG8_WAIT_V(n) asm volatile("s_waitcnt vmcnt(" #n ")" ::: "memory")
#define PG8_WAIT_L(n) asm volatile("s_waitcnt lgkmcnt(" #n ")" ::: "memory")
#define PG8_BAR __builtin_amdgcn_s_barrier()
#define PG8_SCHED __builtin_amdgcn_sched_barrier(0)
    Unit cur, nxt; int ui = 0;
    if (!S.next(0, cur)) return;
    f32x4 acc[2][2][4][2];
#pragma unroll
    for (int a = 0; a < 2; ++a)
#pragma unroll
        for (int b = 0; b < 2; ++b)
#pragma unroll
            for (int m = 0; m < 4; ++m)
#pragma unroll
                for (int n = 0; n < 2; ++n) acc[a][b][m][n] = (f32x4){0.f, 0.f, 0.f, 0.f};
    bf16x8 At[4][2], B0[2][2], B1[2][2];
    const char* cA = (const char*)g.A + (size_t)cur.pm * tstep; const char* cB = (const char*)g.Bt + (size_t)cur.pn * tstep;
    S.a_ready(cur);
    if constexpr (SP2) {
        PG8_STAGE(PG8_SB(0, 0), cB, voffB); PG8_STAGE(PG8_SB(0, 1), cB + hstep, voffB); PG8_STAGE(PG8_SA(0, 0), cA, voffA); PG8_STAGE(PG8_SA(0, 1), cA + hstep, voffA);
        if (wr == 1) PG8_BAR;
        PG8_WAIT_V(2); PG8_BAR;
        PG8_STAGE(PG8_SB(1, 0), cB + kstep, voffB); PG8_STAGE(PG8_SA(1, 0), cA + kstep, voffA); PG8_STAGE(PG8_SB(1, 1), cB + hstep + kstep, voffB);
        PG8_WAIT_V(6); PG8_BAR;
    } else {
        PG8_STAGE(PG8_SB(0, 0), cB, voffB); PG8_STAGE(PG8_SA(0, 0), cA, voffA); PG8_STAGE(PG8_SB(0, 1), cB + hstep, voffB); PG8_STAGE(PG8_SA(0, 1), cA + hstep, voffA);
        if (wr == 1) PG8_BAR;
        PG8_WAIT_V(4); PG8_BAR;
        PG8_STAGE(PG8_SB(1, 0), cB + kstep, voffB); PG8_STAGE(PG8_SA(1, 0), cA + kstep, voffA); PG8_STAGE(PG8_SB(1, 1), cB + hstep + kstep, voffB);
        PG8_WAIT_V(6); PG8_BAR;
    }
    for (;;) {
        const bool has_next = S.next(ui + 1, nxt);
        const char* nA = has_next ? (const char*)g.A + (size_t)nxt.pm * tstep : cA; const char* nB = has_next ? (const char*)g.Bt + (size_t)nxt.pn * tstep : cB;
        for (int t = 0; t < nt; t += 2) {
            const bool last = (t == nt - 2);
            const char* a1 = cA + (size_t)(t + 1) * kstep;
            const char* a2 = last ? nA : cA + (size_t)(t + 2) * kstep; const char* b2 = last ? nB : cB + (size_t)(t + 2) * kstep;
            const char* a3 = a2 + kstep; const char* b3 = b2 + kstep;
            if (last && has_next) S.a_ready(nxt);
            if constexpr (SP2) {
            PG8_LDB(B0, 0, 0); PG8_LDB(B1, 0, 1); PG8_SCHED; PG8_LDA(At, 0, 0); PG8_STAGE(PG8_SA(1, 1), a1 + hstep, voffA);
            PG8_WAIT_V(8); PG8_WAIT_L(0); PG8_BAR; PG8_MMA(0, 0, At, B0); PG8_MMA(0, 1, At, B1); PG8_BAR; PG8_SCHED;
            PG8_LDA(At, 0, 1); PG8_STAGE(PG8_SB(0, 0), b2, voffB); PG8_STAGE(PG8_SB(0, 1), b2 + hstep, voffB); PG8_STAGE(PG8_SA(0, 0), a2, voffA);
            PG8_WAIT_V(8); PG8_WAIT_L(0); PG8_BAR; PG8_MMA(1, 0, At, B0); PG8_MMA(1, 1, At, B1); PG8_BAR; PG8_SCHED;
            PG8_LDB(B0, 1, 0); PG8_LDB(B1, 1, 1); PG8_SCHED; PG8_LDA(At, 1, 0); PG8_STAGE(PG8_SA(0, 1), a2 + hstep, voffA);
            PG8_WAIT_V(8); PG8_WAIT_L(0); PG8_BAR; PG8_MMA(0, 0, At, B0); PG8_MMA(0, 1, At, B1); PG8_BAR; PG8_SCHED;
            PG8_LDA(At, 1, 1); PG8_STAGE(PG8_SB(1, 0), b3, voffB); PG8_STAGE(PG8_SB(1, 1), b3 + hstep, voffB); PG8_STAGE(PG8_SA(1, 0), a3, voffA);
            PG8_WAIT_V(8); PG8_WAIT_L(0); PG8_BAR; PG8_MMA(1, 0, At, B0); PG8_MMA(1, 1, At, B1); PG8_BAR; PG8_SCHED;
            } else {
            PG8_LDB(B0, 0, 0); PG8_SCHED; PG8_LDA(At, 0, 0); PG8_STAGE(PG8_SA(1, 1), a1 + hstep, voffA);
            PG8_WAIT_L(8); PG8_BAR; PG8_WAIT_L(0); PG8_MMA(0, 0, At, B0); PG8_BAR; PG8_SCHED;
            PG8_LDB(B1, 0, 1); PG8_STAGE(PG8_SB(0, 0), b2, voffB);
            PG8_BAR; PG8_WAIT_L(0); PG8_MMA(0, 1, At, B1); PG8_BAR;
            PG8_LDA(At, 0, 1); PG8_STAGE(PG8_SA(0, 0), a2, voffA);
            PG8_BAR; PG8_WAIT_L(0); PG8_MMA(1, 0, At, B0); PG8_BAR; PG8_SCHED;
            PG8_STAGE(PG8_SB(0, 1), b2 + hstep, voffB);
            PG8_WAIT_V(6); PG8_BAR; PG8_MMA(1, 1, At, B1); PG8_BAR;
            PG8_LDB(B0, 1, 0); PG8_SCHED; PG8_LDA(At, 1, 0); PG8_STAGE(PG8_SA(0, 1), a2 + hstep, voffA);
            PG8_WAIT_L(8); PG8_BAR; PG8_WAIT_L(0); PG8_MMA(0, 0, At, B0); PG8_BAR; PG8_SCHED;
            PG8_LDB(B1, 1, 1); PG8_STAGE(PG8_SB(1, 0), b3, voffB);
            PG8_BAR; PG8_WAIT_L(0); PG8_MMA(0, 1, At, B1); PG8_BAR;
            PG8_LDA(At, 1, 1); PG8_STAGE(PG8_SA(1, 0), a3, voffA);
            PG8_BAR; PG8_WAIT_L(0); PG8_MMA(1, 0, At, B0); PG8_BAR; PG8_SCHED;
            PG8_STAGE(PG8_SB(1, 1), b3 + hstep, voffB);
            PG8_WAIT_V(6); PG8_BAR; PG8_MMA(1, 1, At, B1); PG8_BAR;
            }
        }
        if constexpr (ALIGN_EPI) { if (wr == 0) PG8_BAR; }
        if constexpr (!Epi::AFTER_DRAIN) { E(acc, cur, wr, wc, fr, fq); S.done(cur); }
        if (!has_next) break;
#pragma unroll
        for (int a = 0; a < 2; ++a)
#pragma unroll
            for (int b = 0; b < 2; ++b)
#pragma unroll
                for (int m = 0; m < 4; ++m)
#pragma unroll
                    for (int n = 0; n < 2; ++n) acc[a][b][m][n] = (f32x4){0.f, 0.f, 0.f, 0.f};
        cur = nxt; cA = nA; cB = nB; ++ui;
        if constexpr (ALIGN_EPI) { if (wr == 1) PG8_BAR; }
    }
    PG8_WAIT_V(0);
    if constexpr (!ALIGN_EPI) { if (wr == 0) PG8_BAR; }
    PG8_BAR;
    if constexpr (Epi::AFTER_DRAIN) { E.fused(acc, cur, wr, wc, fr, fq, lds, wid, lane); S.done(cur); }
#undef PG8_SA
#undef PG8_SB
#undef PG8_STAGE
#undef PG8_LDA
#undef PG8_LDB
#undef PG8_MMA
#undef PG8_WAIT_V
#undef PG8_WAIT_L
#undef PG8_BAR
#undef PG8_SCHED
}
}

namespace pg8 {
template <class Epi, class Sched, bool ALIGN_EPI>
__device__ __forceinline__ void gemm_phase_gather(PG8_LAS unsigned char* lds, const Gemm g, const PG8_LAS int* tok, const Sched& S, const Epi& E) {
    const int tid = threadIdx.x, wid = __builtin_amdgcn_readfirstlane(tid >> 6), lane = tid & 63, wr = wid >> 2, wc = wid & 3, fr = lane & 15, fq = lane >> 4;
    const int K = g.K, nt = K / BK;
    unsigned voffB[2]; int RA[2], CA[2];
#pragma unroll
    for (int i = 0; i < 2; ++i) { int R, C; stage_rc(tid * 16 + i * 8192, R, C); const int Rb = Epi::PERM ? ((R & ~31) + perm32(R & 31)) : R;
        RA[i] = R; CA[i] = C; voffB[i] = (unsigned)(Rb * K + C) * 2u; }
    const size_t kstep = (size_t)(BK * 2);
    const size_t hstep = (size_t)HALF * K * 2;
    const size_t tstep = 2 * hstep;
    const unsigned ldsw = (unsigned)wid * 1024u;
    const int aoff = lds_byte(wr * 64 + fr, fq * 8), boff = lds_byte(wc * 32 + fr, fq * 8);
#define PG8_SA(b, h) (((b) * 2 + (h)) * HTB)
#define PG8_SB(b, h) ((4 + (b) * 2 + (h)) * HTB)
#define PG8_STAGE(bufoff, gbase, voff) do { _Pragma("unroll") for (int _i = 0; _i < 2; ++_i) \
        __builtin_amdgcn_global_load_lds((const unsigned*)((const char*)(gbase) + (voff)[_i]), (PG8_LAS unsigned*)(lds + (bufoff) + ldsw + _i * 8192), 16, 0, 0); } while (0)
#define PG8_LDA(dst, b, h) do { _Pragma("unroll") for (int m = 0; m < 4; ++m) _Pragma("unroll") for (int k = 0; k < 2; ++k) dst[m][k] = *(const PG8_LAS bf16x8*)(lds + PG8_SA(b, h) + aoff + m * 2048 + k * 1024); } while (0)
#define PG8_LDB(dst, b, h) do { _Pragma("unroll") for (int n = 0; n < 2; ++n) _Pragma("unroll") for (int k = 0; k < 2; ++k) dst[n][k] = *(const PG8_LAS bf16x8*)(lds + PG8_SB(b, h) + boff + n * 2048 + k * 1024); } while (0)
#define PG8_MMA(ai, bj, At, Bt) do { __builtin_amdgcn_s_setprio(1); _Pragma("unroll") for (int m = 0; m < 4; ++m) _Pragma("unroll") for (int n = 0; n < 2; ++n) _Pragma("unroll") for (int k = 0; k < 2; ++k) \
        acc[ai][bj][m][n] = __builtin_amdgcn_mfma_f32_16x16x32_bf16(Bt[n][k], At[m][k], acc[ai][bj][m][n], 0, 0, 0); __builtin_amdgcn_s_setprio(0); } while (0)
#define PG8_WAIT_V(n) asm volatile("s_waitcnt vmcnt(" #n ")" ::: "memory")
#define PG8_WAIT_L(n) asm volatile("s_waitcnt lgkmcnt(" #n ")" ::: "memory")
#define PG8_BAR __builtin_amdgcn_s_barrier()
#define PG8_SCHED __builtin_amdgcn_sched_barrier(0)
#define PG8_GOFF(ui_, o0, o1) do { _Pragma("unroll") for (int _i = 0; _i < 2; ++_i) { \
        o0[_i] = (unsigned)(tok[(ui_) * 256 + RA[_i]] * K + CA[_i]) * 2u; o1[_i] = (unsigned)(tok[(ui_) * 256 + 128 + RA[_i]] * K + CA[_i]) * 2u; } } while (0)
    Unit cur, nxt; int ui = 0;
    if (!S.next(0, cur)) return;
    f32x4 acc[2][2][4][2];
#pragma unroll
    for (int a = 0; a < 2; ++a)
#pragma unroll
        for (int b = 0; b < 2; ++b)
#pragma unroll
            for (int m = 0; m < 4; ++m)
#pragma unroll
                for (int n = 0; n < 2; ++n) acc[a][b][m][n] = (f32x4){0.f, 0.f, 0.f, 0.f};
    bf16x8 At[4][2], B0[2][2], B1[2][2];
    const char* gA = (const char*)g.A; const char* cB = (const char*)g.Bt + (size_t)cur.pn * tstep;
    unsigned c0[2], c1[2], n0[2], n1[2];
    PG8_GOFF(0, c0, c1);
    S.a_ready(cur);
    PG8_STAGE(PG8_SB(0, 0), cB, voffB); PG8_STAGE(PG8_SB(0, 1), cB + hstep, voffB); PG8_STAGE(PG8_SA(0, 0), gA, c0); PG8_STAGE(PG8_SA(0, 1), gA, c1);
    if (wr == 1) PG8_BAR;
    PG8_WAIT_V(2); PG8_BAR;
    PG8_STAGE(PG8_SB(1, 0), cB + kstep, voffB); PG8_STAGE(PG8_SA(1, 0), gA + kstep, c0); PG8_STAGE(PG8_SB(1, 1), cB + hstep + kstep, voffB);
    PG8_WAIT_V(6); PG8_BAR;
    for (;;) {
        const bool has_next = S.next(ui + 1, nxt);
        const char* nB = has_next ? (const char*)g.Bt + (size_t)nxt.pn * tstep : cB;
        if (has_next) { PG8_GOFF(ui + 1, n0, n1); } else { n0[0] = c0[0]; n0[1] = c0[1]; n1[0] = c1[0]; n1[1] = c1[1]; }
        for (int t = 0; t < nt; t += 2) {
            const bool last = (t == nt - 2);
            const char* a1 = gA + (size_t)(t + 1) * kstep;
            const char* a2 = last ? gA : gA + (size_t)(t + 2) * kstep; const char* b2 = last ? nB : cB + (size_t)(t + 2) * kstep;
            const char* a3 = a2 + kstep; const char* b3 = b2 + kstep;
            unsigned s0[2], s1[2];
            s0[0] = last ? n0[0] : c0[0]; s0[1] = last ? n0[1] : c0[1]; s1[0] = last ? n1[0] : c1[0]; s1[1] = last ? n1[1] : c1[1];
            if (last && has_next) S.a_ready(nxt);
            PG8_LDB(B0, 0, 0); PG8_LDB(B1, 0, 1); PG8_SCHED; PG8_LDA(At, 0, 0); PG8_STAGE(PG8_SA(1, 1), a1, c1);
            PG8_WAIT_V(8); PG8_WAIT_L(0); PG8_BAR; PG8_MMA(0, 0, At, B0); PG8_MMA(0, 1, At, B1); PG8_BAR; PG8_SCHED;
            PG8_LDA(At, 0, 1); PG8_STAGE(PG8_SB(0, 0), b2, voffB); PG8_STAGE(PG8_SB(0, 1), b2 + hstep, voffB); PG8_STAGE(PG8_SA(0, 0), a2, s0);
            PG8_WAIT_V(8); PG8_WAIT_L(0); PG8_BAR; PG8_MMA(1, 0, At, B0); PG8_MMA(1, 1, At, B1); PG8_BAR; PG8_SCHED;
            PG8_LDB(B0, 1, 0); PG8_LDB(B1, 1, 1); PG8_SCHED; PG8_LDA(At, 1, 0); PG8_STAGE(PG8_SA(0, 1), a2, s1);
            PG8_WAIT_V(8); PG8_WAIT_L(0); PG8_BAR; PG8_MMA(0, 0, At, B0); PG8_MMA(0, 1, At, B1); PG8_BAR; PG8_SCHED;
            PG8_LDA(At, 1, 1); PG8_STAGE(PG8_SB(1, 0), b3, voffB); PG8_STAGE(PG8_SB(1, 1), b3 + hstep, voffB); PG8_STAGE(PG8_SA(1, 0), a3, s0);
            PG8_WAIT_V(8); PG8_WAIT_L(0); PG8_BAR; PG8_MMA(1, 0, At, B0); PG8_MMA(1, 1, At, B1); PG8_BAR; PG8_SCHED;
        }
        if constexpr (ALIGN_EPI) { if (wr == 0) PG8_BAR; }
        E(acc, cur, wr, wc, fr, fq); S.done(cur);
        if (!has_next) break;
#pragma unroll
        for (int a = 0; a < 2; ++a)
#pragma unroll
            for (int b = 0; b < 2; ++b)
#pragma unroll
                for (int m = 0; m < 4; ++m)
#pragma unroll
                    for (int n = 0; n < 2; ++n) acc[a][b][m][n] = (f32x4){0.f, 0.f, 0.f, 0.f};
        cur = nxt; cB = nB; ++ui; c0[0] = n0[0]; c0[1] = n0[1]; c1[0] = n1[0]; c1[1] = n1[1];
        if constexpr (ALIGN_EPI) { if (wr == 1) PG8_BAR; }
    }
    PG8_WAIT_V(0);
    if constexpr (!ALIGN_EPI) { if (wr == 0) PG8_BAR; }
    PG8_BAR;
#undef PG8_SA
#undef PG8_SB
#undef PG8_STAGE
#undef PG8_LDA
#undef PG8_LDB
#undef PG8_MMA
#undef PG8_WAIT_V
#undef PG8_WAIT_L
#undef PG8_BAR
#undef PG8_SCHED
#undef PG8_GOFF
}
}

__device__ __forceinline__ void transpose_item(const float* W, int ld, int c0, int k0, bf16* WT, int Kd, int r0, LAS float* scr, int lane) {
#pragma unroll 8
    for (int i = 0; i < 32; ++i) { const int kk = 2 * i + (lane >> 5); scr[kk * 33 + (lane & 31)] = W[(size_t)(k0 + kk) * ld + c0 + (lane & 31)]; }
    LDS_WAIT(); asm volatile("" ::: "memory");
    const int c = lane & 7;
#pragma unroll
    for (int j = 0; j < 4; ++j) { const int n = (lane >> 3) + 8 * j; const LAS float* s = scr + (8 * c) * 33 + n;
        v4u o; o.x = pk2(s[0 * 33], s[1 * 33]); o.y = pk2(s[2 * 33], s[3 * 33]); o.z = pk2(s[4 * 33], s[5 * 33]); o.w = pk2(s[6 * 33], s[7 * 33]);
        *(GAS v4u*)(WT + (size_t)(r0 + n) * Kd + k0 + 8 * c) = o; }
    LDS_WAIT(); asm volatile("" ::: "memory");
}
__device__ __forceinline__ int win_src_col(int n32) { const int n = n32 * 32; return n < 2048 ? n : (n < 3584 ? n + 32 : (n < 3616 ? n - 1536 : -1)); }

__device__ __forceinline__ void p0_prologue(const Args& a, LAS unsigned char* lds, int tid, int G, int bid) {
    const int lane = tid & 63, wave = tid >> 6;
    {
        LAS float* scr = (LAS float*)(lds + 32768 + wave * 8704);
        const int gw = bid * NWAVES + wave, NGW = G * NWAVES;
        constexpr int I_IN = (D / 64) * (NIN / 32), I_OUT = (D / 64) * (D / 32);
        for (int it = gw; it < I_IN + I_OUT; it += NGW) {
            if (it < I_IN) { const int kb = it / (NIN / 32), nb = it % (NIN / 32); const int sc = win_src_col(nb);
                if (sc >= 0) transpose_item(a.in[6], INW, sc, kb * 64, a.WinT, D, nb * 32, scr, lane);
                else { for (int j = 0; j < 4; ++j) { const int n = (lane >> 3) + 8 * j; *(GAS v4u*)(a.WinT + (size_t)(nb * 32 + n) * D + kb * 64 + 8 * (lane & 7)) = (v4u){0u, 0u, 0u, 0u}; } }
            } else { const int r = it - I_IN; const int kb = r / (D / 32), nb = r % (D / 32);
                transpose_item(a.in[12], D, nb * 32, kb * 64, a.WoutT, D, nb * 32, scr, lane); }
        }
    }
    if (bid < 6 * D / 32) {
        LAS float* cs = (LAS float*)lds;
        __syncthreads();
        for (int i = tid; i < NB * D; i += NTHR) cs[i] = silu_f(a.in[1][i]);
        __syncthreads();
        const int col = bid * 32 + (tid & 31), ks = tid >> 5;
        float acc[NB];
#pragma unroll
        for (int b = 0; b < NB; ++b) acc[b] = 0.f;
        const float* wp = a.in[2] + (size_t)(ks * 64) * (6 * D) + col;
#pragma unroll 8
        for (int k = 0; k < 64; ++k) { const float w = wp[(size_t)k * (6 * D)];
#pragma unroll
            for (int b = 0; b < NB; ++b) acc[b] += cs[b * D + ks * 64 + k] * w; }
        LAS float* red = (LAS float*)(lds + 32768);
        __syncthreads();
#pragma unroll
        for (int b = 0; b < NB; ++b) red[(ks * NB + b) * 32 + (tid & 31)] = acc[b];
        __syncthreads();
        if (tid < 256) { const int b = tid >> 5, c = tid & 31; float s = 0.f;
#pragma unroll
            for (int k = 0; k < 16; ++k) s += red[(k * NB + b) * 32 + c];
            a.ada[b * 6 * D + bid * 32 + c] = s + a.in[3][bid * 32 + c]; }
        __syncthreads();
    }
}

__device__ __forceinline__ void p1_rows(const Args& a, int tid, int G, int bid) {
    const int lane = tid & 63, wave = tid >> 6;
    const int gw = bid * NWAVES + wave, NGW = G * NWAVES;
    const float* g = a.in[4];
    for (int t = gw; t < T; t += NGW) {
        const int b = t / S;
        const GAS f32x4* xr = (const GAS f32x4*)(a.in[0] + (size_t)t * D) + lane;
        f32x4 v[4]; float ss = 0.f;
#pragma unroll
        for (int j = 0; j < 4; ++j) { v[j] = xr[64 * j]; ss += (v[j].x * v[j].x + v[j].y * v[j].y) + (v[j].z * v[j].z + v[j].w * v[j].w); }
        const float rstd = rsqrtf(wave_sum(ss) * (1.f / D) + EPS);
        GAS v2u* o8 = (GAS v2u*)(a.H + (size_t)t * D) + lane;
        const float* sh = a.ada + b * 6 * D, *sc = sh + D;
#pragma unroll
        for (int j = 0; j < 4; ++j) { const int k = 4 * lane + 256 * j;
            const f32x4 gg = *(const f32x4*)(g + k), s1 = *(const f32x4*)(sc + k), h1 = *(const f32x4*)(sh + k);
            const float o0 = v[j].x * rstd * gg.x * (1.f + s1.x) + h1.x, o1 = v[j].y * rstd * gg.y * (1.f + s1.y) + h1.y;
            const float o2 = v[j].z * rstd * gg.z * (1.f + s1.z) + h1.z, o3 = v[j].w * rstd * gg.w * (1.f + s1.w) + h1.w;
            o8[64 * j] = (v2u){pk2(o0, o1), pk2(o2, o3)}; }
    }
}

struct EpiG1 {
    static constexpr bool PERM = true, AFTER_DRAIN = false;
    bf16* qkv; bf16* z; bf16* naq; bf16* nak; bf16* navt; float* gates;
    __device__ __forceinline__ void operator()(const pg8::f32x4 (&acc)[2][2][4][2], const pg8::Unit& u, int wr, int wc, int fr, int fq) const {
        const int row0 = u.pm * 256 + wr * 64 + fr, pn = u.pn;
        if (pn < 12) {
            bf16* base; int ldc, colt;
            if (pn < 6) { base = qkv; ldc = 1536; colt = pn * 256; }
            else if (pn < 8) { base = z; ldc = 512; colt = (pn - 6) * 256; }
            else if (pn < 10) { base = naq; ldc = 512; colt = (pn - 8) * 256; }
            else { base = nak; ldc = 512; colt = (pn - 10) * 256; }
            const int col0 = colt + wc * 32 + 8 * fq;
#pragma unroll
            for (int ai = 0; ai < 2; ++ai)
#pragma unroll
                for (int m = 0; m < 4; ++m) { bf16* rowp = base + (size_t)(row0 + ai * 128 + m * 16) * ldc + col0;
#pragma unroll
                    for (int bj = 0; bj < 2; ++bj) { const pg8::f32x4 v0 = acc[ai][bj][m][0], v1 = acc[ai][bj][m][1];
                        v4u w; w.x = pg8::cvt_pk_bf16(v0[0], v0[1]); w.y = pg8::cvt_pk_bf16(v0[2], v0[3]); w.z = pg8::cvt_pk_bf16(v1[0], v1[1]); w.w = pg8::cvt_pk_bf16(v1[2], v1[3]);
                        *(v4u*)(rowp + bj * 128) = w; } }
        } else if (pn < 14) {
#pragma unroll
            for (int ai = 0; ai < 2; ++ai)
#pragma unroll
                for (int m = 0; m < 4; ++m) { const int t = row0 + ai * 128 + m * 16, b = t >> 11, s = t & 2047;
#pragma unroll
                    for (int bj = 0; bj < 2; ++bj)
#pragma unroll
                        for (int n = 0; n < 2; ++n)
#pragma unroll
                            for (int r = 0; r < 4; ++r) { const int c = (pn - 12) * 256 + bj * 128 + wc * 32 + 8 * fq + 4 * n + r;
                                navt[((size_t)(b * 8 + (c >> 6)) * 64 + (c & 63)) * S + s] = (bf16)f2bf(acc[ai][bj][m][n][r]); } }
        } else {
            if (wc == 0) {
#pragma unroll
                for (int ai = 0; ai < 2; ++ai)
#pragma unroll
                    for (int m = 0; m < 4; ++m) { float* gp = gates + (size_t)(row0 + ai * 128 + m * 16) * 32 + 8 * fq;
                        *(pg8::f32x4*)gp = acc[ai][0][m][0]; *(pg8::f32x4*)(gp + 4) = acc[ai][0][m][1]; }
            }
        }
    }
};

__device__ __forceinline__ void p3_na(const Args& a, LAS unsigned char* lds, int tid, int G, int bid) {
    LAS float* tab = (LAS float*)(lds + 256);
    for (int i = tid; i < 8 * 465 + 128; i += NTHR) tab[i - 64] = (i >= 64 && i < 8 * 465 + 64) ? a.in[11][i - 64] : 0.f;
    __syncthreads();
    const int lane = tid & 63, wave = tid >> 6, q = lane & 15, g = lane >> 4;
    const int gw = bid * NWAVES + wave, NGW = G * NWAVES;
    const int pi0 = 8 * (q >> 2) + (q & 3);
    for (int item = gw; item < NB * NH * ROWS * 4; item += NGW) {
        const int j = item & 3, r = (item >> 2) & 31, h = (item >> 7) & 7, b = item >> 10;
        int r0 = r - 4; r0 = r0 < 0 ? 0 : (r0 > ROWS - 8 ? ROWS - 8 : r0);
        const int start = j == 0 ? 0 : (j == 1 ? 8 : (j == 2 ? 24 : 32));
        const int c = 16 * j + q; int c0 = c - 8; c0 = c0 < 0 ? 0 : (c0 > GW - 16 ? GW - 16 : c0);
        const size_t tq = (size_t)b * S + r * GW + c;
        const bf16* qp = a.NAQ + tq * 512 + h * 64 + 8 * g;
        const bf16x8 qf0 = *(const bf16x8*)qp, qf1 = *(const bf16x8*)(qp + 32);
        f32x4 sc[8][2];
#pragma unroll
        for (int kr = 0; kr < 8; ++kr) {
            const size_t kt0 = (size_t)b * S + (r0 + kr) * GW + start;
            const bf16* kp0 = a.NAK + (kt0 + pi0) * 512 + h * 64 + 8 * g;
            const bf16* kp1 = kp0 + 4 * 512;
            const bf16x8 k00 = *(const bf16x8*)kp0, k01 = *(const bf16x8*)(kp0 + 32), k10 = *(const bf16x8*)kp1, k11 = *(const bf16x8*)(kp1 + 32);
            f32x4 s0 = {0.f, 0.f, 0.f, 0.f}, s1 = {0.f, 0.f, 0.f, 0.f};
            s0 = __builtin_amdgcn_mfma_f32_16x16x32_bf16(k00, qf0, s0, 0, 0, 0); s0 = __builtin_amdgcn_mfma_f32_16x16x32_bf16(k01, qf1, s0, 0, 0, 0);
            s1 = __builtin_amdgcn_mfma_f32_16x16x32_bf16(k10, qf0, s1, 0, 0, 0); s1 = __builtin_amdgcn_mfma_f32_16x16x32_bf16(k11, qf1, s1, 0, 0, 0);
            sc[kr][0] = s0; sc[kr][1] = s1;
        }
        float m = -1e30f;
#pragma unroll
        for (int kr = 0; kr < 8; ++kr) {
            const LAS float* bp = tab + (h * 15 + (r0 + kr - r + 7)) * 31 + (start + 8 * g - c + 15);
#pragma unroll
            for (int jj = 0; jj < 8; ++jj) { const int kc = start + 8 * g + jj; const bool ok = (kc >= c0) && (kc < c0 + 16);
                const float v = ok ? sc[kr][jj >> 2][jj & 3] * 0.125f + bp[jj] : -1e30f;
                sc[kr][jj >> 2][jj & 3] = v; m = fmaxf(m, v); }
        }
        m = fmaxf(m, __shfl_xor(m, 16)); m = fmaxf(m, __shfl_xor(m, 32));
        float l = 0.f;
        bf16x8 pf[8];
#pragma unroll
        for (int kr = 0; kr < 8; ++kr) {
            float p[8];
#pragma unroll
            for (int jj = 0; jj < 8; ++jj) { const float v = sc[kr][jj >> 2][jj & 3]; p[jj] = v > -1e29f ? __expf(v - m) : 0.f; l += p[jj]; }
            v4u w; w.x = pk2(p[0], p[1]); w.y = pk2(p[2], p[3]); w.z = pk2(p[4], p[5]); w.w = pk2(p[6], p[7]);
            pf[kr] = __builtin_bit_cast(bf16x8, w);
        }
        l += __shfl_xor(l, 16); l += __shfl_xor(l, 32);
        f32x4 o[4];
#pragma unroll
        for (int dt = 0; dt < 4; ++dt) o[dt] = (f32x4){0.f, 0.f, 0.f, 0.f};
        const bf16* vbase = a.NAVT + ((size_t)(b * 8 + h) * 64 + q) * S + start + 8 * g;
#pragma unroll
        for (int kr = 0; kr < 8; ++kr) {
#pragma unroll
            for (int dt = 0; dt < 4; ++dt) { const bf16x8 vf = *(const bf16x8*)(vbase + (size_t)(16 * dt) * S + (r0 + kr) * GW);
                o[dt] = __builtin_amdgcn_mfma_f32_16x16x32_bf16(vf, pf[kr], o[dt], 0, 0, 0); }
        }
        const float inv = 1.f / l;
        bf16* op = a.MIX + tq * D + 512 + h * 64 + 4 * g;
#pragma unroll
        for (int dt = 0; dt < 4; ++dt) *(v2u*)(op + 16 * dt) = (v2u){pk2(o[dt][0] * inv, o[dt][1] * inv), pk2(o[dt][2] * inv, o[dt][3] * inv)};
    }
}

typedef float f32x2_t __attribute__((ext_vector_type(2))); typedef __bf16 bf16x2_t __attribute__((ext_vector_type(2)));
__device__ __forceinline__ unsigned cvtpk(float lo, float hi) { f32x2_t v = {lo, hi}; bf16x2_t b = __builtin_convertvector(v, bf16x2_t); return __builtin_bit_cast(unsigned, b); }
__device__ __forceinline__ int crow(int reg, int hh) { return (reg & 3) + 8 * (reg >> 2) + 4 * hh; }
#define MFMA32(a, b, c) __builtin_amdgcn_mfma_f32_32x32x16_bf16((a), (b), (c), 0, 0, 0)
__device__ __forceinline__ bf16x8 pack8(const f32x16& x, int s) {
    v4u p; p.x = cvtpk(x[8 * s], x[8 * s + 1]); p.y = cvtpk(x[8 * s + 2], x[8 * s + 3]); p.z = cvtpk(x[8 * s + 4], x[8 * s + 5]); p.w = cvtpk(x[8 * s + 6], x[8 * s + 7]);
    return __builtin_bit_cast(bf16x8, p);
}
constexpr int IMG = 72;
constexpr int L_KB = 0, L_QB = 9216, L_VB = 18432, L_KT = 27648, L_UT = 36864, L_WT = 46080, L_M = 55296, L_G = 71680, L_DIR = 73728;
constexpr int PREP_REC = 32768;

__device__ __forceinline__ bf16x8 frag_nat(const LAS bf16* img, int row, int ks, int hh) { return *(const LAS bf16x8*)(img + row * IMG + 16 * ks + 8 * hh); }
__device__ __forceinline__ bf16x8 frag_kap(const LAS bf16* img, int row, int base, int s, int hh) {
    const v2u lo = *(const LAS v2u*)(img + row * IMG + base + 16 * s + 4 * hh), hi = *(const LAS v2u*)(img + row * IMG + base + 16 * s + 8 + 4 * hh);
    return __builtin_bit_cast(bf16x8, (v4u){lo.x, lo.y, hi.x, hi.y});
}

typedef float f32x2v __attribute__((ext_vector_type(2)));
__device__ __forceinline__ void pkfnma(f32x2v& acc, f32x2v m, f32x2v xx) { asm("v_pk_fma_f32 %0, %1, %2, %0 op_sel_hi:[0,1,1] neg_lo:[1,0,0] neg_hi:[1,0,0]" : "+v"(acc) : "v"(xx), "v"(m)); }
__device__ __forceinline__ float fnma(float acc, float m, float x) { asm("v_fma_f32 %0, -%1, %2, %0" : "+v"(acc) : "v"(m), "v"(x)); return acc; }
__device__ __forceinline__ void dn_solve(const LAS float* MT, const LAS bf16* rhs_img, const LAS float* rscale, LAS bf16* out_img, int lane) {
    f32x2v acc[32];
#pragma unroll
    for (int k = 0; k < 32; ++k) { acc[k].x = rscale[2 * k] * bf2f(rhs_img[(2 * k) * IMG + lane]); acc[k].y = rscale[2 * k + 1] * bf2f(rhs_img[(2 * k + 1) * IMG + lane]); }
    f32x4 mc[16], mn[16];
#pragma unroll
    for (int i4 = 0; i4 < 16; ++i4) mc[i4] = *(const LAS f32x4*)(MT + 4 * i4);
#pragma unroll
    for (int j = 0; j < 63; ++j) {
        if (j + 1 < 63) {
#pragma unroll
            for (int i4 = (j + 2) / 4; i4 < 16; ++i4) mn[i4] = *(const LAS f32x4*)(MT + (j + 1) * 64 + 4 * i4);
        }
        __builtin_amdgcn_sched_barrier(0);
        const float xj = (j & 1) ? acc[j >> 1].y : acc[j >> 1].x;
        const f32x2v xx = {xj, xj};
#pragma unroll
        for (int i4 = (j + 1) / 4; i4 < 16; ++i4) {
            const f32x4 m = mc[i4];
            if (4 * i4 > j) pkfnma(acc[2 * i4], (f32x2v){m.x, m.y}, xx);
            else if (4 * i4 + 1 > j) acc[2 * i4].y = fnma(acc[2 * i4].y, m.y, xj);
            if (4 * i4 + 2 > j) pkfnma(acc[2 * i4 + 1], (f32x2v){m.z, m.w}, xx);
            else if (4 * i4 + 3 > j) acc[2 * i4 + 1].y = fnma(acc[2 * i4 + 1].y, m.w, xj);
        }
        __builtin_amdgcn_sched_barrier(0);
#pragma unroll
        for (int i4 = 0; i4 < 16; ++i4) mc[i4] = mn[i4];
    }
#pragma unroll
    for (int i8 = 0; i8 < 8; ++i8) {
        v4u w; w.x = cvtpk(acc[4 * i8].x, acc[4 * i8].y); w.y = cvtpk(acc[4 * i8 + 1].x, acc[4 * i8 + 1].y); w.z = cvtpk(acc[4 * i8 + 2].x, acc[4 * i8 + 2].y); w.w = cvtpk(acc[4 * i8 + 3].x, acc[4 * i8 + 3].y);
        *(LAS v4u*)(out_img + lane * IMG + 8 * i8) = w;
    }
}

__device__ __forceinline__ void p3_dnprep(const Args& a, LAS unsigned char* lds, int tid, int G, int bid) {
    const float* wconv = a.in[7];
    for (int item = bid; item < NB * NH * 32; item += G) {
        int tid_ = tid; asm volatile("" : "+v"(tid_));
        const int lane = tid_ & 63, wave = tid_ >> 6, dir = wave & 1, w4 = wave >> 1;
        const int col = lane & 31, hh = lane >> 5;
        LAS unsigned char* ld = lds + dir * L_DIR;
        LAS bf16* KB = (LAS bf16*)(ld + L_KB); LAS bf16* QB = (LAS bf16*)(ld + L_QB); LAS bf16* VB = (LAS bf16*)(ld + L_VB); LAS bf16* KT = (LAS bf16*)(ld + L_KT);
        LAS bf16* UT = (LAS bf16*)(ld + L_UT); LAS bf16* WT = (LAS bf16*)(ld + L_WT); LAS float* M = (LAS float*)(ld + L_M); LAS float* GT = (LAS float*)(ld + L_G);
        const int chunk = item & 31, h = (item >> 5) & 7, b = item >> 8;
        const int tok0 = b * S + 64 * chunk;
        __syncthreads();
        if (wave < 2) {
            const int p = dir ? 63 - lane : lane;
            const float* gp = a.GATES + (size_t)(tok0 + p) * 32;
            const float av = gp[dir * 8 + h], bv = gp[16 + dir * 8 + h];
            const float g = -__expf(a.in[8][dir * 8 + h]) * softplus_f(av + a.in[9][dir * 8 + h]);
            const float beta = sigmoid_f(bv);
            float v = g;
#pragma unroll
            for (int o = 1; o < 64; o <<= 1) { const float u = __shfl_up(v, o); if (lane >= o) v += u; }
            const float gl = __shfl(v, 63);
            const float e = __expf(v);
            GT[lane] = beta; GT[64 + lane] = v; GT[128 + lane] = e; GT[192 + lane] = __expf(gl - v); GT[256 + lane] = beta * e;
            if (lane == 0) GT[320] = __expf(gl);
        }
        __syncthreads();
        {
            const int p = tid_ >> 3, d0 = 8 * (tid_ & 7);
            const int s = 64 * chunk + p;
#pragma unroll
            for (int mat = 0; mat < 3; ++mat) {
                float acc[8];
#pragma unroll
                for (int e = 0; e < 8; ++e) acc[e] = 0.f;
                const int cbase = mat * 512 + h * 64 + d0;
#pragma unroll
                for (int tap = 0; tap < 5; ++tap) {
                    const int ss = s + tap - 2;
                    if (ss >= 0 && ss < S) {
                        const v4u raw = *(const v4u*)(a.QKV + (size_t)(b * S + ss) * 1536 + cbase);
                        const f32x4 w0 = *(const f32x4*)(wconv + tap * 1536 + cbase), w1 = *(const f32x4*)(wconv + tap * 1536 + cbase + 4);
                        acc[0] += w0.x * bflo(raw.x); acc[1] += w0.y * bfhi(raw.x); acc[2] += w0.z * bflo(raw.y); acc[3] += w0.w * bfhi(raw.y);
                        acc[4] += w1.x * bflo(raw.z); acc[5] += w1.y * bfhi(raw.z); acc[6] += w1.z * bflo(raw.w); acc[7] += w1.w * bfhi(raw.w);
                    }
                }
                float ss2 = 0.f;
#pragma unroll
                for (int e = 0; e < 8; ++e) { acc[e] = silu_f(acc[e]); ss2 += acc[e] * acc[e]; }
                if (mat < 2) {
                    ss2 += __shfl_xor(ss2, 1); ss2 += __shfl_xor(ss2, 2); ss2 += __shfl_xor(ss2, 4);
                    const float sc = rsqrtf(ss2 + EPS);
#pragma unroll
                    for (int e = 0; e < 8; ++e) acc[e] *= sc;
                }
                const v4u w = (v4u){cvtpk(acc[0], acc[1]), cvtpk(acc[2], acc[3]), cvtpk(acc[4], acc[5]), cvtpk(acc[6], acc[7])};
                const int off = mat == 0 ? L_QB : (mat == 1 ? L_KB : L_VB);
                *(LAS v4u*)((LAS bf16*)(lds + off) + p * IMG + d0) = w;
                *(LAS v4u*)((LAS bf16*)(lds + L_DIR + off) + (63 - p) * IMG + d0) = w;
                if (mat == 1) {
                    const float e0 = ((LAS float*)(lds + L_G))[192 + p], e1 = ((LAS float*)(lds + L_DIR + L_G))[192 + 63 - p];
                    LAS bf16* kt0 = (LAS bf16*)(lds + L_KT); LAS bf16* kt1 = (LAS bf16*)(lds + L_DIR + L_KT);
#pragma unroll
                    for (int e = 0; e < 8; ++e) { const float kv = bf2f((unsigned short)(e & 1 ? (w[e >> 1] >> 16) : (w[e >> 1] & 0xffffu)));
                        kt0[(d0 + e) * IMG + p] = (bf16)f2bf(kv * e0); kt1[(d0 + e) * IMG + 63 - p] = (bf16)f2bf(kv * e1); }
                }
            }
        }
        __syncthreads();
        if (w4 < 3) {
            const int bi = w4 == 0 ? 0 : 1, bj = w4 == 2 ? 1 : 0;
            f32x16 acc;
#pragma unroll
            for (int r = 0; r < 16; ++r) acc[r] = 0.f;
#pragma unroll
            for (int ks = 0; ks < 4; ++ks) acc = MFMA32(frag_nat(KB, 32 * bi + col, ks, hh), frag_nat(KB, 32 * bj + col, ks, hh), acc);
            const int j = 32 * bj + col; const float gcj = GT[64 + j];
#pragma unroll
            for (int r4 = 0; r4 < 4; ++r4) { const int i0 = 32 * bi + 8 * r4 + 4 * hh; f32x4 mv;
#pragma unroll
                for (int k = 0; k < 4; ++k) { const int i = i0 + k; mv[k] = (i > j) ? GT[i] * acc[4 * r4 + k] * __expf(GT[64 + i] - gcj) : 0.f; }
                *(LAS f32x4*)(M + j * 64 + i0) = mv; }
        }
        __syncthreads();
        if (w4 < 2) dn_solve(M, w4 == 0 ? VB : KB, w4 == 0 ? GT : GT + 256, w4 == 0 ? UT : WT, lane);
        __syncthreads();
        {
            const int I = w4 >> 1, c = w4 & 1;
            unsigned char* rec = (unsigned char*)a.PREP + ((size_t)((b * 8 + h) * 2 + dir) * 32 + chunk) * PREP_REC;
            bf16x8 Xf[2][2];
            const int i_tok = 32 * I + col; const float gci = GT[64 + i_tok];
#pragma unroll
            for (int J = 0; J < 2; ++J) {
                if (J <= I) {
                    f32x16 acc;
#pragma unroll
                    for (int r = 0; r < 16; ++r) acc[r] = 0.f;
#pragma unroll
                    for (int ks = 0; ks < 4; ++ks) acc = MFMA32(frag_nat(KB, 32 * J + col, ks, hh), frag_nat(QB, 32 * I + col, ks, hh), acc);
#pragma unroll
                    for (int r = 0; r < 16; ++r) { const int j = 32 * J + crow(r, hh); acc[r] = (j <= i_tok) ? acc[r] * 0.125f * __expf(gci - GT[64 + j]) : 0.f; }
                    Xf[J][0] = pack8(acc, 0); Xf[J][1] = pack8(acc, 1);
                }
            }
            {
                f32x16 acc;
#pragma unroll
                for (int r = 0; r < 16; ++r) acc[r] = 0.f;
#pragma unroll
                for (int J = 0; J < 2; ++J) if (J <= I) {
#pragma unroll
                    for (int s = 0; s < 2; ++s) acc = MFMA32(Xf[J][s], frag_kap(UT, 32 * c + col, 32 * J, s, hh), acc); }
                v4u* dst = (v4u*)(rec + 24576 + (I * 2 + c) * 2048 + lane * 32);
                dst[0] = (v4u){cvtpk(acc[0], acc[1]), cvtpk(acc[2], acc[3]), cvtpk(acc[4], acc[5]), cvtpk(acc[6], acc[7])};
                dst[1] = (v4u){cvtpk(acc[8], acc[9]), cvtpk(acc[10], acc[11]), cvtpk(acc[12], acc[13]), cvtpk(acc[14], acc[15])};
            }
            {
                f32x16 acc;
#pragma unroll
                for (int r = 0; r < 16; ++r) acc[r] = 0.f;
#pragma unroll
                for (int J = 0; J < 2; ++J) if (J <= I) {
#pragma unroll
                    for (int s = 0; s < 2; ++s) acc = MFMA32(frag_kap(WT, 32 * c + col, 32 * J, s, hh), Xf[J][s], acc); }
                const float ei = GT[128 + i_tok] * 0.125f;
#pragma unroll
                for (int r4 = 0; r4 < 4; ++r4) { const v2u qv = *(const LAS v2u*)(QB + i_tok * IMG + 32 * c + 8 * r4 + 4 * hh);
                    acc[4 * r4 + 0] = ei * bflo(qv.x) - acc[4 * r4 + 0]; acc[4 * r4 + 1] = ei * bfhi(qv.x) - acc[4 * r4 + 1];
                    acc[4 * r4 + 2] = ei * bflo(qv.y) - acc[4 * r4 + 2]; acc[4 * r4 + 3] = ei * bfhi(qv.y) - acc[4 * r4 + 3]; }
                *(bf16x8*)(rec + ((I * 2 + c) * 2 + 0) * 1024 + lane * 16) = pack8(acc, 0);
                *(bf16x8*)(rec + ((I * 2 + c) * 2 + 1) * 1024 + lane * 16) = pack8(acc, 1);
            }
            {
                f32x16 acc;
#pragma unroll
                for (int r = 0; r < 16; ++r) acc[r] = 0.f;
#pragma unroll
                for (int ks = 0; ks < 4; ++ks) acc = MFMA32(frag_nat(WT, 32 * I + col, ks, hh), frag_nat(KT, 32 * c + col, ks, hh), acc);
                const float egl = GT[320];
#pragma unroll
                for (int r = 0; r < 16; ++r) acc[r] = ((32 * I + crow(r, hh)) == (32 * c + col) ? egl : 0.f) - acc[r];
                *(bf16x8*)(rec + 8192 + ((c * 2 + I) * 2 + 0) * 1024 + lane * 16) = pack8(acc, 0);
                *(bf16x8*)(rec + 8192 + ((c * 2 + I) * 2 + 1) * 1024 + lane * 16) = pack8(acc, 1);
            }
            {
                f32x16 acc;
#pragma unroll
                for (int r = 0; r < 16; ++r) acc[r] = 0.f;
#pragma unroll
                for (int ks = 0; ks < 4; ++ks) acc = MFMA32(frag_nat(KT, 32 * I + col, ks, hh), frag_nat(UT, 32 * c + col, ks, hh), acc);
                v4u* dst = (v4u*)(rec + 16384 + (I * 2 + c) * 2048 + lane * 32);
                dst[0] = (v4u){cvtpk(acc[0], acc[1]), cvtpk(acc[2], acc[3]), cvtpk(acc[4], acc[5]), cvtpk(acc[6], acc[7])};
                dst[1] = (v4u){cvtpk(acc[8], acc[9]), cvtpk(acc[10], acc[11]), cvtpk(acc[12], acc[13]), cvtpk(acc[14], acc[15])};
            }
        }
    }
}

__device__ __forceinline__ void p4_scan_wave(const Args& a, int id, int lane) {
    const int DV = id & 1, dir = (id >> 1) & 1, h = (id >> 2) & 7, b = id >> 5;
    const int col = lane & 31, hh = lane >> 5;
    f32x16 S0, S1;
#pragma unroll
    for (int r = 0; r < 16; ++r) { S0[r] = 0.f; S1[r] = 0.f; }
    const unsigned char* chain = (const unsigned char*)a.PREP + (size_t)((b * 8 + h) * 2 + dir) * 32 * PREP_REC;
    for (int st = 0; st < 32; ++st) {
        const int chunk = dir ? 31 - st : st;
        const unsigned char* rec = chain + (size_t)chunk * PREP_REC;
        bf16x8 Sb[2][2];
        Sb[0][0] = pack8(S0, 0); Sb[0][1] = pack8(S0, 1); Sb[1][0] = pack8(S1, 0); Sb[1][1] = pack8(S1, 1);
        f32x16 o[2], n[2];
#pragma unroll
        for (int I = 0; I < 2; ++I) {
            const v4u* src = (const v4u*)(rec + 24576 + (I * 2 + DV) * 2048 + lane * 32);
            const v4u c0 = src[0], c1 = src[1];
            o[I][0] = bflo(c0.x); o[I][1] = bfhi(c0.x); o[I][2] = bflo(c0.y); o[I][3] = bfhi(c0.y); o[I][4] = bflo(c0.z); o[I][5] = bfhi(c0.z); o[I][6] = bflo(c0.w); o[I][7] = bfhi(c0.w);
            o[I][8] = bflo(c1.x); o[I][9] = bfhi(c1.x); o[I][10] = bflo(c1.y); o[I][11] = bfhi(c1.y); o[I][12] = bflo(c1.z); o[I][13] = bfhi(c1.z); o[I][14] = bflo(c1.w); o[I][15] = bfhi(c1.w);
#pragma unroll
            for (int DK = 0; DK < 2; ++DK)
#pragma unroll
                for (int s = 0; s < 2; ++s) o[I] = MFMA32(*(const bf16x8*)(rec + ((I * 2 + DK) * 2 + s) * 1024 + lane * 16), Sb[DK][s], o[I]);
        }
#pragma unroll
        for (int DKp = 0; DKp < 2; ++DKp) {
            const v4u* src = (const v4u*)(rec + 16384 + (DKp * 2 + DV) * 2048 + lane * 32);
            const v4u c0 = src[0], c1 = src[1];
            n[DKp][0] = bflo(c0.x); n[DKp][1] = bfhi(c0.x); n[DKp][2] = bflo(c0.y); n[DKp][3] = bfhi(c0.y); n[DKp][4] = bflo(c0.z); n[DKp][5] = bfhi(c0.z); n[DKp][6] = bflo(c0.w); n[DKp][7] = bfhi(c0.w);
            n[DKp][8] = bflo(c1.x); n[DKp][9] = bfhi(c1.x); n[DKp][10] = bflo(c1.y); n[DKp][11] = bfhi(c1.y); n[DKp][12] = bflo(c1.z); n[DKp][13] = bfhi(c1.z); n[DKp][14] = bflo(c1.w); n[DKp][15] = bfhi(c1.w);
#pragma unroll
            for (int DK = 0; DK < 2; ++DK)
#pragma unroll
                for (int s = 0; s < 2; ++s) n[DKp] = MFMA32(*(const bf16x8*)(rec + 8192 + ((DKp * 2 + DK) * 2 + s) * 1024 + lane * 16), Sb[DK][s], n[DKp]);
        }
        S0 = n[0]; S1 = n[1];
        bf16* ofb = (bf16*)a.Y + ((size_t)dir * T + (size_t)b * S + 64 * chunk) * 512 + h * 64 + 32 * DV + col;
#pragma unroll
        for (int I = 0; I < 2; ++I)
#pragma unroll
            for (int r = 0; r < 16; ++r) { const int nn = 32 * I + crow(r, hh); const int p = dir ? 63 - nn : nn; ofb[(size_t)p * 512] = (bf16)f2bf(o[I][r]); }
    }
}

__device__ __forceinline__ void p4b_dnout(const Args& a, int tid, int G, int bid) {
    const int lane = tid & 63, wave = tid >> 6;
    const bf16* ofb = (const bf16*)a.Y;
    const float gon = a.in[10][lane];
    for (int w = bid * NWAVES + wave; w < T * 8; w += G * NWAVES) {
        const int t = w >> 3, h = w & 7;
        const float x = bf2f(ofb[(size_t)t * 512 + h * 64 + lane]) + bf2f(ofb[((size_t)T + t) * 512 + h * 64 + lane]);
        const float ss = wave_sum(x * x);
        const float z = bf2f(a.Z[(size_t)t * 512 + h * 64 + lane]);
        a.MIX[(size_t)t * D + h * 64 + lane] = (bf16)f2bf(x * rsqrtf(ss * (1.f / 64.f) + EPS) * gon * silu_f(z));
    }
}

struct EpiF32 {
    static constexpr bool PERM = false, AFTER_DRAIN = false;
    float* C; int ldc;
    __device__ __forceinline__ void operator()(const pg8::f32x4 (&acc)[2][2][4][2], const pg8::Unit& u, int wr, int wc, int fr, int fq) const {
        const int row0 = u.pm * 256 + wr * 64 + fr, col0 = u.pn * 256 + wc * 32 + 4 * fq;
#pragma unroll
        for (int ai = 0; ai < 2; ++ai)
#pragma unroll
            for (int m = 0; m < 4; ++m) { float* rowp = C + (size_t)(row0 + ai * 128 + m * 16) * ldc + col0;
#pragma unroll
                for (int bj = 0; bj < 2; ++bj)
#pragma unroll
                    for (int n = 0; n < 2; ++n) *(pg8::f32x4*)(rowp + bj * 128 + n * 16) = acc[ai][bj][m][n]; }
    }
};

constexpr int WRS = 1028;
__device__ __forceinline__ void p7_mid(const Args& a, LAS unsigned char* lds, int tid, int G, int bid) {
    LAS float* WT = (LAS float*)lds;
    LAS float* LG = (LAS float*)(lds + 36 * WRS * 4);
    const float* wg = a.in[15]; const float* we = a.in[17];
    for (int e = tid; e < D * 4; e += NTHR) WT[(e & 3) * WRS + (e >> 2)] = wg[e];
    for (int e = tid; e < D * 32; e += NTHR) WT[(4 + (e & 31)) * WRS + (e >> 5)] = we[e];
    __syncthreads();
    const int lane = tid & 63, wave = tid >> 6;
    const float* gpost = a.in[5]; const float* gpre = a.in[13];
    for (int t = bid * NWAVES + wave; t < T; t += G * NWAVES) {
        const int b = t / S;
        const float* ad = a.ada + b * 6 * D;
        const GAS f32x4* yr = (const GAS f32x4*)(a.Y + (size_t)t * D) + lane;
        const GAS f32x4* xr = (const GAS f32x4*)(a.in[0] + (size_t)t * D) + lane;
        f32x4 yv[4], xv[4]; float ss = 0.f;
#pragma unroll
        for (int j = 0; j < 4; ++j) { yv[j] = yr[64 * j]; xv[j] = xr[64 * j]; ss += (yv[j].x * yv[j].x + yv[j].y * yv[j].y) + (yv[j].z * yv[j].z + yv[j].w * yv[j].w); }
        const float rstd = rsqrtf(wave_sum(ss) * (1.f / D) + EPS);
        float s2 = 0.f;
#pragma unroll
        for (int j = 0; j < 4; ++j) { const int k = 4 * lane + 256 * j;
            const f32x4 gp = *(const f32x4*)(gpost + k), gt = *(const f32x4*)(ad + 2 * D + k);
            xv[j].x += gt.x * (yv[j].x * rstd * gp.x); xv[j].y += gt.y * (yv[j].y * rstd * gp.y); xv[j].z += gt.z * (yv[j].z * rstd * gp.z); xv[j].w += gt.w * (yv[j].w * rstd * gp.w);
            s2 += (xv[j].x * xv[j].x + xv[j].y * xv[j].y) + (xv[j].z * xv[j].z + xv[j].w * xv[j].w);
            ((GAS f32x4*)(a.X1 + (size_t)t * D) + lane)[64 * j] = xv[j]; }
        const float rstd2 = rsqrtf(wave_sum(s2) * (1.f / D) + EPS);
        GAS v2u* h8 = (GAS v2u*)(a.H2 + (size_t)t * D) + lane;
#pragma unroll
        for (int j = 0; j < 4; ++j) { const int k = 4 * lane + 256 * j;
            const f32x4 gp = *(const f32x4*)(gpre + k), sc = *(const f32x4*)(ad + 4 * D + k), sh = *(const f32x4*)(ad + 3 * D + k);
            xv[j].x = xv[j].x * rstd2 * gp.x * (1.f + sc.x) + sh.x; xv[j].y = xv[j].y * rstd2 * gp.y * (1.f + sc.y) + sh.y;
            xv[j].z = xv[j].z * rstd2 * gp.z * (1.f + sc.z) + sh.z; xv[j].w = xv[j].w * rstd2 * gp.w * (1.f + sc.w) + sh.w;
            h8[64 * j] = (v2u){cvtpk(xv[j].x, xv[j].y), cvtpk(xv[j].z, xv[j].w)}; }
        float mylogit = 0.f;
#pragma unroll 4
        for (int o = 0; o < 36; ++o) {
            float p = 0.f;
#pragma unroll
            for (int j = 0; j < 4; ++j) { const f32x4 w = *(const LAS f32x4*)(WT + o * WRS + 4 * lane + 256 * j);
                p += (xv[j].x * w.x + xv[j].y * w.y) + (xv[j].z * w.z + xv[j].w * w.w); }
            p = wave_sum(p);
            if (lane == o) mylogit = p;
        }
        if (lane < 36) LG[wave * 40 + lane] = mylogit + (lane < 4 ? a.in[16][lane] : a.in[18][lane - 4]);
        asm volatile("s_waitcnt lgkmcnt(0)" ::: "memory");
        if (lane == 0) {
            const LAS float* lg = LG + wave * 40;
            int g = 0; float gm = lg[0];
            for (int j = 1; j < 4; ++j) if (lg[j] > gm) { gm = lg[j]; g = j; }
            float gs = 0.f; for (int j = 0; j < 4; ++j) gs += __expf(lg[j] - gm);
            const float gpv = 1.f / gs;
            const LAS float* el = lg + 4 + g * 8;
            int i1 = 0; float l1 = el[0];
            for (int j = 1; j < 8; ++j) if (el[j] > l1) { l1 = el[j]; i1 = j; }
            int i2 = -1; float l2 = -1e30f;
            for (int j = 0; j < 8; ++j) if (j != i1 && el[j] > l2) { l2 = el[j]; i2 = j; }
            const float p2 = __expf(l2 - l1);
            const float w1 = gpv / (1.f + p2), w2 = gpv * p2 / (1.f + p2);
            const int e1 = g * 8 + i1, e2 = g * 8 + i2;
            a.tok_e[t * 2] = e1; a.tok_e[t * 2 + 1] = e2; a.tok_w[t * 2] = w1; a.tok_w[t * 2 + 1] = w2;
            const int q1 = atomicAdd(&a.cnt[e1], 1), q2 = atomicAdd(&a.cnt[e2], 1);
            a.tok_pos[t * 2] = q1; a.tok_pos[t * 2 + 1] = q2;
            a.perm[(size_t)e1 * 2 * T + q1] = 2 * t; a.perm[(size_t)e2 * 2 * T + q2] = 2 * t + 1;
        }
    }
}

__device__ __forceinline__ void p4_moe_weights(const Args& a, LAS float* scr, int widx, int nw, int lane) {
    for (int it = widx; it < 24576; it += nw) {
        if (it < 16384) { const int e = it >> 9, src = (it >> 8) & 1, kb = (it >> 4) & 15, nb = it & 15, n0 = nb * 32;
            transpose_item((src ? a.in[20] : a.in[19]) + (size_t)e * D * DE, DE, n0, kb * 64, a.WguT + (size_t)e * 1024 * 1024, 1024, 256 * (n0 >> 7) + 128 * src + (n0 & 127), scr, lane);
        } else { const int r = it - 16384, e = r >> 8, kb = (r >> 5) & 7, nb = r & 31;
            transpose_item(a.in[21] + (size_t)e * DE * D, D, nb * 32, kb * 64, a.WdT + (size_t)e * 1024 * 512, 512, nb * 32, scr, lane); }
    }
}

constexpr int MOE_TB_OFF = RING_BYTES, MOE_TOK_OFF = RING_BYTES + 2048;
struct MoeOrder {
    const LAS int* TB; int lo, hi, j;
    __device__ __forceinline__ void init(const LAS int* tb, int G, int bid) { TB = tb; const int NU = tb[0] * 4, x = bid & 7; lo = (x * NU) >> 3; hi = ((x + 1) * NU) >> 3; j = bid >> 3; (void)G; }
    __device__ __forceinline__ bool next(int i, pg8::Unit& u) const { const int L = lo + i * 32 + j; if (L >= hi) return false; const int rt = L >> 2; u.pm = rt; u.pn = TB[4 + rt] * 4 + (L & 3); return true; }
    __device__ __forceinline__ void a_ready(const pg8::Unit&) const {}
    __device__ __forceinline__ void done(const pg8::Unit&) const {}
};
__device__ __forceinline__ void moe_setup(const Args& a, LAS unsigned char* lds, int tid, int G, int bid, bool need_tok) {
    LAS int* TB = (LAS int*)(lds + MOE_TB_OFF); LAS int* TOK = (LAS int*)(lds + MOE_TOK_OFF);
    __syncthreads();
    if (tid < NE) { int start = 0; for (int q = 0; q < tid; ++q) start += (a.cnt[q] + 255) >> 8; const int n = (a.cnt[tid] + 255) >> 8;
        for (int i = 0; i < n; ++i) { TB[4 + start + i] = tid; TB[164 + start + i] = i; }
        if (tid == NE - 1) TB[0] = start + n; }
    __syncthreads();
    if (need_tok) {
        MoeOrder O; O.init(TB, G, bid);
        for (int ui = 0; ui < 3; ++ui) { pg8::Unit u; if (!O.next(ui, u)) break;
            if (tid < 256) { const int e = u.pn >> 2, idx = 256 * TB[164 + u.pm] + tid; int pr = -1; if (idx < a.cnt[e]) pr = a.perm[(size_t)e * 2 * T + idx];
                TOK[ui * 256 + tid] = pr < 0 ? 0 : (pr >> 1); } }
        __syncthreads();
    }
}
struct EpiSwiglu {
    static constexpr bool PERM = true, AFTER_DRAIN = false;
    bf16* HE;
    __device__ __forceinline__ void operator()(const pg8::f32x4 (&acc)[2][2][4][2], const pg8::Unit& u, int wr, int wc, int fr, int fq) const {
        const int row0 = u.pm * 256 + wr * 64 + fr, col0 = (u.pn & 3) * 128 + wc * 32 + 8 * fq;
#pragma unroll
        for (int ai = 0; ai < 2; ++ai)
#pragma unroll
            for (int m = 0; m < 4; ++m) { bf16* rowp = HE + (size_t)(row0 + ai * 128 + m * 16) * DE + col0;
                const pg8::f32x4 g0 = acc[ai][0][m][0], g1 = acc[ai][0][m][1], u0 = acc[ai][1][m][0], u1 = acc[ai][1][m][1];
                v4u w; w.x = cvtpk(silu_f(g0[0]) * u0[0], silu_f(g0[1]) * u0[1]); w.y = cvtpk(silu_f(g0[2]) * u0[2], silu_f(g0[3]) * u0[3]);
                w.z = cvtpk(silu_f(g1[0]) * u1[0], silu_f(g1[1]) * u1[1]); w.w = cvtpk(silu_f(g1[2]) * u1[2], silu_f(g1[3]) * u1[3]);
                *(v4u*)rowp = w; }
    }
};
struct EpiScatter {
    static constexpr bool PERM = true, AFTER_DRAIN = false;
    bf16* Y2S; const int* perm; const float* tokw; const int* cnt; const LAS int* TB;
    __device__ __forceinline__ void operator()(const pg8::f32x4 (&acc)[2][2][4][2], const pg8::Unit& u, int wr, int wc, int fr, int fq) const {
        const int e = u.pn >> 2, lt = TB[164 + u.pm], ce = cnt[e];
        const int col0 = (u.pn & 3) * 256 + wc * 32 + 8 * fq;
#pragma unroll
        for (int ai = 0; ai < 2; ++ai)
#pragma unroll
            for (int m = 0; m < 4; ++m) { const int idx = 256 * lt + ai * 128 + wr * 64 + m * 16 + fr;
                if (idx < ce) { const int pr = perm[(size_t)e * 2 * T + idx]; const float w = tokw[pr];
                    bf16* rowp = Y2S + ((size_t)(pr & 1) * T + (pr >> 1)) * D + col0;
#pragma unroll
                    for (int bj = 0; bj < 2; ++bj) { const pg8::f32x4 v0 = acc[ai][bj][m][0], v1 = acc[ai][bj][m][1];
                        *(v4u*)(rowp + bj * 128) = (v4u){cvtpk(w * v0[0], w * v0[1]), cvtpk(w * v0[2], w * v0[3]), cvtpk(w * v1[0], w * v1[1]), cvtpk(w * v1[2], w * v1[3])}; } } }
    }
};
__device__ __forceinline__ void p10_final(const Args& a, int tid, int G, int bid) {
    const int lane = tid & 63, wave = tid >> 6;
    const float* gpost = a.in[14];
    for (int t = bid * NWAVES + wave; t < T; t += G * NWAVES) {
        const float* ad = a.ada + (t / S) * 6 * D + 5 * D;
        const GAS v2u* ya = (const GAS v2u*)(a.Y2S + (size_t)t * D) + lane; const GAS v2u* yb = (const GAS v2u*)(a.Y2S + ((size_t)T + t) * D) + lane;
        f32x4 yv[4]; float ss = 0.f;
#pragma unroll
        for (int j = 0; j < 4; ++j) { const v2u p = ya[64 * j], q = yb[64 * j];
            yv[j].x = bflo(p.x) + bflo(q.x); yv[j].y = bfhi(p.x) + bfhi(q.x); yv[j].z = bflo(p.y) + bflo(q.y); yv[j].w = bfhi(p.y) + bfhi(q.y);
            ss += (yv[j].x * yv[j].x + yv[j].y * yv[j].y) + (yv[j].z * yv[j].z + yv[j].w * yv[j].w); }
        const float rstd = rsqrtf(wave_sum(ss) * (1.f / D) + EPS);
        GAS f32x4* xo = (GAS f32x4*)(a.out + (size_t)t * D) + lane;
#pragma unroll
        for (int j = 0; j < 4; ++j) { const int k = 4 * lane + 256 * j; const f32x4 gp = *(const f32x4*)(gpost + k), gt = *(const f32x4*)(ad + k); f32x4 x = xo[64 * j];
            x.x += gt.x * (yv[j].x * rstd * gp.x); x.y += gt.y * (yv[j].y * rstd * gp.y); x.z += gt.z * (yv[j].z * rstd * gp.z); x.w += gt.w * (yv[j].w * rstd * gp.w);
            xo[64 * j] = x; }
    }
}

__global__ void __launch_bounds__(NTHR, 2) mega(Args args) {
    extern __shared__ __attribute__((aligned(16))) unsigned char lds_raw[];
    LAS unsigned char* lds = (LAS unsigned char*)lds_raw;
    const int tid = threadIdx.x, G = gridDim.x, bid = blockIdx.x;
    const int lo = args.ph_lo, hi = args.ph_hi;
#define IN(k) (lo <= (k) && (k) < hi)
    if (IN(0)) { p0_prologue(args, lds, tid, G, bid); }
    if (IN(1)) { p1_rows(args, tid, G, bid); }
    if (IN(2)) {
        pg8::Gemm g{args.H, args.WinT, T, NIN, D}; pg8::StaticOrder So; So.init(T, NIN, G, bid);
        EpiG1 E{args.QKV, args.Z, args.NAQ, args.NAK, args.NAVT, args.GATES};
        pg8::gemm_phase<EpiG1, pg8::StaticOrder, true, true>(lds, g, So, E);
    }
    if (IN(3)) { p3_dnprep(args, lds, tid, G, bid); __syncthreads(); p3_na(args, lds, tid, G, bid); }
    if (IN(4)) {
        if ((tid >> 6) == 0) { for (int id = bid; id < 256; id += G) p4_scan_wave(args, id, tid & 63); }
        else p4_moe_weights(args, (LAS float*)(lds + (tid >> 6) * 8704), bid * 7 + (tid >> 6) - 1, G * 7, tid & 63);
    }
    if (IN(5)) { p4b_dnout(args, tid, G, bid); }
    if (IN(6)) {
        pg8::Gemm g{args.MIX, args.WoutT, T, D, D}; pg8::StaticOrder So; So.init(T, D, G, bid);
        EpiF32 E{args.Y, D};
        pg8::gemm_phase<EpiF32, pg8::StaticOrder, true, true>(lds, g, So, E);
    }
    if (IN(7)) { p7_mid(args, lds, tid, G, bid); }
    if (IN(8)) {
        moe_setup(args, lds, tid, G, bid, true);
        pg8::Gemm g{args.H2, args.WguT, 0, 0, D}; MoeOrder Mo; Mo.init((const LAS int*)(lds + MOE_TB_OFF), G, bid);
        EpiSwiglu E{args.HE};
        pg8::gemm_phase_gather<EpiSwiglu, MoeOrder, true>(lds, g, (const LAS int*)(lds + MOE_TOK_OFF), Mo, E);
    }
    if (IN(9)) {
        moe_setup(args, lds, tid, G, bid, false);
        pg8::Gemm g{args.HE, args.WdT, 0, 0, DE}; MoeOrder Mo; Mo.init((const LAS int*)(lds + MOE_TB_OFF), G, bid);
        EpiScatter E{args.Y2S, args.perm, args.tok_w, args.cnt, (const LAS int*)(lds + MOE_TB_OFF)};
        pg8::gemm_phase<EpiScatter, MoeOrder, true, true>(lds, g, Mo, E);
    }
    if (IN(10)) { p10_final(args, tid, G, bid); }
#undef IN
}

static void fill_args(Args& a, void* const* d_in, void* d_out, void* d_ws) {
    const size_t MiB = 1u << 20; unsigned char* ws = (unsigned char*)d_ws;
    for (int i = 0; i < 22; ++i) a.in[i] = (const float*)d_in[i];
    a.out = (float*)d_out; a.ws = ws;
    a.bar = (unsigned*)(ws + 4096); a.cnt = (int*)ws;
    a.ada = (float*)(ws + 1 * MiB); a.tok_w = (float*)(ws + 1 * MiB + 256 * 1024); a.tok_e = (int*)(ws + 1 * MiB + 384 * 1024); a.tok_pos = (int*)(ws + 1 * MiB + 512 * 1024);
    a.WinT = (bf16*)(ws + 2 * MiB); a.WoutT = (bf16*)(ws + 10 * MiB);
    a.H = (bf16*)(ws + 12 * MiB); a.PREP = (bf16*)(ws + 12 * MiB); a.HE = (bf16*)(ws + 12 * MiB); a.Y2S = (bf16*)(ws + 52 * MiB);
    a.QKV = (bf16*)(ws + 140 * MiB); a.NAQ = (bf16*)(ws + 188 * MiB); a.NAK = (bf16*)(ws + 204 * MiB); a.NAVT = (bf16*)(ws + 220 * MiB);
    a.WguT = (bf16*)(ws + 140 * MiB); a.WdT = (bf16*)(ws + 204 * MiB);
    a.Z = (bf16*)(ws + 236 * MiB); a.GATES = (float*)(ws + 252 * MiB); a.MIX = (bf16*)(ws + 254 * MiB); a.H2 = (bf16*)(ws + 236 * MiB);
    a.perm = (int*)(ws + 286 * MiB);
    a.Y = (float*)d_out; a.X1 = (float*)d_out;
}
extern "C" void kernel_launch(void* const* d_in, const int* in_sizes, int n_in, void* d_out, int out_size, void* d_ws, size_t ws_size, hipStream_t stream) {
    const size_t MiB = 1u << 20;
    if (ws_size < (size_t)290 * MiB) { fprintf(stderr, "kernel_launch: workspace too small: %zu\n", ws_size); return; }
    static int attr_done = 0;
    if (!attr_done) { (void)hipFuncSetAttribute((const void*)mega, hipFuncAttributeMaxDynamicSharedMemorySize, LDS_BYTES); attr_done = 1; }
    (void)hipMemsetAsync(d_ws, 0, 1 * MiB, stream);
    Args a{};
    fill_args(a, d_in, d_out, d_ws);
    for (int ph = 0; ph < 11; ++ph) { a.ph_lo = ph; a.ph_hi = ph + 1; hipLaunchKernelGGL(mega, dim3(256), dim3(NTHR), LDS_BYTES, stream, a); }
}
```

```cpp
#include <hip/hip_runtime.h>
#include <cstdio>
#include <cstdint>
#include <utility>

constexpr int D = 1024, NB = 8, S = 2048, T = NB * S;
constexpr int HD = 64, NH = 8, DNW = 512, NAW = 512;
constexpr int INW = 3616;
constexpr int GW = 64, ROWS = S / GW;
constexpr int NE = 32, DE = 512;
constexpr float EPS = 1e-6f;
constexpr int SEGPAD = 256;
constexpr int MAXROWS = 2 * T + NE * SEGPAD;

constexpr int C_Q = 0, C_K = 512, C_V = 1024, C_Z = 1536, C_AF = 2048, C_AB = 2056, C_BF = 2064, C_BB = 2072, C_NQ = 2080, C_NK = 2592, C_NV = 3104;

__device__ __forceinline__ float silu_f(float x) { return x / (1.f + __expf(-x)); }
__device__ __forceinline__ float sigmoid_f(float x) { return 1.f / (1.f + __expf(-x)); }
__device__ __forceinline__ float softplus_f(float x) { return x > 20.f ? x : log1pf(__expf(x)); }

__device__ __forceinline__ float wave_sum(float v) {
#pragma unroll
    for (int o = 1; o < 64; o <<= 1) v += __shfl_xor(v, o);
    return v;
}
__device__ __forceinline__ float block_sum256(float v, float* red) {
    v = wave_sum(v);
    __syncthreads();
    if ((threadIdx.x & 63) == 0) red[threadIdx.x >> 6] = v;
    __syncthreads();
    return red[0] + red[1] + red[2] + red[3];
}


#include <hip/hip_cooperative_groups.h>
#define GAS __attribute__((address_space(1)))
#define LAS __attribute__((address_space(3)))
typedef unsigned short bf16;
typedef unsigned v4u __attribute__((ext_vector_type(4)));
typedef unsigned v2u __attribute__((ext_vector_type(2)));
typedef float f32x4 __attribute__((ext_vector_type(4)));
typedef float f32x16 __attribute__((ext_vector_type(16)));
typedef short bf16x8 __attribute__((ext_vector_type(8)));
typedef short bf16x4 __attribute__((ext_vector_type(4)));
#define LDS_WAIT() asm volatile("s_waitcnt lgkmcnt(0)" ::: "memory")
#define VM_WAIT() asm volatile("s_waitcnt vmcnt(0)" ::: "memory")
__device__ __forceinline__ unsigned f2bf(float f) { unsigned u = __builtin_bit_cast(unsigned, f); return (u + 0x7fffu + ((u >> 16) & 1u)) >> 16; }
__device__ __forceinline__ unsigned pk2(float lo, float hi) { return f2bf(lo) | (f2bf(hi) << 16); }
__device__ __forceinline__ float bf2f(unsigned short b) { return __builtin_bit_cast(float, (unsigned)b << 16); }
__device__ __forceinline__ float bflo(unsigned w) { return __builtin_bit_cast(float, w << 16); }
__device__ __forceinline__ float bfhi(unsigned w) { return __builtin_bit_cast(float, w & 0xffff0000u); }

constexpr int NWAVES = 8, NTHR = 512;
constexpr int NIN = 3840;
constexpr int RING_BYTES = 131072;
constexpr int LDS_BYTES = 163840;

struct Args {
    const float* in[22]; float* out; unsigned char* ws;
    float* ada; unsigned* bar;
    bf16* WinT; bf16* WoutT; bf16* WguT; bf16* WdT; bf16* WrT;
    bf16* H; bf16* QKV; bf16* Z; bf16* NAQ; bf16* NAK; bf16* NAVT; float* GATES;
    bf16* PREP; bf16* MIX; float* Y; bf16* YB; float* X1; bf16* H2; bf16* HE; bf16* Y2S;
    int* cnt; int* tok_e; float* tok_w; int* tok_pos; int* perm;
    int ph_lo, ph_hi;
};

template <int CTRL, int RMASK> __device__ __forceinline__ float dppf(float v) { return __builtin_bit_cast(float, __builtin_amdgcn_update_dpp(0, __builtin_bit_cast(int, v), CTRL, RMASK, 0xF, false)); }
__device__ __forceinline__ float wave_sum_hi(float v) {
    v += dppf<0xB1, 0xF>(v); v += dppf<0x4E, 0xF>(v); v += dppf<0x141, 0xF>(v); v += dppf<0x140, 0xF>(v);
    v += dppf<0x142, 0xA>(v); v += dppf<0x143, 0xC>(v);
    return v;
}

#define XB_TMO      128
#define XB_XCNT(j)  (256  + 64 * (j))
#define XB_XSUB(j)  (1280 + 64 * (j))
#define XB_XGEN(j)  (2304 + 64 * (j))
#define XB_TOP      3328
#define XB_TOPGEN   3392
#define XCD_BAR_WORDS 3456
#define XB_SPIN_CAP (1u << 18)

__device__ __forceinline__ unsigned xb_ld(unsigned* p)              { return __hip_atomic_load(p, __ATOMIC_RELAXED, __HIP_MEMORY_SCOPE_AGENT); }
__device__ __forceinline__ unsigned xb_add(unsigned* p, unsigned v) { return __hip_atomic_fetch_add(p, v, __ATOMIC_RELAXED, __HIP_MEMORY_SCOPE_AGENT); }
__device__ __forceinline__ unsigned xb_xcc_id() { return (unsigned)__builtin_amdgcn_s_getreg((3 << 11) | 20) & 0xFu; }
#define XB_SPIN(cond, bar) do { unsigned _sp = 0; while (cond) { __builtin_amdgcn_s_sleep(1); \
    if ((++_sp & 255u) == 0u) { if (xb_ld(&(bar)[XB_TMO])) break; if (_sp > XB_SPIN_CAP) { atomicAdd(&(bar)[XB_TMO], 1u); break; } } } } while (0)

struct XcdBarrier {
    unsigned* bar; unsigned x;
    volatile LAS unsigned* st;
};

__device__ __forceinline__ XcdBarrier xcd_barrier_post(unsigned* bar, volatile LAS unsigned* st) {
    XcdBarrier b; b.bar = bar; b.x = xb_xcc_id(); b.st = st;
    if (threadIdx.x == 0) (void)xb_add(&bar[XB_XCNT(b.x)], 1u);
    return b;
}
__device__ __forceinline__ void xcd_barrier_complete(unsigned* bar, unsigned x, unsigned& nloc, unsigned& nx) {
    const unsigned G = gridDim.x * gridDim.y * gridDim.z;
    unsigned sum, cnt, mine, sp = 0u;
    for (;;) {
        sum = 0u; cnt = 0u; mine = 0u;
#pragma unroll
        for (unsigned j = 0; j < 16; ++j) { const unsigned c = xb_ld(&bar[XB_XCNT(j)]); sum += c; cnt += (c > 0u) ? 1u : 0u; mine = (j == x) ? c : mine; }
        if (sum == G) break;
        __builtin_amdgcn_s_sleep(1);
        if ((++sp & 255u) == 0u) { if (xb_ld(&bar[XB_TMO])) break; if (sp > XB_SPIN_CAP) { atomicAdd(&bar[XB_TMO], 1u); break; } }
    }
    nloc = mine > 0u ? mine : 1u; nx = cnt > 0u ? cnt : 1u;
}

__device__ __forceinline__ void xcd_barrier(const XcdBarrier& b) {
    asm volatile("s_waitcnt vmcnt(0)" ::: "memory");
    __syncthreads();
    if (threadIdx.x == 0) {
        unsigned* bar = b.bar;
        __builtin_amdgcn_s_waitcnt(0);
        unsigned nloc = b.st[0], nx = b.st[1];
        if (nloc == 0u) { xcd_barrier_complete(bar, b.x, nloc, nx); b.st[0] = nloc; b.st[1] = nx; }
        const unsigned old = xb_add(&bar[XB_XSUB(b.x)], 1u);
        const unsigned gen = old / nloc;
        if (old + 1u == (gen + 1u) * nloc) {
            __builtin_amdgcn_fence(__ATOMIC_RELEASE, "agent");
            asm volatile("s_waitcnt vmcnt(0)" ::: "memory");
            const unsigned og = xb_add(&bar[XB_TOP], 1u);
            const unsigned tg = og / nx;
            if (og + 1u == (tg + 1u) * nx) xb_add(&bar[XB_TOPGEN], 1u);
            else XB_SPIN(xb_ld(&bar[XB_TOPGEN]) == tg, bar);
            __builtin_amdgcn_fence(__ATOMIC_ACQUIRE, "agent");
            xb_add(&bar[XB_XGEN(b.x)], 1u);
            asm volatile("s_waitcnt vmcnt(0)" ::: "memory");
        } else {
            XB_SPIN(xb_ld(&bar[XB_XGEN(b.x)]) == gen, bar);
            __builtin_amdgcn_fence(__ATOMIC_ACQUIRE, "agent");
            asm volatile("s_waitcnt vmcnt(0)" ::: "memory");
        }
    }
    __syncthreads();
}

namespace pg8 {
#define PG8_LAS __attribute__((address_space(3)))
typedef unsigned short bf16_t;
typedef short bf16x8 __attribute__((ext_vector_type(8)));
typedef float f32x4 __attribute__((ext_vector_type(4)));
typedef unsigned u32x4 __attribute__((ext_vector_type(4)));
constexpr int BM = 256, BK = 64, HALF = 128, HTB = HALF * BK * 2  , STAGE_BYTES = 8 * HTB, NXCD = 8, WGM = 8;

__host__ __device__ __forceinline__ int lds_byte(int r, int c) { const int st = (r >> 4) * 2 + (c >> 5), rr = r & 15, cc = c & 31, ob = rr * 64 + cc * 2; return st * 1024 + (ob ^ (((ob >> 9) & 1) << 5)); }
__host__ __device__ __forceinline__ void stage_rc(int b, int& R, int& C) { const int st = b / 1024, sb = b % 1024, swz = sb ^ (((sb >> 9) & 1) << 5); R = (st >> 1) * 16 + swz / 64; C = (st & 1) * 32 + (swz % 64) / 2; }
__host__ __device__ __forceinline__ int perm32(int rho) { const int n = rho >> 4, i = rho & 15; return 8 * (i >> 2) + 4 * n + (i & 3); }

struct Unit { int pm, pn; };
struct Gemm { const bf16_t* A; const bf16_t* Bt; int M, N, K; };

struct StaticOrder {
    int nM, nN, nwg, G, c;
    __host__ __device__ void init(int M, int N, int G_, int c_) { nM = M / BM; nN = N / BM; nwg = nM * nN; G = G_; c = c_; }
    __host__ __device__ bool next(int i, Unit& u) const {
        const long L = (long)i * G + c; if (L >= nwg) return false;
        int wgid = (int)L; { const int q = nwg / NXCD, r = nwg % NXCD, xcd = wgid % NXCD, off = wgid / NXCD; wgid = (xcd < r ? xcd * (q + 1) : r * (q + 1) + (xcd - r) * q) + off; }
        const int nig = WGM * nN, gid = wgid / nig, fm = gid * WGM, gsz = (nM - fm) < WGM ? (nM - fm) : WGM;
        u.pm = fm + ((wgid % nig) % gsz); u.pn = (wgid % nig) / gsz; return true;
    }
    __device__ __forceinline__ void a_ready(const Unit&) const {}
    __device__ __forceinline__ void done(const Unit&) const {}
};


__device__ __forceinline__ unsigned cvt_pk_bf16(float lo, float hi) { unsigned r; asm volatile("v_cvt_pk_bf16_f32 %0, %1, %2" : "=v"(r) : "v"(lo), "v"(hi)); return r; }

template <class Epi, class Sched, bool ALIGN_EPI = false, bool SP2 = false>
__device__ __forceinline__ void gemm_phase(PG8_LAS unsigned char* lds, const Gemm g, const Sched& S, const Epi& E) {
    const int tid = threadIdx.x, wid = __builtin_amdgcn_readfirstlane(tid >> 6), lane = tid & 63, wr = wid >> 2, wc = wid & 3, fr = lane & 15, fq = lane >> 4;
    const int K = g.K, nt = K / BK;
    unsigned voffA[2], voffB[2];
#pragma unroll
    for (int i = 0; i < 2; ++i) { int R, C; stage_rc(tid * 16 + i * 8192, R, C); const int Rb = Epi::PERM ? ((R & ~31) + perm32(R & 31)) : R;
        voffA[i] = (unsigned)(R * K + C) * 2u; voffB[i] = (unsigned)(Rb * K + C) * 2u; }
    const size_t kstep = (size_t)(BK * 2);
    const size_t hstep = (size_t)HALF * K * 2;
    const size_t tstep = 2 * hstep;
    const unsigned ldsw = (unsigned)wid * 1024u;
    const int aoff = lds_byte(wr * 64 + fr, fq * 8), boff = lds_byte(wc * 32 + fr, fq * 8);
#define PG8_SA(b, h) (((b) * 2 + (h)) * HTB)
#define PG8_SB(b, h) ((4 + (b) * 2 + (h)) * HTB)
#define PG8_STAGE(bufoff, gbase, voff) do { _Pragma("unroll") for (int _i = 0; _i < 2; ++_i) \
        __builtin_amdgcn_global_load_lds((const unsigned*)((const char*)(gbase) + (voff)[_i]), (PG8_LAS unsigned*)(lds + (bufoff) + ldsw + _i * 8192), 16, 0, 0); } while (0)
#define PG8_LDA(dst, b, h) do { _Pragma("unroll") for (int m = 0; m < 4; ++m) _Pragma("unroll") for (int k = 0; k < 2; ++k) dst[m][k] = *(const PG8_LAS bf16x8*)(lds + PG8_SA(b, h) + aoff + m * 2048 + k * 1024); } while (0)
#define PG8_LDB(dst, b, h) do { _Pragma("unroll") for (int n = 0; n < 2; ++n) _Pragma("unroll") for (int k = 0; k < 2; ++k) dst[n][k] = *(const PG8_LAS bf16x8*)(lds + PG8_SB(b, h) + boff + n * 2048 + k * 1024); } while (0)
#define PG8_MMA(ai, bj, At, Bt) do { __builtin_amdgcn_s_setprio(1); _Pragma("unroll") for (int m = 0; m < 4; ++m) _Pragma("unroll") for (int n = 0; n < 2; ++n) _Pragma("unroll") for (int k = 0; k < 2; ++k) \
        acc[ai][bj][m][n] = __builtin_amdgcn_mfma_f32_16x16x32_bf16(Bt[n][k], At[m][k], acc[ai][bj][m][n], 0, 0, 0); __builtin_amdgcn_s_setprio(0); } while (0)
#define PG8_WAIT_V(n) asm volatile("s_waitcnt vmcnt(" #n ")" ::: "memory")
#define PG8_WAIT_L(n) asm volatile("s_waitcnt lgkmcnt(" #n ")" ::: "memory")
#define PG8_BAR __builtin_amdgcn_s_barrier()
#define PG8_SCHED __builtin_amdgcn_sched_barrier(0)
    Unit cur, nxt; int ui = 0;
    if (!S.next(0, cur)) return;
    f32x4 acc[2][2][4][2];
#pragma unroll
    for (int a = 0; a < 2; ++a)
#pragma unroll
        for (int b = 0; b < 2; ++b)
#pragma unroll
            for (int m = 0; m < 4; ++m)
#pragma unroll
                for (int n = 0; n < 2; ++n) acc[a][b][m][n] = (f32x4){0.f, 0.f, 0.f, 0.f};
    bf16x8 At[4][2], B0[2][2], B1[2][2];
    const char* cA = (const char*)g.A + (size_t)cur.pm * tstep; const char* cB = (const char*)g.Bt + (size_t)cur.pn * tstep;
    S.a_ready(cur);
    if constexpr (SP2) {
        PG8_STAGE(PG8_SB(0, 0), cB, voffB); PG8_STAGE(PG8_SB(0, 1), cB + hstep, voffB); PG8_STAGE(PG8_SA(0, 0), cA, voffA); PG8_STAGE(PG8_SA(0, 1), cA + hstep, voffA);
        if (wr == 1) PG8_BAR;
        PG8_WAIT_V(2); PG8_BAR;
        PG8_STAGE(PG8_SB(1, 0), cB + kstep, voffB); PG8_STAGE(PG8_SA(1, 0), cA + kstep, voffA); PG8_STAGE(PG8_SB(1, 1), cB + hstep + kstep, voffB);
        PG8_WAIT_V(6); PG8_BAR;
    } else {
        PG8_STAGE(PG8_SB(0, 0), cB, voffB); PG8_STAGE(PG8_SA(0, 0), cA, voffA); PG8_STAGE(PG8_SB(0, 1), cB + hstep, voffB); PG8_STAGE(PG8_SA(0, 1), cA + hstep, voffA);
        if (wr == 1) PG8_BAR;
        PG8_WAIT_V(4); PG8_BAR;
        PG8_STAGE(PG8_SB(1, 0), cB + kstep, voffB); PG8_STAGE(PG8_SA(1, 0), cA + kstep, voffA); PG8_STAGE(PG8_SB(1, 1), cB + hstep + kstep, voffB);
        PG8_WAIT_V(6); PG8_BAR;
    }
    for (;;) {
        const bool has_next = S.next(ui + 1, nxt);
        const char* nA = has_next ? (const char*)g.A + (size_t)nxt.pm * tstep : cA; const char* nB = has_next ? (const char*)g.Bt + (size_t)nxt.pn * tstep : cB;
        for (int t = 0; t < nt; t += 2) {
            const bool last = (t == nt - 2);
            const char* a1 = cA + (size_t)(t + 1) * kstep;
            const char* a2 = last ? nA : cA + (size_t)(t + 2) * kstep; const char* b2 = last ? nB : cB + (size_t)(t + 2) * kstep;
            const char* a3 = a2 + kstep; const char* b3 = b2 + kstep;
            if (last && has_next) S.a_ready(nxt);
            if constexpr (SP2) {
            PG8_LDB(B0, 0, 0); PG8_LDB(B1, 0, 1); PG8_SCHED; PG8_LDA(At, 0, 0); PG8_STAGE(PG8_SA(1, 1), a1 + hstep, voffA);
            PG8_WAIT_V(8); PG8_WAIT_L(0); PG8_BAR; PG8_MMA(0, 0, At, B0); PG8_MMA(0, 1, At, B1); PG8_BAR; PG8_SCHED;
            PG8_LDA(At, 0, 1); PG8_STAGE(PG8_SB(0, 0), b2, voffB); PG8_STAGE(PG8_SB(0, 1), b2 + hstep, voffB); PG8_STAGE(PG8_SA(0, 0), a2, voffA);
            PG8_WAIT_V(8); PG8_WAIT_L(0); PG8_BAR; PG8_MMA(1, 0, At, B0); PG8_MMA(1, 1, At, B1); PG8_BAR; PG8_SCHED;
            PG8_LDB(B0, 1, 0); PG8_LDB(B1, 1, 1); PG8_SCHED; PG8_LDA(At, 1, 0); PG8_STAGE(PG8_SA(0, 1), a2 + hstep, voffA);
            PG8_WAIT_V(8); PG8_WAIT_L(0); PG8_BAR; PG8_MMA(0, 0, At, B0); PG8_MMA(0, 1, At, B1); PG8_BAR; PG8_SCHED;
            PG8_LDA(At, 1, 1); PG8_STAGE(PG8_SB(1, 0), b3, voffB); PG8_STAGE(PG8_SB(1, 1), b3 + hstep, voffB); PG8_STAGE(PG8_SA(1, 0), a3, voffA);
            PG8_WAIT_V(8); PG8_WAIT_L(0); PG8_BAR; PG8_MMA(1, 0, At, B0); PG8_MMA(1, 1, At, B1); PG8_BAR; PG8_SCHED;
            } else {
            PG8_LDB(B0, 0, 0); PG8_SCHED; PG8_LDA(At, 0, 0); PG8_STAGE(PG8_SA(1, 1), a1 + hstep, voffA);
            PG8_WAIT_L(8); PG8_BAR; PG8_WAIT_L(0); PG8_MMA(0, 0, At, B0); PG8_BAR; PG8_SCHED;
            PG8_LDB(B1, 0, 1); PG8_STAGE(PG8_SB(0, 0), b2, voffB);
            PG8_BAR; PG8_WAIT_L(0); PG8_MMA(0, 1, At, B1); PG8_BAR;
            PG8_LDA(At, 0, 1); PG8_STAGE(PG8_SA(0, 0), a2, voffA);
            PG8_BAR; PG8_WAIT_L(0); PG8_MMA(1, 0, At, B0); PG8_BAR; PG8_SCHED;
            PG8_STAGE(PG8_SB(0, 1), b2 + hstep, voffB);
            PG8_WAIT_V(6); PG8_BAR; PG8_MMA(1, 1, At, B1); PG8_BAR;
            PG8_LDB(B0, 1, 0); PG8_SCHED; PG8_LDA(At, 1, 0); PG8_STAGE(PG8_SA(0, 1), a2 + hstep, voffA);
            PG8_WAIT_L(8); PG8_BAR; PG8_WAIT_L(0); PG8_MMA(0, 0, At, B0); PG8_BAR; PG8_SCHED;
            PG8_LDB(B1, 1, 1); PG8_STAGE(PG8_SB(1, 0), b3, voffB);
            PG8_BAR; PG8_WAIT_L(0); PG8_MMA(0, 1, At, B1); PG8_BAR;
            PG8_LDA(At, 1, 1); PG8_STAGE(PG8_SA(1, 0), a3, voffA);
            PG8_BAR; PG8_WAIT_L(0); PG8_MMA(1, 0, At, B0); PG8_BAR; PG8_SCHED;
            PG8_STAGE(PG8_SB(1, 1), b3 + hstep, voffB);
            PG8_WAIT_V(6); PG8_BAR; PG8_MMA(1, 1, At, B1); PG8_BAR;
            }
        }
        if constexpr (ALIGN_EPI) { if (wr == 0) PG8_BAR; }
        if constexpr (!Epi::AFTER_DRAIN) { E(acc, cur, wr, wc, fr, fq); S.done(cur); }
        if (!has_next) break;
#pragma unroll
        for (int a = 0; a < 2; ++a)
#pragma unroll
            for (int b = 0; b < 2; ++b)
#pragma unroll
                for (int m = 0; m < 4; ++m)
#pragma unroll
                    for (int n = 0; n < 2; ++n) acc[a][b][m][n] = (f32x4){0.f, 0.f, 0.f, 0.f};
        cur = nxt; cA = nA; cB = nB; ++ui;
        if constexpr (ALIGN_EPI) { if (wr == 1) PG8_BAR; }
    }
    PG8_WAIT_V(0);
    if constexpr (!ALIGN_EPI) { if (wr == 0) PG8_BAR; }
    PG8_BAR;
    if constexpr (Epi::AFTER_DRAIN) { E.fused(acc, cur, wr, wc, fr, fq, lds, wid, lane); S.done(cur); }
#undef PG8_SA
#undef PG8_SB
#undef PG8_STAGE
#undef PG8_LDA
#undef PG8_LDB
#undef PG8_MMA
#undef PG8_WAIT_V
#undef PG8_WAIT_L
#undef PG8_BAR
#undef PG8_SCHED
}
}

namespace pg8 {
template <class Epi, class Sched, bool ALIGN_EPI>
__device__ __forceinline__ void gemm_phase_gather(PG8_LAS unsigned char* lds, const Gemm g, const PG8_LAS int* tok, const Sched& S, const Epi& E) {
    const int tid = threadIdx.x, wid = __builtin_amdgcn_readfirstlane(tid >> 6), lane = tid & 63, wr = wid >> 2, wc = wid & 3, fr = lane & 15, fq = lane >> 4;
    const int K = g.K, nt = K / BK;
    unsigned voffB[2]; int RA[2], CA[2];
#pragma unroll
    for (int i = 0; i < 2; ++i) { int R, C; stage_rc(tid * 16 + i * 8192, R, C); const int Rb = Epi::PERM ? ((R & ~31) + perm32(R & 31)) : R;
        RA[i] = R; CA[i] = C; voffB[i] = (unsigned)(Rb * K + C) * 2u; }
    const size_t kstep = (size_t)(BK * 2);
    const size_t hstep = (size_t)HALF * K * 2;
    const size_t tstep = 2 * hstep;
    const unsigned ldsw = (unsigned)wid * 1024u;
    const int aoff = lds_byte(wr * 64 + fr, fq * 8), boff = lds_byte(wc * 32 + fr, fq * 8);
#define PG8_SA(b, h) (((b) * 2 + (h)) * HTB)
#define PG8_SB(b, h) ((4 + (b) * 2 + (h)) * HTB)
#define PG8_STAGE(bufoff, gbase, voff) do { _Pragma("unroll") for (int _i = 0; _i < 2; ++_i) \
        __builtin_amdgcn_global_load_lds((const unsigned*)((const char*)(gbase) + (voff)[_i]), (PG8_LAS unsigned*)(lds + (bufoff) + ldsw + _i * 8192), 16, 0, 0); } while (0)
#define PG8_LDA(dst, b, h) do { _Pragma("unroll") for (int m = 0; m < 4; ++m) _Pragma("unroll") for (int k = 0; k < 2; ++k) dst[m][k] = *(const PG8_LAS bf16x8*)(lds + PG8_SA(b, h) + aoff + m * 2048 + k * 1024); } while (0)
#define PG8_LDB(dst, b, h) do { _Pragma("unroll") for (int n = 0; n < 2; ++n) _Pragma("unroll") for (int k = 0; k < 2; ++k) dst[n][k] = *(const PG8_LAS bf16x8*)(lds + PG8_SB(b, h) + boff + n * 2048 + k * 1024); } while (0)
#define PG8_MMA(ai, bj, At, Bt) do { __builtin_amdgcn_s_setprio(1); _Pragma("unroll") for (int m = 0; m < 4; ++m) _Pragma("unroll") for (int n = 0; n < 2; ++n) _Pragma("unroll") for (int k = 0; k < 2; ++k) \
        acc[ai][bj][m][n] = __builtin_amdgcn_mfma_f32_16x16x32_bf16(Bt[n][k], At[m][k], acc[ai][bj][m][n], 0, 0, 0); __builtin_amdgcn_s_setprio(0); } while (0)
#define PG8_WAIT_V(n) asm volatile("s_waitcnt vmcnt(" #n ")" ::: "memory")
#define PG8_WAIT_L(n) asm volatile("s_waitcnt lgkmcnt(" #n ")" ::: "memory")
#define PG8_BAR __builtin_amdgcn_s_barrier()
#define PG8_SCHED __builtin_amdgcn_sched_barrier(0)
#define PG8_GOFF(ui_, o0, o1) do { _Pragma("unroll") for (int _i = 0; _i < 2; ++_i) { \
        o0[_i] = (unsigned)(tok[(ui_) * 256 + RA[_i]] * K + CA[_i]) * 2u; o1[_i] = (unsigned)(tok[(ui_) * 256 + 128 + RA[_i]] * K + CA[_i]) * 2u; } } while (0)
    Unit cur, nxt; int ui = 0;
    if (!S.next(0, cur)) return;
    f32x4 acc[2][2][4][2];
#pragma unroll
    for (int a = 0; a < 2; ++a)
#pragma unroll
        for (int b = 0; b < 2; ++b)
#pragma unroll
            for (int m = 0; m < 4; ++m)
#pragma unroll
                for (int n = 0; n < 2; ++n) acc[a][b][m][n] = (f32x4){0.f, 0.f, 0.f, 0.f};
    bf16x8 At[4][2], B0[2][2], B1[2][2];
    const char* gA = (const char*)g.A; const char* cB = (const char*)g.Bt + (size_t)cur.pn * tstep;
    unsigned c0[2], c1[2], n0[2], n1[2];
    PG8_GOFF(0, c0, c1);
    S.a_ready(cur);
    PG8_STAGE(PG8_SB(0, 0), cB, voffB); PG8_STAGE(PG8_SB(0, 1), cB + hstep, voffB); PG8_STAGE(PG8_SA(0, 0), gA, c0); PG8_STAGE(PG8_SA(0, 1), gA, c1);
    if (wr == 1) PG8_BAR;
    PG8_WAIT_V(2); PG8_BAR;
    PG8_STAGE(PG8_SB(1, 0), cB + kstep, voffB); PG8_STAGE(PG8_SA(1, 0), gA + kstep, c0); PG8_STAGE(PG8_SB(1, 1), cB + hstep + kstep, voffB);
    PG8_WAIT_V(6); PG8_BAR;
    for (;;) {
        const bool has_next = S.next(ui + 1, nxt);
        const char* nB = has_next ? (const char*)g.Bt + (size_t)nxt.pn * tstep : cB;
        if (has_next) { PG8_GOFF(ui + 1, n0, n1); } else { n0[0] = c0[0]; n0[1] = c0[1]; n1[0] = c1[0]; n1[1] = c1[1]; }
        for (int t = 0; t < nt; t += 2) {
            const bool last = (t == nt - 2);
            const char* a1 = gA + (size_t)(t + 1) * kstep;
            const char* a2 = last ? gA : gA + (size_t)(t + 2) * kstep; const char* b2 = last ? nB : cB + (size_t)(t + 2) * kstep;
            const char* a3 = a2 + kstep; const char* b3 = b2 + kstep;
            unsigned s0[2], s1[2];
            s0[0] = last ? n0[0] : c0[0]; s0[1] = last ? n0[1] : c0[1]; s1[0] = last ? n1[0] : c1[0]; s1[1] = last ? n1[1] : c1[1];
            if (last && has_next) S.a_ready(nxt);
            PG8_LDB(B0, 0, 0); PG8_LDB(B1, 0, 1); PG8_SCHED; PG8_LDA(At, 0, 0); PG8_STAGE(PG8_SA(1, 1), a1, c1);
            PG8_WAIT_V(8); PG8_WAIT_L(0); PG8_BAR; PG8_MMA(0, 0, At, B0); PG8_MMA(0, 1, At, B1); PG8_BAR; PG8_SCHED;
            PG8_LDA(At, 0, 1); PG8_STAGE(PG8_SB(0, 0), b2, voffB); PG8_STAGE(PG8_SB(0, 1), b2 + hstep, voffB); PG8_STAGE(PG8_SA(0, 0), a2, s0);
            PG8_WAIT_V(8); PG8_WAIT_L(0); PG8_BAR; PG8_MMA(1, 0, At, B0); PG8_MMA(1, 1, At, B1); PG8_BAR; PG8_SCHED;
            PG8_LDB(B0, 1, 0); PG8_LDB(B1, 1, 1); PG8_SCHED; PG8_LDA(At, 1, 0); PG8_STAGE(PG8_SA(0, 1), a2, s1);
            PG8_WAIT_V(8); PG8_WAIT_L(0); PG8_BAR; PG8_MMA(0, 0, At, B0); PG8_MMA(0, 1, At, B1); PG8_BAR; PG8_SCHED;
            PG8_LDA(At, 1, 1); PG8_STAGE(PG8_SB(1, 0), b3, voffB); PG8_STAGE(PG8_SB(1, 1), b3 + hstep, voffB); PG8_STAGE(PG8_SA(1, 0), a3, s0);
            PG8_WAIT_V(8); PG8_WAIT_L(0); PG8_BAR; PG8_MMA(1, 0, At, B0); PG8_MMA(1, 1, At, B1); PG8_BAR; PG8_SCHED;
        }
        if constexpr (ALIGN_EPI) { if (wr == 0) PG8_BAR; }
        E(acc, cur, wr, wc, fr, fq); S.done(cur);
        if (!has_next) break;
#pragma unroll
        for (int a = 0; a < 2; ++a)
#pragma unroll
            for (int b = 0; b < 2; ++b)
#pragma unroll
                for (int m = 0; m < 4; ++m)
#pragma unroll
                    for (int n = 0; n < 2; ++n) acc[a][b][m][n] = (f32x4){0.f, 0.f, 0.f, 0.f};
        cur = nxt; cB = nB; ++ui; c0[0] = n0[0]; c0[1] = n0[1]; c1[0] = n1[0]; c1[1] = n1[1];
        if constexpr (ALIGN_EPI) { if (wr == 1) PG8_BAR; }
    }
    PG8_WAIT_V(0);
    if constexpr (!ALIGN_EPI) { if (wr == 0) PG8_BAR; }
    PG8_BAR;
#undef PG8_SA
#undef PG8_SB
#undef PG8_STAGE
#undef PG8_LDA
#undef PG8_LDB
#undef PG8_MMA
#undef PG8_WAIT_V
#undef PG8_WAIT_L
#undef PG8_BAR
#undef PG8_SCHED
#undef PG8_GOFF
}
}

__device__ __forceinline__ void transpose_item(const float* W, int ld, int c0, int k0, bf16* WT, int Kd, int r0, LAS float* scr, int lane) {
#pragma unroll 8
    for (int i = 0; i < 32; ++i) { const int kk = 2 * i + (lane >> 5); scr[kk * 33 + (lane & 31)] = W[(size_t)(k0 + kk) * ld + c0 + (lane & 31)]; }
    LDS_WAIT(); asm volatile("" ::: "memory");
    const int c = lane & 7;
#pragma unroll
    for (int j = 0; j < 4; ++j) { const int n = (lane >> 3) + 8 * j; const LAS float* s = scr + (8 * c) * 33 + n;
        v4u o; o.x = pk2(s[0 * 33], s[1 * 33]); o.y = pk2(s[2 * 33], s[3 * 33]); o.z = pk2(s[4 * 33], s[5 * 33]); o.w = pk2(s[6 * 33], s[7 * 33]);
        *(GAS v4u*)(WT + (size_t)(r0 + n) * Kd + k0 + 8 * c) = o; }
    LDS_WAIT(); asm volatile("" ::: "memory");
}
__device__ __forceinline__ int win_src_col(int n32) { const int n = n32 * 32; return n < 2048 ? n : (n < 3584 ? n + 32 : (n < 3616 ? n - 1536 : -1)); }

__device__ __forceinline__ void p0_prologue(const Args& a, LAS unsigned char* lds, int tid, int G, int bid) {
    const int lane = tid & 63, wave = tid >> 6;
    {
        LAS float* scr = (LAS float*)(lds + 32768 + wave * 8704);
        const int gw = bid * NWAVES + wave, NGW = G * NWAVES;
        constexpr int I_IN = (D / 64) * (NIN / 32), I_OUT = (D / 64) * (D / 32);
        for (int it = gw; it < I_IN + I_OUT; it += NGW) {
            if (it < I_IN) { const int kb = it / (NIN / 32), nb = it % (NIN / 32); const int sc = win_src_col(nb);
                if (sc >= 0) transpose_item(a.in[6], INW, sc, kb * 64, a.WinT, D, nb * 32, scr, lane);
                else { for (int j = 0; j < 4; ++j) { const int n = (lane >> 3) + 8 * j; *(GAS v4u*)(a.WinT + (size_t)(nb * 32 + n) * D + kb * 64 + 8 * (lane & 7)) = (v4u){0u, 0u, 0u, 0u}; } }
            } else { const int r = it - I_IN; const int kb = r / (D / 32), nb = r % (D / 32);
                transpose_item(a.in[12], D, nb * 32, kb * 64, a.WoutT, D, nb * 32, scr, lane); }
        }
    }
    for (int i = bid * NTHR + tid; i < 48 * D; i += G * NTHR) { const int o = i / D, k = i % D;
        const float w = o < 4 ? a.in[15][k * 4 + o] : (o < 36 ? a.in[17][k * 32 + (o - 4)] : 0.f);
        const unsigned hi = f2bf(w); const float lo = w - __builtin_bit_cast(float, hi << 16);
        a.WrT[i] = (bf16)hi; a.WrT[48 * D + i] = (bf16)f2bf(lo); }
    if (bid < 6 * D / 32) {
        LAS float* cs = (LAS float*)lds;
        __syncthreads();
        for (int i = tid; i < NB * D; i += NTHR) cs[i] = silu_f(a.in[1][i]);
        __syncthreads();
        const int col = bid * 32 + (tid & 31), ks = tid >> 5;
        float acc[NB];
#pragma unroll
        for (int b = 0; b < NB; ++b) acc[b] = 0.f;
        const float* wp = a.in[2] + (size_t)(ks * 64) * (6 * D) + col;
        float wv[64];
#pragma unroll
        for (int k = 0; k < 64; ++k) wv[k] = wp[(size_t)k * (6 * D)];
#pragma unroll
        for (int k = 0; k < 64; ++k) {
#pragma unroll
            for (int b = 0; b < NB; ++b) acc[b] += cs[b * D + ks * 64 + k] * wv[k]; }
        LAS float* red = (LAS float*)(lds + 32768);
        __syncthreads();
#pragma unroll
        for (int b = 0; b < NB; ++b) red[(ks * NB + b) * 32 + (tid & 31)] = acc[b];
        __syncthreads();
        if (tid < 256) { const int b = tid >> 5, c = tid & 31; float s = 0.f;
#pragma unroll
            for (int k = 0; k < 16; ++k) s += red[(k * NB + b) * 32 + c];
            a.ada[b * 6 * D + bid * 32 + c] = s + a.in[3][bid * 32 + c]; }
        __syncthreads();
    }
}

__device__ __forceinline__ void p1_rows(const Args& a, int tid, int G, int bid) {
    const int lane = tid & 63, wave = tid >> 6;
    const int gw = bid * NWAVES + wave, NGW = G * NWAVES;
    const float* g = a.in[4];
    f32x4 nx[4];
    if (gw < T) {
#pragma unroll
        for (int j = 0; j < 4; ++j) nx[j] = ((const GAS f32x4*)(a.in[0] + (size_t)gw * D) + lane)[64 * j]; }
    for (int t = gw; t < T; t += NGW) {
        const int b = t / S;
        f32x4 v[4]; float ss = 0.f;
#pragma unroll
        for (int j = 0; j < 4; ++j) v[j] = nx[j];
        if (t + NGW < T) {
#pragma unroll
            for (int j = 0; j < 4; ++j) nx[j] = ((const GAS f32x4*)(a.in[0] + (size_t)(t + NGW) * D) + lane)[64 * j]; }
#pragma unroll
        for (int j = 0; j < 4; ++j) ss += (v[j].x * v[j].x + v[j].y * v[j].y) + (v[j].z * v[j].z + v[j].w * v[j].w);
        const float rstd = rsqrtf(wave_sum(ss) * (1.f / D) + EPS);
        GAS v2u* o8 = (GAS v2u*)(a.H + (size_t)t * D) + lane;
        const float* sh = a.ada + b * 6 * D, *sc = sh + D;
#pragma unroll
        for (int j = 0; j < 4; ++j) { const int k = 4 * lane + 256 * j;
            const f32x4 gg = *(const f32x4*)(g + k), s1 = *(const f32x4*)(sc + k), h1 = *(const f32x4*)(sh + k);
            const float o0 = v[j].x * rstd * gg.x * (1.f + s1.x) + h1.x, o1 = v[j].y * rstd * gg.y * (1.f + s1.y) + h1.y;
            const float o2 = v[j].z * rstd * gg.z * (1.f + s1.z) + h1.z, o3 = v[j].w * rstd * gg.w * (1.f + s1.w) + h1.w;
            o8[64 * j] = (v2u){pk2(o0, o1), pk2(o2, o3)}; }
    }
}

struct EpiG1 {
    static constexpr bool PERM = true, AFTER_DRAIN = false;
    bf16* qkv; bf16* z; bf16* naq; bf16* nak; bf16* navt; float* gates;
    __device__ __forceinline__ void operator()(const pg8::f32x4 (&acc)[2][2][4][2], const pg8::Unit& u, int wr, int wc, int fr, int fq) const {
        const int row0 = u.pm * 256 + wr * 64 + fr, pn = u.pn;
        if (pn < 10) {
            bf16* base; int ldc, colt;
            if (pn < 6) { base = qkv; ldc = 1536; colt = pn * 256; }
            else if (pn < 8) { base = z; ldc = 512; colt = (pn - 6) * 256; }
            else { base = naq; ldc = 512; colt = (pn - 8) * 256; }
            const int col0 = colt + wc * 32 + 8 * fq;
#pragma unroll
            for (int ai = 0; ai < 2; ++ai)
#pragma unroll
                for (int m = 0; m < 4; ++m) { bf16* rowp = base + (size_t)(row0 + ai * 128 + m * 16) * ldc + col0;
#pragma unroll
                    for (int bj = 0; bj < 2; ++bj) { const pg8::f32x4 v0 = acc[ai][bj][m][0], v1 = acc[ai][bj][m][1];
                        v4u w; w.x = pg8::cvt_pk_bf16(v0[0], v0[1]); w.y = pg8::cvt_pk_bf16(v0[2], v0[3]); w.z = pg8::cvt_pk_bf16(v1[0], v1[1]); w.w = pg8::cvt_pk_bf16(v1[2], v1[3]);
                        *(v4u*)(rowp + bj * 128) = w; } }
        } else if (pn < 12) {
#pragma unroll
            for (int ai = 0; ai < 2; ++ai)
#pragma unroll
                for (int m = 0; m < 4; ++m) { const int t = row0 + ai * 128 + m * 16, b = t >> 11, sidx = t & 2047, R = sidx >> 6, colk = sidx & 63;
#pragma unroll
                    for (int bj = 0; bj < 2; ++bj) { const int c = (pn - 10) * 256 + bj * 128 + wc * 32 + 8 * fq, hd = c >> 6, d0 = c & 63;
                        const size_t off = ((((((size_t)((b * 8 + hd) * 32 + R) * 8 + (colk >> 3)) * 2 + ((colk >> 2) & 1)) * 2 + (d0 >> 5)) * 4 + (colk & 3)) * 4 + ((d0 >> 3) & 3)) * 8;
                        const pg8::f32x4 v0 = acc[ai][bj][m][0], v1 = acc[ai][bj][m][1];
                        v4u w; w.x = pg8::cvt_pk_bf16(v0[0], v0[1]); w.y = pg8::cvt_pk_bf16(v0[2], v0[3]); w.z = pg8::cvt_pk_bf16(v1[0], v1[1]); w.w = pg8::cvt_pk_bf16(v1[2], v1[3]);
                        *(v4u*)(nak + off) = w; } }
        } else if (pn < 14) {
#pragma unroll
            for (int ai = 0; ai < 2; ++ai)
#pragma unroll
                for (int m = 0; m < 4; ++m) { const int t = row0 + ai * 128 + m * 16, b = t >> 11, sidx = t & 2047, R = sidx >> 6, colk = sidx & 63;
#pragma unroll
                    for (int bj = 0; bj < 2; ++bj)
#pragma unroll
                        for (int n = 0; n < 2; ++n)
#pragma unroll
                            for (int r = 0; r < 4; ++r) { const int c = (pn - 12) * 256 + bj * 128 + wc * 32 + 8 * fq + 4 * n + r, hd = c >> 6, d = c & 63;
                                navt[(((((size_t)((b * 8 + hd) * 32 + R) * 4 + (d >> 4)) * 8 + (colk >> 3)) * 16 + (d & 15)) * 8) + (colk & 7)] = (bf16)f2bf(acc[ai][bj][m][n][r]); } }
        } else {
            if (wc == 0) {
#pragma unroll
                for (int ai = 0; ai < 2; ++ai)
#pragma unroll
                    for (int m = 0; m < 4; ++m) { float* gp = gates + (size_t)(row0 + ai * 128 + m * 16) * 32 + 8 * fq;
                        *(pg8::f32x4*)gp = acc[ai][0][m][0]; *(pg8::f32x4*)(gp + 4) = acc[ai][0][m][1]; }
            }
        }
    }
};

__device__ __forceinline__ void p3_na(const Args& a, LAS unsigned char* lds, int tid, int G, int bid) {
    LAS float* tab = (LAS float*)(lds + 256);
    for (int i = tid; i < 8 * 465 + 128; i += NTHR) tab[i - 64] = (i >= 64 && i < 8 * 465 + 64) ? a.in[11][i - 64] : 0.f;
    __syncthreads();
    const int lane = tid & 63, wave = tid >> 6, q = lane & 15, g = lane >> 4;
    const int pi0 = 8 * (q >> 2) + (q & 3);
    const int xg = bid & 7, gs8 = (G >> 3) * NWAVES, slot = (bid >> 3) * NWAVES + wave;
    for (int it = slot; it < 8 * ROWS * 4; it += gs8) {
        const int pair = xg * 8 + (it >> 7), j = it & 3, r = (it >> 2) & 31, h = pair & 7, b = pair >> 3;
        int r0 = r - 4; r0 = r0 < 0 ? 0 : (r0 > ROWS - 8 ? ROWS - 8 : r0);
        const int start = j == 0 ? 0 : (j == 1 ? 8 : (j == 2 ? 24 : 32));
        const int c = 16 * j + q; int c0 = c - 8; c0 = c0 < 0 ? 0 : (c0 > GW - 16 ? GW - 16 : c0);
        const size_t tq = (size_t)b * S + r * GW + c;
        const bf16* qp = a.NAQ + tq * 512 + h * 64 + 8 * g;
        const bf16x8 qf0 = *(const bf16x8*)qp, qf1 = *(const bf16x8*)(qp + 32);
        f32x4 sc[8][2];
        {
            bf16x8 kf[8][4];
#pragma unroll
            for (int kr = 0; kr < 8; ++kr) {
                const bf16* kp = a.NAK + ((size_t)((b * 8 + h) * 32 + r0 + kr) * 512 + (size_t)((start >> 3) + (q >> 2)) * 64 + (q & 3) * 4 + g) * 8;
                kf[kr][0] = *(const bf16x8*)kp; kf[kr][1] = *(const bf16x8*)(kp + 128); kf[kr][2] = *(const bf16x8*)(kp + 256); kf[kr][3] = *(const bf16x8*)(kp + 384);
            }
            __builtin_amdgcn_sched_barrier(0);
#pragma unroll
            for (int kr = 0; kr < 8; ++kr) {
                f32x4 s0 = {0.f, 0.f, 0.f, 0.f}, s1 = {0.f, 0.f, 0.f, 0.f};
                s0 = __builtin_amdgcn_mfma_f32_16x16x32_bf16(kf[kr][0], qf0, s0, 0, 0, 0); s0 = __builtin_amdgcn_mfma_f32_16x16x32_bf16(kf[kr][1], qf1, s0, 0, 0, 0);
                s1 = __builtin_amdgcn_mfma_f32_16x16x32_bf16(kf[kr][2], qf0, s1, 0, 0, 0); s1 = __builtin_amdgcn_mfma_f32_16x16x32_bf16(kf[kr][3], qf1, s1, 0, 0, 0);
                sc[kr][0] = s0; sc[kr][1] = s1;
            }
        }
        bf16x8 vf[8][4];
        {
            const bf16* vbase = a.NAVT + ((size_t)((b * 8 + h) * 32 + r0) * 512 + (size_t)((start >> 3) + g) * 16 + q) * 8;
#pragma unroll
            for (int kr = 0; kr < 8; ++kr)
#pragma unroll
                for (int dt = 0; dt < 4; ++dt) vf[kr][dt] = *(const bf16x8*)(vbase + (size_t)kr * 4096 + dt * 1024);
        }
        __builtin_amdgcn_sched_barrier(0);
        float m = -1e30f;
#pragma unroll
        for (int kr = 0; kr < 8; ++kr) {
            const LAS float* bp = tab + (h * 15 + (r0 + kr - r + 7)) * 31 + (start + 8 * g - c + 15);
#pragma unroll
            for (int jj = 0; jj < 8; ++jj) { const int kc = start + 8 * g + jj; const bool ok = (kc >= c0) && (kc < c0 + 16);
                const float v = ok ? sc[kr][jj >> 2][jj & 3] * 0.125f + bp[jj] : -1e30f;
                sc[kr][jj >> 2][jj & 3] = v; m = fmaxf(m, v); }
        }
        m = fmaxf(m, __shfl_xor(m, 16)); m = fmaxf(m, __shfl_xor(m, 32));
        float l = 0.f;
        bf16x8 pf[8];
#pragma unroll
        for (int kr = 0; kr < 8; ++kr) {
            float p[8];
#pragma unroll
            for (int jj = 0; jj < 8; ++jj) { const float v = sc[kr][jj >> 2][jj & 3]; p[jj] = v > -1e29f ? __expf(v - m) : 0.f; l += p[jj]; }
            v4u w; w.x = pk2(p[0], p[1]); w.y = pk2(p[2], p[3]); w.z = pk2(p[4], p[5]); w.w = pk2(p[6], p[7]);
            pf[kr] = __builtin_bit_cast(bf16x8, w);
        }
        l += __shfl_xor(l, 16); l += __shfl_xor(l, 32);
        f32x4 o[4];
#pragma unroll
        for (int dt = 0; dt < 4; ++dt) o[dt] = (f32x4){0.f, 0.f, 0.f, 0.f};
#pragma unroll
        for (int kr = 0; kr < 8; ++kr) {
#pragma unroll
            for (int dt = 0; dt < 4; ++dt) o[dt] = __builtin_amdgcn_mfma_f32_16x16x32_bf16(vf[kr][dt], pf[kr], o[dt], 0, 0, 0);
        }
        const float inv = 1.f / l;
        bf16* op = a.MIX + tq * D + 512 + h * 64 + 4 * g;
#pragma unroll
        for (int dt = 0; dt < 4; ++dt) *(v2u*)(op + 16 * dt) = (v2u){pk2(o[dt][0] * inv, o[dt][1] * inv), pk2(o[dt][2] * inv, o[dt][3] * inv)};
    }
}

typedef float f32x2_t __attribute__((ext_vector_type(2))); typedef __bf16 bf16x2_t __attribute__((ext_vector_type(2)));
__device__ __forceinline__ unsigned cvtpk(float lo, float hi) { f32x2_t v = {lo, hi}; bf16x2_t b = __builtin_convertvector(v, bf16x2_t); return __builtin_bit_cast(unsigned, b); }
__device__ __forceinline__ int crow(int reg, int hh) { return (reg & 3) + 8 * (reg >> 2) + 4 * hh; }
#define MFMA32(a, b, c) __builtin_amdgcn_mfma_f32_32x32x16_bf16((a), (b), (c), 0, 0, 0)
__device__ __forceinline__ bf16x8 pack8(const f32x16& x, int s) {
    v4u p; p.x = cvtpk(x[8 * s], x[8 * s + 1]); p.y = cvtpk(x[8 * s + 2], x[8 * s + 3]); p.z = cvtpk(x[8 * s + 4], x[8 * s + 5]); p.w = cvtpk(x[8 * s + 6], x[8 * s + 7]);
    return __builtin_bit_cast(bf16x8, p);
}
constexpr int IMG = 72;
constexpr int L_KB = 0, L_QB = 9216, L_VB = 18432, L_KT = 27648, L_UT = 36864, L_WT = 46080, L_M = 55296, L_G = 71680, L_DIR = 73728;
constexpr int PREP_REC = 32768;

__device__ __forceinline__ bf16x8 frag_nat(const LAS bf16* img, int row, int ks, int hh) { return *(const LAS bf16x8*)(img + row * IMG + 16 * ks + 8 * hh); }
__device__ __forceinline__ bf16x8 frag_kap(const LAS bf16* img, int row, int base, int s, int hh) {
    const v2u lo = *(const LAS v2u*)(img + row * IMG + base + 16 * s + 4 * hh), hi = *(const LAS v2u*)(img + row * IMG + base + 16 * s + 8 + 4 * hh);
    return __builtin_bit_cast(bf16x8, (v4u){lo.x, lo.y, hi.x, hi.y});
}

typedef float f32x2v __attribute__((ext_vector_type(2)));
__device__ __forceinline__ void pkfnma(f32x2v& acc, f32x2v m, f32x2v xx) { asm("v_pk_fma_f32 %0, %1, %2, %0 op_sel_hi:[0,1,1] neg_lo:[1,0,0] neg_hi:[1,0,0]" : "+v"(acc) : "v"(xx), "v"(m)); }
__device__ __forceinline__ float fnma(float acc, float m, float x) { asm("v_fma_f32 %0, -%1, %2, %0" : "+v"(acc) : "v"(m), "v"(x)); return acc; }
template <int B0, int JJ> __device__ __forceinline__ void dn_tri_step(f32x2v (&acc)[32], f32x4 (&mc)[8], const LAS float* MT) {
    constexpr int j = B0 + JJ;
    f32x4 mn[8];
    if (JJ + 1 < 31) {
#pragma unroll
        for (int i4 = (JJ + 2) / 4; i4 < 8; ++i4) mn[i4] = *(const LAS f32x4*)(MT + (j + 1) * 64 + B0 + 4 * i4);
    }
    __builtin_amdgcn_sched_barrier(0);
    const float xj = (j & 1) ? acc[j >> 1].y : acc[j >> 1].x;
    const f32x2v xx = {xj, xj};
#pragma unroll
    for (int i4 = (JJ + 1) / 4; i4 < 8; ++i4) {
        const f32x4 m = mc[i4]; const int ia = B0 + 4 * i4;
        if (ia > j) pkfnma(acc[ia >> 1], (f32x2v){m.x, m.y}, xx);
        else if (ia + 1 > j) acc[ia >> 1].y = fnma(acc[ia >> 1].y, m.y, xj);
        if (ia + 2 > j) pkfnma(acc[(ia >> 1) + 1], (f32x2v){m.z, m.w}, xx);
        else if (ia + 3 > j) acc[(ia >> 1) + 1].y = fnma(acc[(ia >> 1) + 1].y, m.w, xj);
    }
    __builtin_amdgcn_sched_barrier(0);
    if (JJ + 1 < 31) {
#pragma unroll
        for (int i4 = (JJ + 2) / 4; i4 < 8; ++i4) mc[i4] = mn[i4];
    }
}
template <int B0, int... JJ> __device__ __forceinline__ void dn_tri_steps(f32x2v (&acc)[32], f32x4 (&mc)[8], const LAS float* MT, std::integer_sequence<int, JJ...>) { (dn_tri_step<B0, JJ>(acc, mc, MT), ...); }
template <int B0> __device__ __forceinline__ void dn_tri32(f32x2v (&acc)[32], const LAS float* MT) {
    f32x4 mc[8];
#pragma unroll
    for (int i4 = 0; i4 < 8; ++i4) mc[i4] = *(const LAS f32x4*)(MT + B0 * 64 + B0 + 4 * i4);
    dn_tri_steps<B0>(acc, mc, MT, std::make_integer_sequence<int, 31>{});
}
__device__ __forceinline__ void dn_store32(const f32x2v (&acc)[32], int half, LAS bf16* out_img, int lane) {
#pragma unroll
    for (int i8 = 0; i8 < 4; ++i8) { const int k = 16 * half + 4 * i8;
        v4u w; w.x = cvtpk(acc[k].x, acc[k].y); w.y = cvtpk(acc[k + 1].x, acc[k + 1].y); w.z = cvtpk(acc[k + 2].x, acc[k + 2].y); w.w = cvtpk(acc[k + 3].x, acc[k + 3].y);
        *(LAS v4u*)(out_img + lane * IMG + 32 * half + 8 * i8) = w; }
}
__device__ __forceinline__ void dn_solve(const LAS float* MT, const LAS bf16* ML, const LAS bf16* rhs_img, const LAS float* rscale, LAS bf16* out_img, int lane) {
    f32x2v acc[32];
#pragma unroll
    for (int k = 0; k < 16; ++k) { acc[k].x = rscale[2 * k] * bf2f(rhs_img[(2 * k) * IMG + lane]); acc[k].y = rscale[2 * k + 1] * bf2f(rhs_img[(2 * k + 1) * IMG + lane]); }
    dn_tri32<0>(acc, MT);
    dn_store32(acc, 0, out_img, lane);
    __builtin_amdgcn_sched_barrier(0);
#pragma unroll
    for (int k = 16; k < 32; ++k) { acc[k].x = rscale[2 * k] * bf2f(rhs_img[(2 * k) * IMG + lane]); acc[k].y = rscale[2 * k + 1] * bf2f(rhs_img[(2 * k + 1) * IMG + lane]); }
    asm volatile("s_waitcnt lgkmcnt(0)" ::: "memory");
    {
        const int col = lane & 31, hh = lane >> 5;
        f32x16 d0, d1;
#pragma unroll
        for (int r = 0; r < 16; ++r) { d0[r] = 0.f; d1[r] = 0.f; }
#pragma unroll
        for (int ks = 0; ks < 2; ++ks) { const bf16x8 af = *(const LAS bf16x8*)(ML + col * 128 + 16 * ks + 8 * hh);
            d0 = MFMA32(af, frag_nat(out_img, col, ks, hh), d0); d1 = MFMA32(af, frag_nat(out_img, 32 + col, ks, hh), d1); }
#pragma unroll
        for (int r = 0; r < 16; ++r) { const float t0 = __shfl_xor(d0[r], 32), t1 = __shfl_xor(d1[r], 32);
            const float n0 = hh ? t1 : d0[r], n1 = hh ? d1[r] : t0; d0[r] = n0; d1[r] = n1; }
#pragma unroll
        for (int r = 0; r < 16; ++r) { const int i0r = 32 + crow(r, 0), i1r = 32 + crow(r, 1);
            if (i0r & 1) acc[i0r >> 1].y -= d0[r]; else acc[i0r >> 1].x -= d0[r];
            if (i1r & 1) acc[i1r >> 1].y -= d1[r]; else acc[i1r >> 1].x -= d1[r]; }
    }
    dn_tri32<32>(acc, MT);
    dn_store32(acc, 1, out_img, lane);
}

__device__ __forceinline__ void p3_dnprep(const Args& a, LAS unsigned char* lds, int tid, int G, int bid) {
    const float* wconv = a.in[7];
    LAS float* WCV = (LAS float*)(lds + 2 * L_DIR);
    int hcur = -1;
    float pg_a = 0.f, pg_b = 0.f; v4u raw[3][5];
#define PREP_PF_GATES(it) do { if ((tid >> 6) < 2 && (it) < NB * NH * 32) { const int _c = (it) & 31, _h = ((it) >> 5) & 7, _b = (it) >> 8, _d = tid >> 6, _l = tid & 63; \
        const float* _gp = a.GATES + (size_t)(_b * S + 64 * _c + (_d ? 63 - _l : _l)) * 32; pg_a = _gp[_d * 8 + _h]; pg_b = _gp[16 + _d * 8 + _h]; } } while (0)
#define PREP_PF_RAW(it) do { if ((it) < NB * NH * 32) { const int _c = (it) & 31, _h = ((it) >> 5) & 7, _b = (it) >> 8, _s = 64 * _c + (tid >> 3); \
        _Pragma("unroll") for (int _m = 0; _m < 3; ++_m) _Pragma("unroll") for (int _t = 0; _t < 5; ++_t) { const int _ss = _s + _t - 2; \
            raw[_m][_t] = (_ss >= 0 && _ss < S) ? *(const v4u*)(a.QKV + (size_t)(_b * S + _ss) * 1536 + _m * 512 + _h * 64 + 8 * (tid & 7)) : (v4u){0u, 0u, 0u, 0u}; } } } while (0)
    PREP_PF_GATES(bid); PREP_PF_RAW(bid);
    for (int item = bid; item < NB * NH * 32; item += G) {
        int tid_ = tid; asm volatile("" : "+v"(tid_));
        const int lane = tid_ & 63, wave = tid_ >> 6, dir = wave & 1, w4 = wave >> 1;
        const int col = lane & 31, hh = lane >> 5;
        LAS unsigned char* ld = lds + dir * L_DIR;
        LAS bf16* KB = (LAS bf16*)(ld + L_KB); LAS bf16* QB = (LAS bf16*)(ld + L_QB); LAS bf16* VB = (LAS bf16*)(ld + L_VB); LAS bf16* KT = (LAS bf16*)(ld + L_KT);
        LAS bf16* UT = (LAS bf16*)(ld + L_UT); LAS bf16* WT = (LAS bf16*)(ld + L_WT); LAS float* M = (LAS float*)(ld + L_M); LAS float* GT = (LAS float*)(ld + L_G);
        const int chunk = item & 31, h = (item >> 5) & 7, b = item >> 8;
        const int tok0 = b * S + 64 * chunk;
        __syncthreads();
        if (wave < 2) {
            const float av = pg_a, bv = pg_b;
            const float g = -__expf(a.in[8][dir * 8 + h]) * softplus_f(av + a.in[9][dir * 8 + h]);
            const float beta = sigmoid_f(bv);
            float v = g;
#pragma unroll
            for (int o = 1; o < 64; o <<= 1) { const float u = __shfl_up(v, o); if (lane >= o) v += u; }
            const float gl = __shfl(v, 63);
            const float e = __expf(v);
            GT[lane] = beta; GT[64 + lane] = v; GT[128 + lane] = e; GT[192 + lane] = __expf(gl - v); GT[256 + lane] = beta * e;
            if (lane == 0) GT[320] = __expf(gl);
        }
        if (h != hcur) { for (int i = tid; i < 5 * 192; i += NTHR) { const int tp = i / 192, cc = i % 192; WCV[i] = wconv[tp * 1536 + (cc >> 6) * 512 + h * 64 + (cc & 63)]; } hcur = h; }
        PREP_PF_GATES(item + G);
        __syncthreads();
        {
            const int p = tid_ >> 3, d0 = 8 * (tid_ & 7);
#pragma unroll
            for (int mat = 0; mat < 3; ++mat) {
                float acc[8];
#pragma unroll
                for (int e = 0; e < 8; ++e) acc[e] = 0.f;
#pragma unroll
                for (int tap = 0; tap < 5; ++tap) {
                    const v4u rw = raw[mat][tap];
                    const f32x4 w0 = *(const LAS f32x4*)(WCV + tap * 192 + mat * 64 + d0), w1 = *(const LAS f32x4*)(WCV + tap * 192 + mat * 64 + d0 + 4);
                    acc[0] += w0.x * bflo(rw.x); acc[1] += w0.y * bfhi(rw.x); acc[2] += w0.z * bflo(rw.y); acc[3] += w0.w * bfhi(rw.y);
                    acc[4] += w1.x * bflo(rw.z); acc[5] += w1.y * bfhi(rw.z); acc[6] += w1.z * bflo(rw.w); acc[7] += w1.w * bfhi(rw.w);
                }
                float ss2 = 0.f;
#pragma unroll
                for (int e = 0; e < 8; ++e) { acc[e] = silu_f(acc[e]); ss2 += acc[e] * acc[e]; }
                if (mat < 2) {
                    ss2 += __shfl_xor(ss2, 1); ss2 += __shfl_xor(ss2, 2); ss2 += __shfl_xor(ss2, 4);
                    const float sc = rsqrtf(ss2 + EPS);
#pragma unroll
                    for (int e = 0; e < 8; ++e) acc[e] *= sc;
                }
                const v4u w = (v4u){cvtpk(acc[0], acc[1]), cvtpk(acc[2], acc[3]), cvtpk(acc[4], acc[5]), cvtpk(acc[6], acc[7])};
                const int off = mat == 0 ? L_QB : (mat == 1 ? L_KB : L_VB);
                *(LAS v4u*)((LAS bf16*)(lds + off) + p * IMG + d0) = w;
                *(LAS v4u*)((LAS bf16*)(lds + L_DIR + off) + (63 - p) * IMG + d0) = w;
                if (mat == 1) {
                    const float e0 = ((LAS float*)(lds + L_G))[192 + p], e1 = ((LAS float*)(lds + L_DIR + L_G))[192 + 63 - p];
                    LAS bf16* kt0 = (LAS bf16*)(lds + L_KT); LAS bf16* kt1 = (LAS bf16*)(lds + L_DIR + L_KT);
#pragma unroll
                    for (int e = 0; e < 8; ++e) { const float kv = bf2f((unsigned short)(e & 1 ? (w[e >> 1] >> 16) : (w[e >> 1] & 0xffffu)));
                        kt0[(d0 + e) * IMG + p] = (bf16)f2bf(kv * e0); kt1[(d0 + e) * IMG + 63 - p] = (bf16)f2bf(kv * e1); }
                }
            }
        }
        __syncthreads();
        if (w4 < 3) {
            const int bi = w4 == 0 ? 0 : 1, bj = w4 == 2 ? 1 : 0;
            f32x16 acc;
#pragma unroll
            for (int r = 0; r < 16; ++r) acc[r] = 0.f;
#pragma unroll
            for (int ks = 0; ks < 4; ++ks) acc = MFMA32(frag_nat(KB, 32 * bi + col, ks, hh), frag_nat(KB, 32 * bj + col, ks, hh), acc);
            const int j = 32 * bj + col; const float gcj = GT[64 + j];
            if (w4 == 1) {
#pragma unroll
                for (int r = 0; r < 16; ++r) { const int ip = crow(r, hh), i = 32 + ip;
                    ((LAS bf16*)((LAS unsigned char*)M + 128))[ip * 128 + j] = (bf16)f2bf(GT[i] * acc[r] * __expf(GT[64 + i] - gcj)); }
            } else {
#pragma unroll
            for (int r4 = 0; r4 < 4; ++r4) { const int i0 = 32 * bi + 8 * r4 + 4 * hh; f32x4 mv;
#pragma unroll
                for (int k = 0; k < 4; ++k) { const int i = i0 + k; mv[k] = (i > j) ? GT[i] * acc[4 * r4 + k] * __expf(GT[64 + i] - gcj) : 0.f; }
                *(LAS f32x4*)(M + j * 64 + i0) = mv; }
            }
        }
        __syncthreads();
        if (w4 < 2) dn_solve(M, (const LAS bf16*)((const LAS unsigned char*)M + 128), w4 == 0 ? VB : KB, w4 == 0 ? GT : GT + 256, w4 == 0 ? UT : WT, lane);
        __syncthreads();
        __builtin_amdgcn_sched_barrier(0);
        PREP_PF_RAW(item + G);
        __builtin_amdgcn_sched_barrier(0);
        {
            int col5 = lane & 31; asm volatile("" : "+v"(col5));
            const int col = col5;
            const int I = w4 >> 1, c = w4 & 1;
            unsigned char* rec = (unsigned char*)a.PREP + ((size_t)((b * 8 + h) * 2 + dir) * 32 + chunk) * PREP_REC;
            bf16x8 Xf[2][2];
            const int i_tok = 32 * I + col; const float gci = GT[64 + i_tok];
#pragma unroll
            for (int J = 0; J < 2; ++J) {
                if (J <= I) {
                    f32x16 acc;
#pragma unroll
                    for (int r = 0; r < 16; ++r) acc[r] = 0.f;
#pragma unroll
                    for (int ks = 0; ks < 4; ++ks) acc = MFMA32(frag_nat(KB, 32 * J + col, ks, hh), frag_nat(QB, 32 * I + col, ks, hh), acc);
#pragma unroll
                    for (int r = 0; r < 16; ++r) { const int j = 32 * J + crow(r, hh); acc[r] = (j <= i_tok) ? acc[r] * 0.125f * __expf(gci - GT[64 + j]) : 0.f; }
                    Xf[J][0] = pack8(acc, 0); Xf[J][1] = pack8(acc, 1);
                }
            }
            {
                f32x16 acc;
#pragma unroll
                for (int r = 0; r < 16; ++r) acc[r] = 0.f;
#pragma unroll
                for (int J = 0; J < 2; ++J) if (J <= I) {
#pragma unroll
                    for (int s = 0; s < 2; ++s) acc = MFMA32(Xf[J][s], frag_kap(UT, 32 * c + col, 32 * J, s, hh), acc); }
                v4u* dst = (v4u*)(rec + 24576 + (I * 2 + c) * 2048 + lane * 32);
                dst[0] = (v4u){cvtpk(acc[0], acc[1]), cvtpk(acc[2], acc[3]), cvtpk(acc[4], acc[5]), cvtpk(acc[6], acc[7])};
                dst[1] = (v4u){cvtpk(acc[8], acc[9]), cvtpk(acc[10], acc[11]), cvtpk(acc[12], acc[13]), cvtpk(acc[14], acc[15])};
            }
            {
                f32x16 acc;
#pragma unroll
                for (int r = 0; r < 16; ++r) acc[r] = 0.f;
#pragma unroll
                for (int J = 0; J < 2; ++J) if (J <= I) {
#pragma unroll
                    for (int s = 0; s < 2; ++s) acc = MFMA32(frag_kap(WT, 32 * c + col, 32 * J, s, hh), Xf[J][s], acc); }
                const float ei = GT[128 + i_tok] * 0.125f;
#pragma unroll
                for (int r4 = 0; r4 < 4; ++r4) { const v2u qv = *(const LAS v2u*)(QB + i_tok * IMG + 32 * c + 8 * r4 + 4 * hh);
                    acc[4 * r4 + 0] = ei * bflo(qv.x) - acc[4 * r4 + 0]; acc[4 * r4 + 1] = ei * bfhi(qv.x) - acc[4 * r4 + 1];
                    acc[4 * r4 + 2] = ei * bflo(qv.y) - acc[4 * r4 + 2]; acc[4 * r4 + 3] = ei * bfhi(qv.y) - acc[4 * r4 + 3]; }
                *(bf16x8*)(rec + ((I * 2 + c) * 2 + 0) * 1024 + lane * 16) = pack8(acc, 0);
                *(bf16x8*)(rec + ((I * 2 + c) * 2 + 1) * 1024 + lane * 16) = pack8(acc, 1);
            }
            {
                f32x16 acc;
#pragma unroll
                for (int r = 0; r < 16; ++r) acc[r] = 0.f;
#pragma unroll
                for (int ks = 0; ks < 4; ++ks) acc = MFMA32(frag_nat(WT, 32 * I + col, ks, hh), frag_nat(KT, 32 * c + col, ks, hh), acc);
                const float egl = GT[320];
#pragma unroll
                for (int r = 0; r < 16; ++r) acc[r] = ((32 * I + crow(r, hh)) == (32 * c + col) ? egl : 0.f) - acc[r];
                *(bf16x8*)(rec + 8192 + ((c * 2 + I) * 2 + 0) * 1024 + lane * 16) = pack8(acc, 0);
                *(bf16x8*)(rec + 8192 + ((c * 2 + I) * 2 + 1) * 1024 + lane * 16) = pack8(acc, 1);
            }
            {
                f32x16 acc;
#pragma unroll
                for (int r = 0; r < 16; ++r) acc[r] = 0.f;
#pragma unroll
                for (int ks = 0; ks < 4; ++ks) acc = MFMA32(frag_nat(KT, 32 * I + col, ks, hh), frag_nat(UT, 32 * c + col, ks, hh), acc);
                v4u* dst = (v4u*)(rec + 16384 + (I * 2 + c) * 2048 + lane * 32);
                dst[0] = (v4u){cvtpk(acc[0], acc[1]), cvtpk(acc[2], acc[3]), cvtpk(acc[4], acc[5]), cvtpk(acc[6], acc[7])};
                dst[1] = (v4u){cvtpk(acc[8], acc[9]), cvtpk(acc[10], acc[11]), cvtpk(acc[12], acc[13]), cvtpk(acc[14], acc[15])};
            }
        }
    }
}

#undef PREP_PF_GATES
#undef PREP_PF_RAW
constexpr int SCAN_BUF = 24576, SCAN_OFF = 71680;
__device__ __forceinline__ void scan_dma(const unsigned char* rec, LAS unsigned char* buf, int DV, int lane) {
    const unsigned char* src = rec + lane * 16;
#pragma unroll
    for (int p = 0; p < 8; ++p) __builtin_amdgcn_global_load_lds((const unsigned*)(src + 8192 + p * 1024), (LAS unsigned*)(buf + p * 1024), 16, 0, 0);
#pragma unroll
    for (int p = 0; p < 8; ++p) __builtin_amdgcn_global_load_lds((const unsigned*)(src + p * 1024), (LAS unsigned*)(buf + 8192 + p * 1024), 16, 0, 0);
#pragma unroll
    for (int blk = 0; blk < 2; ++blk)
#pragma unroll
        for (int hf = 0; hf < 2; ++hf) {
            __builtin_amdgcn_global_load_lds((const unsigned*)(src + 16384 + (blk * 2 + DV) * 2048 + hf * 1024), (LAS unsigned*)(buf + 16384 + blk * 2048 + hf * 1024), 16, 0, 0);
            __builtin_amdgcn_global_load_lds((const unsigned*)(src + 24576 + (blk * 2 + DV) * 2048 + hf * 1024), (LAS unsigned*)(buf + 20480 + blk * 2048 + hf * 1024), 16, 0, 0);
        }
}
__device__ __forceinline__ void unpack16(f32x16& d, const LAS unsigned char* p) {
    const v4u c0 = *(const LAS v4u*)p, c1 = *(const LAS v4u*)(p + 16);
    d[0] = bflo(c0.x); d[1] = bfhi(c0.x); d[2] = bflo(c0.y); d[3] = bfhi(c0.y); d[4] = bflo(c0.z); d[5] = bfhi(c0.z); d[6] = bflo(c0.w); d[7] = bfhi(c0.w);
    d[8] = bflo(c1.x); d[9] = bfhi(c1.x); d[10] = bflo(c1.y); d[11] = bfhi(c1.y); d[12] = bflo(c1.z); d[13] = bfhi(c1.z); d[14] = bflo(c1.w); d[15] = bfhi(c1.w);
}
__device__ __forceinline__ void p4_scan_wave(const Args& a, LAS unsigned char* lds, int id, int lane) {
    const int DV = id & 1, dir = (id >> 1) & 1, h = (id >> 2) & 7, b = id >> 5;
    const int col = lane & 31, hh = lane >> 5;
    f32x16 S0, S1;
#pragma unroll
    for (int r = 0; r < 16; ++r) { S0[r] = 0.f; S1[r] = 0.f; }
    const unsigned char* chain = (const unsigned char*)a.PREP + (size_t)((b * 8 + h) * 2 + dir) * 32 * PREP_REC;
    LAS unsigned char* ring = lds + SCAN_OFF;
    scan_dma(chain + (size_t)(dir ? 31 : 0) * PREP_REC, ring, DV, lane);
    scan_dma(chain + (size_t)(dir ? 30 : 1) * PREP_REC, ring + SCAN_BUF, DV, lane);
    for (int st = 0; st < 32; ++st) {
        const int chunk = dir ? 31 - st : st;
        asm volatile("s_waitcnt lgkmcnt(0)" ::: "memory");
        { const int s2 = st + 2 < 32 ? st + 2 : 31; scan_dma(chain + (size_t)(dir ? 31 - s2 : s2) * PREP_REC, ring + ((st + 2) % 3) * SCAN_BUF, DV, lane); }
        asm volatile("s_waitcnt vmcnt(48)" ::: "memory");
        __builtin_amdgcn_sched_barrier(0);
        const LAS unsigned char* buf = ring + (st % 3) * SCAN_BUF;
        bf16x8 Sb[2][2];
        Sb[0][0] = pack8(S0, 0); Sb[0][1] = pack8(S0, 1); Sb[1][0] = pack8(S1, 0); Sb[1][1] = pack8(S1, 1);
        f32x16 o[2], n[2];
#pragma unroll
        for (int I = 0; I < 2; ++I) {
            unpack16(o[I], buf + 20480 + I * 2048 + lane * 32);
#pragma unroll
            for (int DK = 0; DK < 2; ++DK)
#pragma unroll
                for (int s = 0; s < 2; ++s) o[I] = MFMA32(*(const LAS bf16x8*)(buf + 8192 + ((I * 2 + DK) * 2 + s) * 1024 + lane * 16), Sb[DK][s], o[I]);
        }
#pragma unroll
        for (int DKp = 0; DKp < 2; ++DKp) {
            unpack16(n[DKp], buf + 16384 + DKp * 2048 + lane * 32);
#pragma unroll
            for (int DK = 0; DK < 2; ++DK)
#pragma unroll
                for (int s = 0; s < 2; ++s) n[DKp] = MFMA32(*(const LAS bf16x8*)(buf + ((DKp * 2 + DK) * 2 + s) * 1024 + lane * 16), Sb[DK][s], n[DKp]);
        }
        S0 = n[0]; S1 = n[1];
        bf16* ofb = (bf16*)a.Y + ((size_t)dir * T + (size_t)b * S + 64 * chunk) * 512 + h * 64 + 32 * DV + col;
#pragma unroll
        for (int I = 0; I < 2; ++I)
#pragma unroll
            for (int r = 0; r < 16; ++r) { const int nn = 32 * I + crow(r, hh); const int p = dir ? 63 - nn : nn; ofb[(size_t)p * 512] = (bf16)f2bf(o[I][r]); }
    }
    asm volatile("s_waitcnt vmcnt(0)" ::: "memory");
}

__device__ __forceinline__ void p4b_dnout(const Args& a, int tid, int G, int bid) {
    const bf16* ofb = (const bf16*)a.Y;
    const int d0 = 8 * (tid & 7);
    const f32x4 g0 = *(const f32x4*)(a.in[10] + d0), g1 = *(const f32x4*)(a.in[10] + d0 + 4);
    for (size_t u = (size_t)bid * NTHR + tid; u < (size_t)T * 64; u += (size_t)G * NTHR) {
        const size_t th = u >> 3;
        const v4u pf = *(const v4u*)(ofb + th * 64 + d0), pb = *(const v4u*)(ofb + ((size_t)T * 8 + th) * 64 + d0), zz = *(const v4u*)(a.Z + th * 64 + d0);
        float x[8];
        x[0] = bflo(pf.x) + bflo(pb.x); x[1] = bfhi(pf.x) + bfhi(pb.x); x[2] = bflo(pf.y) + bflo(pb.y); x[3] = bfhi(pf.y) + bfhi(pb.y);
        x[4] = bflo(pf.z) + bflo(pb.z); x[5] = bfhi(pf.z) + bfhi(pb.z); x[6] = bflo(pf.w) + bflo(pb.w); x[7] = bfhi(pf.w) + bfhi(pb.w);
        float ss = 0.f;
#pragma unroll
        for (int e = 0; e < 8; ++e) ss += x[e] * x[e];
        ss += __shfl_xor(ss, 1); ss += __shfl_xor(ss, 2); ss += __shfl_xor(ss, 4);
        const float rs = rsqrtf(ss * (1.f / 64.f) + EPS);
        const float z[8] = {bflo(zz.x), bfhi(zz.x), bflo(zz.y), bfhi(zz.y), bflo(zz.z), bfhi(zz.z), bflo(zz.w), bfhi(zz.w)};
        const float gg[8] = {g0.x, g0.y, g0.z, g0.w, g1.x, g1.y, g1.z, g1.w};
        float o[8];
#pragma unroll
        for (int e = 0; e < 8; ++e) o[e] = x[e] * rs * gg[e] * silu_f(z[e]);
        const size_t t = th >> 3; const int h = (int)(th & 7);
        *(v4u*)(a.MIX + t * D + h * 64 + d0) = (v4u){cvtpk(o[0], o[1]), cvtpk(o[2], o[3]), cvtpk(o[4], o[5]), cvtpk(o[6], o[7])};
    }
}

namespace pp {
constexpr int I_K = 0, I_Q = 9216, I_V = 18432, I_KT = 27648  , INP = 46080;
constexpr int W_BASE = 2 * INP, W_UT = 0, W_WT = 9216, W_MT = 18432, W_ML = 26624, W_DIR = 29184;
constexpr int G_BASE = W_BASE + 2 * W_DIR, G_SZ = 2048;
constexpr int WCV_OFF = G_BASE + 4 * G_SZ;
static_assert(WCV_OFF + 3840 <= LDS_BYTES - 16, "prep LDS map");
constexpr int MLP = 40;

template <int B0, int JJ> __device__ __forceinline__ void tri_step(f32x2v (&acc)[32], f32x4 (&mc)[8], const LAS float* MTb) {
    constexpr int j = B0 + JJ;
    f32x4 mn[8];
    if (JJ + 1 < 31) {
#pragma unroll
        for (int i4 = (JJ + 2) / 4; i4 < 8; ++i4) mn[i4] = *(const LAS f32x4*)(MTb + (JJ + 1) * 32 + 4 * i4);
    }
    __builtin_amdgcn_sched_barrier(0);
    const float xj = (j & 1) ? acc[j >> 1].y : acc[j >> 1].x;
    const f32x2v xx = {xj, xj};
#pragma unroll
    for (int i4 = (JJ + 1) / 4; i4 < 8; ++i4) {
        const f32x4 m = mc[i4]; const int ia = B0 + 4 * i4;
        if (ia > j) pkfnma(acc[ia >> 1], (f32x2v){m.x, m.y}, xx);
        else if (ia + 1 > j) acc[ia >> 1].y = fnma(acc[ia >> 1].y, m.y, xj);
        if (ia + 2 > j) pkfnma(acc[(ia >> 1) + 1], (f32x2v){m.z, m.w}, xx);
        else if (ia + 3 > j) acc[(ia >> 1) + 1].y = fnma(acc[(ia >> 1) + 1].y, m.w, xj);
    }
    __builtin_amdgcn_sched_barrier(0);
    if (JJ + 1 < 31) {
#pragma unroll
        for (int i4 = (JJ + 2) / 4; i4 < 8; ++i4) mc[i4] = mn[i4];
    }
}
template <int B0, int... JJ> __device__ __forceinline__ void tri_steps(f32x2v (&acc)[32], f32x4 (&mc)[8], const LAS float* MTb, std::integer_sequence<int, JJ...>) { (tri_step<B0, JJ>(acc, mc, MTb), ...); }
template <int B0> __device__ __forceinline__ void tri32(f32x2v (&acc)[32], const LAS float* MT) {
    const LAS float* MTb = MT + (B0 / 32) * 1024;
    f32x4 mc[8];
#pragma unroll
    for (int i4 = 0; i4 < 8; ++i4) mc[i4] = *(const LAS f32x4*)(MTb + 4 * i4);
    tri_steps<B0>(acc, mc, MTb, std::make_integer_sequence<int, 31>{});
}
__device__ __forceinline__ void solve(const LAS float* MT, const LAS bf16* ML, const LAS bf16* rhs_img, int rev, const LAS float* rscale, LAS bf16* out_img, int lane) {
    f32x2v acc[32];
    const LAS bf16* rp = rhs_img + (rev ? 63 * IMG : 0) + lane; const int rstep = rev ? -IMG : IMG;
#pragma unroll
    for (int k = 0; k < 16; ++k) { acc[k].x = rscale[2 * k] * bf2f(rp[(2 * k) * rstep]); acc[k].y = rscale[2 * k + 1] * bf2f(rp[(2 * k + 1) * rstep]); }
    tri32<0>(acc, MT);
    dn_store32(acc, 0, out_img, lane);
    __builtin_amdgcn_sched_barrier(0);
#pragma unroll
    for (int k = 16; k < 32; ++k) { acc[k].x = rscale[2 * k] * bf2f(rp[(2 * k) * rstep]); acc[k].y = rscale[2 * k + 1] * bf2f(rp[(2 * k + 1) * rstep]); }
    asm volatile("s_waitcnt lgkmcnt(0)" ::: "memory");
    {
        const int col = lane & 31, hh = lane >> 5;
        f32x16 d0, d1;
#pragma unroll
        for (int r = 0; r < 16; ++r) { d0[r] = 0.f; d1[r] = 0.f; }
#pragma unroll
        for (int ks = 0; ks < 2; ++ks) { const bf16x8 af = *(const LAS bf16x8*)(ML + col * MLP + 16 * ks + 8 * hh);
            d0 = MFMA32(af, frag_nat(out_img, col, ks, hh), d0); d1 = MFMA32(af, frag_nat(out_img, 32 + col, ks, hh), d1); }
#pragma unroll
        for (int r = 0; r < 16; ++r) { const float t0 = __shfl_xor(d0[r], 32), t1 = __shfl_xor(d1[r], 32);
            const float n0 = hh ? t1 : d0[r], n1 = hh ? d1[r] : t0; d0[r] = n0; d1[r] = n1; }
#pragma unroll
        for (int r = 0; r < 16; ++r) { const int i0r = 32 + crow(r, 0), i1r = 32 + crow(r, 1);
            if (i0r & 1) acc[i0r >> 1].y -= d0[r]; else acc[i0r >> 1].x -= d0[r];
            if (i1r & 1) acc[i1r >> 1].y -= d1[r]; else acc[i1r >> 1].x -= d1[r]; }
    }
    tri32<32>(acc, MT);
    dn_store32(acc, 1, out_img, lane);
}

__device__ __forceinline__ void gates(const Args& a, LAS float* GT, int item, int dir, int lane) {
    const int chunk = item & 31, h = (item >> 5) & 7, b = item >> 8;
    const int p = dir ? 63 - lane : lane;
    const float* gp = a.GATES + (size_t)(b * S + 64 * chunk + p) * 32;
    const float av = gp[dir * 8 + h], bv = gp[16 + dir * 8 + h];
    const float g = -__expf(a.in[8][dir * 8 + h]) * softplus_f(av + a.in[9][dir * 8 + h]);
    const float beta = sigmoid_f(bv);
    float v = g;
#pragma unroll
    for (int o = 1; o < 64; o <<= 1) { const float u = __shfl_up(v, o); if (lane >= o) v += u; }
    const float gl = __shfl(v, 63);
    const float e = __expf(v);
    GT[lane] = beta; GT[64 + lane] = v; GT[128 + lane] = e; GT[192 + lane] = __expf(gl - v); GT[256 + lane] = beta * e;
    if (lane == 0) GT[320] = __expf(gl);
}
__device__ __forceinline__ void conv(const Args& a, LAS unsigned char* inp, const LAS float* WCV, int item, int t) {
    const int chunk = item & 31, h = (item >> 5) & 7, b = item >> 8;
    const int p = t >> 2, d0 = 16 * (t & 3), s = 64 * chunk + p;
#pragma unroll
    for (int mat = 0; mat < 3; ++mat) {
        float acc[16];
#pragma unroll
        for (int e = 0; e < 16; ++e) acc[e] = 0.f;
#pragma unroll
        for (int tap = 0; tap < 5; ++tap) {
            const int ss = s + tap - 2;
            if (ss >= 0 && ss < S) {
                const bf16* src = a.QKV + (size_t)(b * S + ss) * 1536 + mat * 512 + h * 64 + d0;
                const v4u r0 = *(const v4u*)src, r1 = *(const v4u*)(src + 8);
                const LAS float* wp = WCV + tap * 192 + mat * 64 + d0;
                const f32x4 w0 = *(const LAS f32x4*)wp, w1 = *(const LAS f32x4*)(wp + 4), w2 = *(const LAS f32x4*)(wp + 8), w3 = *(const LAS f32x4*)(wp + 12);
                acc[0] += w0.x * bflo(r0.x); acc[1] += w0.y * bfhi(r0.x); acc[2] += w0.z * bflo(r0.y); acc[3] += w0.w * bfhi(r0.y);
                acc[4] += w1.x * bflo(r0.z); acc[5] += w1.y * bfhi(r0.z); acc[6] += w1.z * bflo(r0.w); acc[7] += w1.w * bfhi(r0.w);
                acc[8] += w2.x * bflo(r1.x); acc[9] += w2.y * bfhi(r1.x); acc[10] += w2.z * bflo(r1.y); acc[11] += w2.w * bfhi(r1.y);
                acc[12] += w3.x * bflo(r1.z); acc[13] += w3.y * bfhi(r1.z); acc[14] += w3.z * bflo(r1.w); acc[15] += w3.w * bfhi(r1.w);
            }
        }
        float ss2 = 0.f;
#pragma unroll
        for (int e = 0; e < 16; ++e) { acc[e] = silu_f(acc[e]); ss2 += acc[e] * acc[e]; }
        if (mat < 2) {
            ss2 += __shfl_xor(ss2, 1); ss2 += __shfl_xor(ss2, 2);
            const float sc = rsqrtf(ss2 + EPS);
#pragma unroll
            for (int e = 0; e < 16; ++e) acc[e] *= sc;
        }
        LAS bf16* img = (LAS bf16*)(inp + (mat == 0 ? I_Q : (mat == 1 ? I_K : I_V))) + p * IMG + d0;
        *(LAS v4u*)img = (v4u){cvtpk(acc[0], acc[1]), cvtpk(acc[2], acc[3]), cvtpk(acc[4], acc[5]), cvtpk(acc[6], acc[7])};
        *(LAS v4u*)(img + 8) = (v4u){cvtpk(acc[8], acc[9]), cvtpk(acc[10], acc[11]), cvtpk(acc[12], acc[13]), cvtpk(acc[14], acc[15])};
    }
}
__device__ __forceinline__ void mkt(LAS unsigned char* lds, LAS unsigned char* inp, int set, int tid) {
    const int lane = tid & 63, wave = tid >> 6, dir = wave & 1, w4 = wave >> 1, col = lane & 31, hh = lane >> 5;
    const LAS bf16* KB = (const LAS bf16*)(inp + I_K);
    const LAS float* GT = (const LAS float*)(lds + G_BASE + (set * 2 + dir) * G_SZ);
    LAS unsigned char* wk = lds + W_BASE + dir * W_DIR;
    if (w4 < 3) {
        const int bi = w4 == 0 ? 0 : 1, bj = w4 == 2 ? 1 : 0;
        const int ra = 32 * bi + col, rb = 32 * bj + col;
        f32x16 acc;
#pragma unroll
        for (int r = 0; r < 16; ++r) acc[r] = 0.f;
#pragma unroll
        for (int ks = 0; ks < 4; ++ks) acc = MFMA32(frag_nat(KB, dir ? 63 - ra : ra, ks, hh), frag_nat(KB, dir ? 63 - rb : rb, ks, hh), acc);
        const int j = 32 * bj + col; const float gcj = GT[64 + j];
        if (w4 == 1) {
            LAS bf16* ML = (LAS bf16*)(wk + W_ML);
#pragma unroll
            for (int r = 0; r < 16; ++r) { const int ip = crow(r, hh), i = 32 + ip; ML[ip * MLP + j] = (bf16)f2bf(GT[i] * acc[r] * __expf(GT[64 + i] - gcj)); }
        } else {
            LAS float* MTb = (LAS float*)(wk + W_MT) + bi * 1024;
#pragma unroll
            for (int r4 = 0; r4 < 4; ++r4) { const int ip0 = 8 * r4 + 4 * hh; f32x4 mv;
#pragma unroll
                for (int k = 0; k < 4; ++k) { const int i = 32 * bi + ip0 + k; mv[k] = (i > j) ? GT[i] * acc[4 * r4 + k] * __expf(GT[64 + i] - gcj) : 0.f; }
                *(LAS f32x4*)(MTb + col * 32 + ip0) = mv; }
        }
    }
    {
        const int p = tid >> 3, d0 = 8 * (tid & 7);
        const v4u kv = *(const LAS v4u*)(KB + p * IMG + d0);
        const float e0 = ((const LAS float*)(lds + G_BASE + (set * 2 + 0) * G_SZ))[192 + p], e1 = ((const LAS float*)(lds + G_BASE + (set * 2 + 1) * G_SZ))[192 + 63 - p];
        LAS bf16* kt0 = (LAS bf16*)(inp + I_KT); LAS bf16* kt1 = (LAS bf16*)(inp + I_KT + 9216);
        const float kf[8] = {bflo(kv.x), bfhi(kv.x), bflo(kv.y), bfhi(kv.y), bflo(kv.z), bfhi(kv.z), bflo(kv.w), bfhi(kv.w)};
#pragma unroll
        for (int e = 0; e < 8; ++e) { kt0[(d0 + e) * IMG + p] = (bf16)f2bf(kf[e] * e0); kt1[(d0 + e) * IMG + 63 - p] = (bf16)f2bf(kf[e] * e1); }
    }
}
__device__ __forceinline__ void stage5(const Args& a, LAS unsigned char* lds, LAS unsigned char* inp, int set, int item, int tid) {
    const int lane = tid & 63, wave = tid >> 6, dir = wave & 1, w4 = wave >> 1, hh = lane >> 5;
    int col5 = lane & 31; asm volatile("" : "+v"(col5));
    const int col = col5;
    const int chunk = item & 31, h = (item >> 5) & 7, b = item >> 8;
    const LAS bf16* KB = (const LAS bf16*)(inp + I_K); const LAS bf16* QB = (const LAS bf16*)(inp + I_Q); const LAS bf16* KT = (const LAS bf16*)(inp + I_KT + dir * 9216);
    LAS unsigned char* wk = lds + W_BASE + dir * W_DIR;
    const LAS bf16* UT = (const LAS bf16*)(wk + W_UT); const LAS bf16* WT = (const LAS bf16*)(wk + W_WT);
    const LAS float* GT = (const LAS float*)(lds + G_BASE + (set * 2 + dir) * G_SZ);
    const int I = w4 >> 1, c = w4 & 1;
    unsigned char* rec = (unsigned char*)a.PREP + ((size_t)((b * 8 + h) * 2 + dir) * 32 + chunk) * PREP_REC;
    bf16x8 Xf[2][2];
    const int i_tok = 32 * I + col, i_row = dir ? 63 - i_tok : i_tok; const float gci = GT[64 + i_tok];
#pragma unroll
    for (int J = 0; J < 2; ++J) {
        if (J <= I) {
            const int jr = 32 * J + col;
            f32x16 acc;
#pragma unroll
            for (int r = 0; r < 16; ++r) acc[r] = 0.f;
#pragma unroll
            for (int ks = 0; ks < 4; ++ks) acc = MFMA32(frag_nat(KB, dir ? 63 - jr : jr, ks, hh), frag_nat(QB, i_row, ks, hh), acc);
#pragma unroll
            for (int r = 0; r < 16; ++r) { const int j = 32 * J + crow(r, hh); acc[r] = (j <= i_tok) ? acc[r] * 0.125f * __expf(gci - GT[64 + j]) : 0.f; }
            Xf[J][0] = pack8(acc, 0); Xf[J][1] = pack8(acc, 1);
        }
    }
    {
        f32x16 acc;
#pragma unroll
        for (int r = 0; r < 16; ++r) acc[r] = 0.f;
#pragma unroll
        for (int J = 0; J < 2; ++J) if (J <= I) {
#pragma unroll
            for (int s = 0; s < 2; ++s) acc = MFMA32(Xf[J][s], frag_kap(UT, 32 * c + col, 32 * J, s, hh), acc); }
        v4u* dst = (v4u*)(rec + 24576 + (I * 2 + c) * 2048 + lane * 32);
        dst[0] = (v4u){cvtpk(acc[0], acc[1]), cvtpk(acc[2], acc[3]), cvtpk(acc[4], acc[5]), cvtpk(acc[6], acc[7])};
        dst[1] = (v4u){cvtpk(acc[8], acc[9]), cvtpk(acc[10], acc[11]), cvtpk(acc[12], acc[13]), cvtpk(acc[14], acc[15])};
    }
    {
        f32x16 acc;
#pragma unroll
        for (int r = 0; r < 16; ++r) acc[r] = 0.f;
#pragma unroll
        for (int J = 0; J < 2; ++J) if (J <= I) {
#pragma unroll
            for (int s = 0; s < 2; ++s) acc = MFMA32(frag_kap(WT, 32 * c + col, 32 * J, s, hh), Xf[J][s], acc); }
        const float ei = GT[128 + i_tok] * 0.125f;
#pragma unroll
        for (int r4 = 0; r4 < 4; ++r4) { const v2u qv = *(const LAS v2u*)(QB + i_row * IMG + 32 * c + 8 * r4 + 4 * hh);
            acc[4 * r4 + 0] = ei * bflo(qv.x) - acc[4 * r4 + 0]; acc[4 * r4 + 1] = ei * bfhi(qv.x) - acc[4 * r4 + 1];
            acc[4 * r4 + 2] = ei * bflo(qv.y) - acc[4 * r4 + 2]; acc[4 * r4 + 3] = ei * bfhi(qv.y) - acc[4 * r4 + 3]; }
        *(bf16x8*)(rec + ((I * 2 + c) * 2 + 0) * 1024 + lane * 16) = pack8(acc, 0);
        *(bf16x8*)(rec + ((I * 2 + c) * 2 + 1) * 1024 + lane * 16) = pack8(acc, 1);
    }
    {
        f32x16 acc;
#pragma unroll
        for (int r = 0; r < 16; ++r) acc[r] = 0.f;
#pragma unroll
        for (int ks = 0; ks < 4; ++ks) acc = MFMA32(frag_nat(WT, 32 * I + col, ks, hh), frag_nat(KT, 32 * c + col, ks, hh), acc);
        const float egl = GT[320];
#pragma unroll
        for (int r = 0; r < 16; ++r) acc[r] = ((32 * I + crow(r, hh)) == (32 * c + col) ? egl : 0.f) - acc[r];
        *(bf16x8*)(rec + 8192 + ((c * 2 + I) * 2 + 0) * 1024 + lane * 16) = pack8(acc, 0);
        *(bf16x8*)(rec + 8192 + ((c * 2 + I) * 2 + 1) * 1024 + lane * 16) = pack8(acc, 1);
    }
    {
        f32x16 acc;
#pragma unroll
        for (int r = 0; r < 16; ++r) acc[r] = 0.f;
#pragma unroll
        for (int ks = 0; ks < 4; ++ks) acc = MFMA32(frag_nat(KT, 32 * I + col, ks, hh), frag_nat(UT, 32 * c + col, ks, hh), acc);
        v4u* dst = (v4u*)(rec + 16384 + (I * 2 + c) * 2048 + lane * 32);
        dst[0] = (v4u){cvtpk(acc[0], acc[1]), cvtpk(acc[2], acc[3]), cvtpk(acc[4], acc[5]), cvtpk(acc[6], acc[7])};
        dst[1] = (v4u){cvtpk(acc[8], acc[9]), cvtpk(acc[10], acc[11]), cvtpk(acc[12], acc[13]), cvtpk(acc[14], acc[15])};
    }
}
}

__device__ __forceinline__ void p3_dnprep2(const Args& a, LAS unsigned char* lds, int tid, int G, int bid) {
    using namespace pp;
    const int NIT = NB * NH * 32;
    LAS float* WCV = (LAS float*)(lds + WCV_OFF);
    const int wave = tid >> 6, lane = tid & 63;
    if (bid >= NIT) return;
    const int h0 = (bid >> 5) & 7;
    __syncthreads();
    for (int i = tid; i < 5 * 192; i += NTHR) { const int tp = i / 192, cc = i % 192; WCV[i] = a.in[7][tp * 1536 + (cc >> 6) * 512 + h0 * 64 + (cc & 63)]; }
    if (wave == 4 || wave == 5) gates(a, (LAS float*)(lds + G_BASE + (0 * 2 + (wave - 4)) * G_SZ), bid, wave - 4, lane);
    __syncthreads();
    if (wave >= 4) conv(a, lds + 0 * INP, WCV, bid, tid - 256);
    __syncthreads();
    mkt(lds, lds + 0 * INP, 0, tid);
    __syncthreads();
    int k = 0;
    for (int item = bid; item < NIT; item += G, ++k) {
        const int set = k & 1, nitem = item + G;
        LAS unsigned char* inp = lds + set * INP; LAS unsigned char* ninp = lds + (set ^ 1) * INP;
        if (wave < 4) {
            const int dir = wave & 1, w4 = wave >> 1;
            LAS unsigned char* wk = lds + W_BASE + dir * W_DIR;
            const LAS float* GT = (const LAS float*)(lds + G_BASE + (set * 2 + dir) * G_SZ);
            solve((const LAS float*)(wk + W_MT), (const LAS bf16*)(wk + W_ML), (const LAS bf16*)(inp + (w4 == 0 ? I_V : I_K)), dir, w4 == 0 ? GT : GT + 256, (LAS bf16*)(wk + (w4 == 0 ? W_UT : W_WT)), lane);
        } else if (nitem < NIT) {
            if (((nitem >> 5) & 7) != h0) { for (int i = tid - 256; i < 5 * 192; i += 256) { const int tp = i / 192, cc = i % 192; WCV[i] = a.in[7][tp * 1536 + (cc >> 6) * 512 + ((nitem >> 5) & 7) * 64 + (cc & 63)]; } }
            if (wave < 6) gates(a, (LAS float*)(lds + G_BASE + ((set ^ 1) * 2 + (wave - 4)) * G_SZ), nitem, wave - 4, lane);
            conv(a, ninp, WCV, nitem, tid - 256);
        }
        __syncthreads();
        stage5(a, lds, inp, set, item, tid);
        __syncthreads();
        if (nitem < NIT) mkt(lds, ninp, set ^ 1, tid);
        __syncthreads();
    }
}

struct EpiY {
    static constexpr bool PERM = true, AFTER_DRAIN = false;
    bf16* C; int ldc;
    __device__ __forceinline__ void operator()(const pg8::f32x4 (&acc)[2][2][4][2], const pg8::Unit& u, int wr, int wc, int fr, int fq) const {
        const int row0 = u.pm * 256 + wr * 64 + fr, col0 = u.pn * 256 + wc * 32 + 8 * fq;
#pragma unroll
        for (int ai = 0; ai < 2; ++ai)
#pragma unroll
            for (int m = 0; m < 4; ++m) { bf16* rowp = C + (size_t)(row0 + ai * 128 + m * 16) * ldc + col0;
#pragma unroll
                for (int bj = 0; bj < 2; ++bj) { const pg8::f32x4 v0 = acc[ai][bj][m][0], v1 = acc[ai][bj][m][1];
                    *(v4u*)(rowp + bj * 128) = (v4u){cvtpk(v0[0], v0[1]), cvtpk(v0[2], v0[3]), cvtpk(v1[0], v1[1]), cvtpk(v1[2], v1[3])}; } }
    }
};

constexpr int P7_HT = 0, P7_LGP = 131072, P7_LC = P7_LGP + 2 * 64 * 48 * 4;
__device__ __forceinline__ void p7_mid(const Args& a, LAS unsigned char* lds, int tid, int G, int bid) {
    const int lane = tid & 63, wave = tid >> 6;
    const float* gpost = a.in[5]; const float* gpre = a.in[13];
    for (int blk = bid; blk < T / 64; blk += G) {
        const int row0 = blk * 64;
        __syncthreads();
        v2u ny[4]; f32x4 nxx[4];
        { const int t0 = row0 + wave * 8;
#pragma unroll
          for (int j = 0; j < 4; ++j) { ny[j] = ((const GAS v2u*)(a.YB + (size_t)t0 * D) + lane)[64 * j]; nxx[j] = ((const GAS f32x4*)(a.in[0] + (size_t)t0 * D) + lane)[64 * j]; } }
        for (int k = 0; k < 8; ++k) {
            const int rl = wave * 8 + k, t = row0 + rl;
            const int b = t / S;
            const float* ad = a.ada + b * 6 * D;
            f32x4 yv[4], xv[4]; float ss = 0.f;
#pragma unroll
            for (int j = 0; j < 4; ++j) { yv[j] = (f32x4){bflo(ny[j].x), bfhi(ny[j].x), bflo(ny[j].y), bfhi(ny[j].y)}; xv[j] = nxx[j]; }
            if (k + 1 < 8) {
#pragma unroll
                for (int j = 0; j < 4; ++j) { ny[j] = ((const GAS v2u*)(a.YB + (size_t)(t + 1) * D) + lane)[64 * j]; nxx[j] = ((const GAS f32x4*)(a.in[0] + (size_t)(t + 1) * D) + lane)[64 * j]; } }
#pragma unroll
            for (int j = 0; j < 4; ++j) ss += (yv[j].x * yv[j].x + yv[j].y * yv[j].y) + (yv[j].z * yv[j].z + yv[j].w * yv[j].w);
            const float rstd = rsqrtf(wave_sum(ss) * (1.f / D) + EPS);
            float s2 = 0.f;
#pragma unroll
            for (int j = 0; j < 4; ++j) { const int kk = 4 * lane + 256 * j;
                const f32x4 gp = *(const f32x4*)(gpost + kk), gt = *(const f32x4*)(ad + 2 * D + kk);
                xv[j].x += gt.x * (yv[j].x * rstd * gp.x); xv[j].y += gt.y * (yv[j].y * rstd * gp.y); xv[j].z += gt.z * (yv[j].z * rstd * gp.z); xv[j].w += gt.w * (yv[j].w * rstd * gp.w);
                s2 += (xv[j].x * xv[j].x + xv[j].y * xv[j].y) + (xv[j].z * xv[j].z + xv[j].w * xv[j].w);
                ((GAS f32x4*)(a.X1 + (size_t)t * D) + lane)[64 * j] = xv[j]; }
            const float rstd2 = rsqrtf(wave_sum(s2) * (1.f / D) + EPS);
            GAS v2u* h8 = (GAS v2u*)(a.H2 + (size_t)t * D) + lane;
#pragma unroll
            for (int j = 0; j < 4; ++j) { const int kk = 4 * lane + 256 * j;
                const f32x4 gp = *(const f32x4*)(gpre + kk), sc = *(const f32x4*)(ad + 4 * D + kk), sh = *(const f32x4*)(ad + 3 * D + kk);
                const float h0 = xv[j].x * rstd2 * gp.x * (1.f + sc.x) + sh.x, h1 = xv[j].y * rstd2 * gp.y * (1.f + sc.y) + sh.y;
                const float h2v = xv[j].z * rstd2 * gp.z * (1.f + sc.z) + sh.z, h3 = xv[j].w * rstd2 * gp.w * (1.f + sc.w) + sh.w;
                const v2u pk = (v2u){cvtpk(h0, h1), cvtpk(h2v, h3)};
                h8[64 * j] = pk;
                *(LAS v2u*)(lds + P7_HT + rl * 2048 + ((((kk >> 3) ^ (rl & 15)) << 4) | ((lane & 1) << 3))) = pk; }
        }
        __syncthreads();
        {
            const int tt = wave & 3, kh = wave >> 2, q = lane & 15, g = lane >> 4, rl = 16 * tt + q;
            const bf16* whi = a.WrT + (size_t)q * D + 8 * g; const bf16* wlo = whi + 48 * D;
            f32x4 acc[3];
#pragma unroll
            for (int ot = 0; ot < 3; ++ot) acc[ot] = (f32x4){0.f, 0.f, 0.f, 0.f};
#pragma unroll 1
            for (int ks4 = 0; ks4 < 4; ++ks4) {
                bf16x8 ah[4][3], al[4][3], bfr[4];
#pragma unroll
                for (int kk = 0; kk < 4; ++kk) { const int ks = kh * 16 + ks4 * 4 + kk;
#pragma unroll
                    for (int ot = 0; ot < 3; ++ot) { ah[kk][ot] = *(const bf16x8*)(whi + (size_t)(16 * ot) * D + 32 * ks); al[kk][ot] = *(const bf16x8*)(wlo + (size_t)(16 * ot) * D + 32 * ks); }
                    bfr[kk] = *(const LAS bf16x8*)(lds + P7_HT + rl * 2048 + (((ks * 4 + g) ^ (rl & 15)) << 4)); }
#pragma unroll
                for (int kk = 0; kk < 4; ++kk)
#pragma unroll
                    for (int ot = 0; ot < 3; ++ot) { acc[ot] = __builtin_amdgcn_mfma_f32_16x16x32_bf16(ah[kk][ot], bfr[kk], acc[ot], 0, 0, 0); acc[ot] = __builtin_amdgcn_mfma_f32_16x16x32_bf16(al[kk][ot], bfr[kk], acc[ot], 0, 0, 0); }
            }
            LAS float* lgp = (LAS float*)(lds + P7_LGP) + (kh * 64 + rl) * 48 + 4 * g;
#pragma unroll
            for (int ot = 0; ot < 3; ++ot) *(LAS f32x4*)(lgp + 16 * ot) = acc[ot];
        }
        LAS int* LC = (LAS int*)(lds + P7_LC);
        if (tid < 64) LC[tid] = 0;
        __syncthreads();
        int e1 = 0, e2 = 0, q1 = 0, q2 = 0; float w1 = 0.f, w2 = 0.f;
        if (tid < 64) {
            const LAS float* l0 = (const LAS float*)(lds + P7_LGP) + tid * 48; const LAS float* l1 = l0 + 64 * 48;
            float lg[36];
#pragma unroll
            for (int o = 0; o < 36; ++o) lg[o] = l0[o] + l1[o] + (o < 4 ? a.in[16][o] : a.in[18][o - 4]);
            int g = 0; float gm = lg[0];
#pragma unroll
            for (int j = 1; j < 4; ++j) if (lg[j] > gm) { gm = lg[j]; g = j; }
            float gs = 0.f;
#pragma unroll
            for (int j = 0; j < 4; ++j) gs += __expf(lg[j] - gm);
            const float gpv = 1.f / gs;
            float el[8];
#pragma unroll
            for (int j = 0; j < 8; ++j) el[j] = g == 0 ? lg[4 + j] : (g == 1 ? lg[12 + j] : (g == 2 ? lg[20 + j] : lg[28 + j]));
            int i1 = 0; float l1v = el[0];
#pragma unroll
            for (int j = 1; j < 8; ++j) if (el[j] > l1v) { l1v = el[j]; i1 = j; }
            int i2 = -1; float l2v = -1e30f;
#pragma unroll
            for (int j = 0; j < 8; ++j) if (j != i1 && el[j] > l2v) { l2v = el[j]; i2 = j; }
            const float p2 = __expf(l2v - l1v);
            w1 = gpv / (1.f + p2); w2 = gpv * p2 / (1.f + p2);
            e1 = g * 8 + i1; e2 = g * 8 + i2;
            q1 = atomicAdd((int*)&LC[e1], 1); q2 = atomicAdd((int*)&LC[e2], 1);
        }
        __syncthreads();
        if (tid < NE) { const int c = LC[tid]; LC[32 + tid] = c ? atomicAdd(&a.cnt[tid], c) : 0; }
        __syncthreads();
        if (tid < 64) {
            const int trow = row0 + tid;
            q1 += LC[32 + e1]; q2 += LC[32 + e2];
            a.tok_w[trow * 2] = w1; a.tok_w[trow * 2 + 1] = w2;
            a.perm[(size_t)e1 * 2 * T + q1] = 2 * trow; a.perm[(size_t)e2 * 2 * T + q2] = 2 * trow + 1;
        }
    }
}

__device__ __forceinline__ void p4_moe_weights(const Args& a, LAS float* scr, int widx, int nw, int lane) {
    for (int it = widx; it < 24576; it += nw) {
        if (it < 16384) { const int e = it >> 9, src = (it >> 8) & 1, kb = (it >> 4) & 15, nb = it & 15, n0 = nb * 32;
            transpose_item((src ? a.in[20] : a.in[19]) + (size_t)e * D * DE, DE, n0, kb * 64, a.WguT + (size_t)e * 1024 * 1024, 1024, 256 * (n0 >> 7) + 128 * src + (n0 & 127), scr, lane);
        } else { const int r = it - 16384, e = r >> 8, kb = (r >> 5) & 7, nb = r & 31;
            transpose_item(a.in[21] + (size_t)e * DE * D, D, nb * 32, kb * 64, a.WdT + (size_t)e * 1024 * 512, 512, nb * 32, scr, lane); }
    }
}

constexpr int MOE_TB_OFF = RING_BYTES, MOE_TOK_OFF = RING_BYTES + 2048;
struct MoeOrder {
    const LAS int* TB; int lo, hi, j, gs;
    __device__ __forceinline__ void init(const LAS int* tb, int G, int bid) { TB = tb; const int NU = tb[0] * 4, x = bid & 7; lo = (x * NU) >> 3; hi = ((x + 1) * NU) >> 3; j = bid >> 3; gs = G >> 3; }
    __device__ __forceinline__ bool next(int i, pg8::Unit& u) const { const int L = lo + i * gs + j; if (L >= hi) return false; const int rt = L >> 2; u.pm = rt; u.pn = TB[4 + rt] * 4 + (L & 3); return true; }
    __device__ __forceinline__ void a_ready(const pg8::Unit&) const {}
    __device__ __forceinline__ void done(const pg8::Unit&) const {}
};
__device__ __forceinline__ void moe_setup(const Args& a, LAS unsigned char* lds, int tid, int G, int bid, bool need_tok) {
    LAS int* TB = (LAS int*)(lds + MOE_TB_OFF); LAS int* TOK = (LAS int*)(lds + MOE_TOK_OFF);
    __syncthreads();
    if (tid < NE) { int start = 0; for (int q = 0; q < tid; ++q) start += (a.cnt[q] + 255) >> 8; const int n = (a.cnt[tid] + 255) >> 8;
        for (int i = 0; i < n; ++i) { TB[4 + start + i] = tid; TB[164 + start + i] = i; }
        if (tid == NE - 1) TB[0] = start + n; }
    __syncthreads();
    if (need_tok) {
        MoeOrder O; O.init(TB, G, bid);
        for (int ui = 0; ui < 3; ++ui) { pg8::Unit u; if (!O.next(ui, u)) break;
            if (tid < 256) { const int e = u.pn >> 2, idx = 256 * TB[164 + u.pm] + tid; int pr = -1; if (idx < a.cnt[e]) pr = a.perm[(size_t)e * 2 * T + idx];
                TOK[ui * 256 + tid] = pr < 0 ? 0 : (pr >> 1); } }
        __syncthreads();
    }
}
struct EpiSwiglu {
    static constexpr bool PERM = true, AFTER_DRAIN = false;
    bf16* HE;
    __device__ __forceinline__ void operator()(const pg8::f32x4 (&acc)[2][2][4][2], const pg8::Unit& u, int wr, int wc, int fr, int fq) const {
        const int row0 = u.pm * 256 + wr * 64 + fr, col0 = (u.pn & 3) * 128 + wc * 32 + 8 * fq;
#pragma unroll
        for (int ai = 0; ai < 2; ++ai)
#pragma unroll
            for (int m = 0; m < 4; ++m) { bf16* rowp = HE + (size_t)(row0 + ai * 128 + m * 16) * DE + col0;
                const pg8::f32x4 g0 = acc[ai][0][m][0], g1 = acc[ai][0][m][1], u0 = acc[ai][1][m][0], u1 = acc[ai][1][m][1];
                v4u w; w.x = cvtpk(silu_f(g0[0]) * u0[0], silu_f(g0[1]) * u0[1]); w.y = cvtpk(silu_f(g0[2]) * u0[2], silu_f(g0[3]) * u0[3]);
                w.z = cvtpk(silu_f(g1[0]) * u1[0], silu_f(g1[1]) * u1[1]); w.w = cvtpk(silu_f(g1[2]) * u1[2], silu_f(g1[3]) * u1[3]);
                *(v4u*)rowp = w; }
    }
};
struct EpiScatter {
    static constexpr bool PERM = true, AFTER_DRAIN = false;
    bf16* Y2S; const int* perm; const float* tokw; const int* cnt; const LAS int* TB;
    __device__ __forceinline__ void operator()(const pg8::f32x4 (&acc)[2][2][4][2], const pg8::Unit& u, int wr, int wc, int fr, int fq) const {
        const int e = u.pn >> 2, lt = TB[164 + u.pm], ce = cnt[e];
        const int col0 = (u.pn & 3) * 256 + wc * 32 + 8 * fq;
#pragma unroll
        for (int ai = 0; ai < 2; ++ai)
#pragma unroll
            for (int m = 0; m < 4; ++m) { const int idx = 256 * lt + ai * 128 + wr * 64 + m * 16 + fr;
                if (idx < ce) { const int pr = perm[(size_t)e * 2 * T + idx]; const float w = tokw[pr];
                    bf16* rowp = Y2S + ((size_t)(pr & 1) * T + (pr >> 1)) * D + col0;
#pragma unroll
                    for (int bj = 0; bj < 2; ++bj) { const pg8::f32x4 v0 = acc[ai][bj][m][0], v1 = acc[ai][bj][m][1];
                        *(v4u*)(rowp + bj * 128) = (v4u){cvtpk(w * v0[0], w * v0[1]), cvtpk(w * v0[2], w * v0[3]), cvtpk(w * v1[0], w * v1[1]), cvtpk(w * v1[2], w * v1[3])}; } } }
    }
};
__device__ __forceinline__ void p10_final(const Args& a, int tid, int G, int bid) {
    const int lane = tid & 63, wave = tid >> 6;
    const float* gpost = a.in[14];
    const int t00 = bid * NWAVES + wave, tstep = G * NWAVES;
    v2u na[4], nb[4]; f32x4 nx[4];
    if (t00 < T) {
#pragma unroll
        for (int j = 0; j < 4; ++j) { na[j] = ((const GAS v2u*)(a.Y2S + (size_t)t00 * D) + lane)[64 * j]; nb[j] = ((const GAS v2u*)(a.Y2S + ((size_t)T + t00) * D) + lane)[64 * j]; nx[j] = ((const GAS f32x4*)(a.out + (size_t)t00 * D) + lane)[64 * j]; } }
    for (int t = t00; t < T; t += tstep) {
        const float* ad = a.ada + (t / S) * 6 * D + 5 * D;
        v2u pa[4], pb[4]; f32x4 xin[4];
#pragma unroll
        for (int j = 0; j < 4; ++j) { pa[j] = na[j]; pb[j] = nb[j]; xin[j] = nx[j]; }
        if (t + tstep < T) { const size_t tn = (size_t)t + tstep;
#pragma unroll
            for (int j = 0; j < 4; ++j) { na[j] = ((const GAS v2u*)(a.Y2S + tn * D) + lane)[64 * j]; nb[j] = ((const GAS v2u*)(a.Y2S + ((size_t)T + tn) * D) + lane)[64 * j]; nx[j] = ((const GAS f32x4*)(a.out + tn * D) + lane)[64 * j]; } }
        f32x4 yv[4]; float ss = 0.f;
#pragma unroll
        for (int j = 0; j < 4; ++j) { const v2u p = pa[j], q = pb[j];
            yv[j].x = bflo(p.x) + bflo(q.x); yv[j].y = bfhi(p.x) + bfhi(q.x); yv[j].z = bflo(p.y) + bflo(q.y); yv[j].w = bfhi(p.y) + bfhi(q.y);
            ss += (yv[j].x * yv[j].x + yv[j].y * yv[j].y) + (yv[j].z * yv[j].z + yv[j].w * yv[j].w); }
        const float rstd = rsqrtf(wave_sum(ss) * (1.f / D) + EPS);
        GAS f32x4* xo = (GAS f32x4*)(a.out + (size_t)t * D) + lane;
#pragma unroll
        for (int j = 0; j < 4; ++j) { const int k = 4 * lane + 256 * j; const f32x4 gp = *(const f32x4*)(gpost + k), gt = *(const f32x4*)(ad + k); f32x4 x = xin[j];
            x.x += gt.x * (yv[j].x * rstd * gp.x); x.y += gt.y * (yv[j].y * rstd * gp.y); x.z += gt.z * (yv[j].z * rstd * gp.z); x.w += gt.w * (yv[j].w * rstd * gp.w);
            xo[64 * j] = x; }
    }
}

namespace cg = cooperative_groups;
__global__ void __launch_bounds__(NTHR, 2) mega(Args args) {
    extern __shared__ __attribute__((aligned(16))) unsigned char lds_raw[];
    LAS unsigned char* lds = (LAS unsigned char*)lds_raw;
    const int tid = threadIdx.x, G = gridDim.x, bid = blockIdx.x;
    const int lo = args.ph_lo, hi = args.ph_hi;
    cg::grid_group grid = cg::this_grid();
#define IN(k) (lo <= (k) && (k) < hi)
    volatile LAS unsigned* bst = (volatile LAS unsigned*)(lds + LDS_BYTES - 16);
    if (tid == 0) { bst[0] = 0u; bst[1] = 0u; }
    __syncthreads();
    const XcdBarrier xb = xcd_barrier_post(args.bar, bst);
#ifndef CG_SEAM
#define CG_SEAM 99
#endif
#define SEAM(k) do { if (IN(k) && IN((k) + 1)) { if ((k) == CG_SEAM) grid.sync(); else xcd_barrier(xb); } } while (0)
    if (IN(0)) { p0_prologue(args, lds, tid, G, bid); }
    SEAM(0);
    if (IN(1)) { p1_rows(args, tid, G, bid); }
    SEAM(1);
    if (IN(2)) {
        pg8::Gemm g{args.H, args.WinT, T, NIN, D}; pg8::StaticOrder So; So.init(T, NIN, G, bid);
        EpiG1 E{args.QKV, args.Z, args.NAQ, args.NAK, args.NAVT, args.GATES};
        pg8::gemm_phase<EpiG1, pg8::StaticOrder, true, true>(lds, g, So, E);
    }
    SEAM(2);
    if (IN(3)) { p3_dnprep2(args, lds, tid, G, bid); __syncthreads(); p3_na(args, lds, tid, G, bid); }
    SEAM(3);
    if (IN(4)) {
        if ((tid >> 6) == 0) { for (int id = bid; id < 256; id += G) p4_scan_wave(args, lds, id, tid & 63); }
        else p4_moe_weights(args, (LAS float*)(lds + (tid >> 6) * 8704), bid * 7 + (tid >> 6) - 1, G * 7, tid & 63);
    }
    SEAM(4);
    if (IN(5)) { p4b_dnout(args, tid, G, bid); }
    SEAM(5);
    if (IN(6)) {
        pg8::Gemm g{args.MIX, args.WoutT, T, D, D}; pg8::StaticOrder So; So.init(T, D, G, bid);
        EpiY E{args.YB, D};
        pg8::gemm_phase<EpiY, pg8::StaticOrder, true, true>(lds, g, So, E);
    }
    SEAM(6);
    if (IN(7)) { p7_mid(args, lds, tid, G, bid); }
    SEAM(7);
    if (IN(8)) {
        moe_setup(args, lds, tid, G, bid, true);
        pg8::Gemm g{args.H2, args.WguT, 0, 0, D}; MoeOrder Mo; Mo.init((const LAS int*)(lds + MOE_TB_OFF), G, bid);
        EpiSwiglu E{args.HE};
        pg8::gemm_phase_gather<EpiSwiglu, MoeOrder, true>(lds, g, (const LAS int*)(lds + MOE_TOK_OFF), Mo, E);
    }
    SEAM(8);
    if (IN(9)) {
        moe_setup(args, lds, tid, G, bid, false);
        pg8::Gemm g{args.HE, args.WdT, 0, 0, DE}; MoeOrder Mo; Mo.init((const LAS int*)(lds + MOE_TB_OFF), G, bid);
        EpiScatter E{args.Y2S, args.perm, args.tok_w, args.cnt, (const LAS int*)(lds + MOE_TB_OFF)};
        pg8::gemm_phase<EpiScatter, MoeOrder, true, true>(lds, g, Mo, E);
    }
    SEAM(9);
    if (IN(10)) { p10_final(args, tid, G, bid); }
#undef IN
#undef SEAM
}

static void fill_args(Args& a, void* const* d_in, void* d_out, void* d_ws) {
    const size_t MiB = 1u << 20; unsigned char* ws = (unsigned char*)d_ws;
    for (int i = 0; i < 22; ++i) a.in[i] = (const float*)d_in[i];
    a.out = (float*)d_out; a.ws = ws;
    a.bar = (unsigned*)(ws + 4096); a.cnt = (int*)ws;
    a.ada = (float*)(ws + 1 * MiB); a.tok_w = (float*)(ws + 1 * MiB + 256 * 1024); a.tok_e = (int*)(ws + 1 * MiB + 384 * 1024); a.tok_pos = (int*)(ws + 1 * MiB + 512 * 1024);
    a.WinT = (bf16*)(ws + 2 * MiB); a.WoutT = (bf16*)(ws + 10 * MiB); a.WrT = (bf16*)(ws + 1 * MiB + 640 * 1024);
    a.H = (bf16*)(ws + 12 * MiB); a.PREP = (bf16*)(ws + 12 * MiB); a.HE = (bf16*)(ws + 12 * MiB); a.Y2S = (bf16*)(ws + 52 * MiB);
    a.QKV = (bf16*)(ws + 140 * MiB); a.NAQ = (bf16*)(ws + 188 * MiB); a.NAK = (bf16*)(ws + 204 * MiB); a.NAVT = (bf16*)(ws + 220 * MiB);
    a.WguT = (bf16*)(ws + 140 * MiB); a.WdT = (bf16*)(ws + 204 * MiB);
    a.Z = (bf16*)(ws + 236 * MiB); a.GATES = (float*)(ws + 252 * MiB); a.MIX = (bf16*)(ws + 254 * MiB); a.H2 = (bf16*)(ws + 236 * MiB);
    a.perm = (int*)(ws + 286 * MiB);
    a.Y = (float*)d_out; a.X1 = (float*)d_out; a.YB = (bf16*)(ws + 12 * MiB);
}
extern "C" void kernel_launch(void* const* d_in, const int* in_sizes, int n_in, void* d_out, int out_size, void* d_ws, size_t ws_size, hipStream_t stream) {
    const size_t MiB = 1u << 20;
    if (ws_size < (size_t)290 * MiB) { fprintf(stderr, "kernel_launch: workspace too small: %zu\n", ws_size); return; }
    static int attr_done = 0;
    if (!attr_done) { (void)hipFuncSetAttribute((const void*)mega, hipFuncAttributeMaxDynamicSharedMemorySize, LDS_BYTES); attr_done = 1; }
    (void)hipMemsetAsync(d_ws, 0, 1 * MiB, stream);
    Args a{};
    fill_args(a, d_in, d_out, d_ws);
    a.ph_lo = 0; a.ph_hi = 11;
    static int grid_blocks = 0;
    if (!grid_blocks) { int dev = 0, cus = 0, per_cu = 0; (void)hipGetDevice(&dev); (void)hipDeviceGetAttribute(&cus, hipDeviceAttributeMultiprocessorCount, dev);
        (void)hipOccupancyMaxActiveBlocksPerMultiprocessor(&per_cu, (const void*)mega, NTHR, LDS_BYTES);
        if (per_cu < 1) { fprintf(stderr, "kernel_launch: occupancy query says %d blocks per CU\n", per_cu); per_cu = 1; }
        if (per_cu > 1) per_cu = 1;
        grid_blocks = cus * per_cu; if (grid_blocks % 8) grid_blocks -= grid_blocks % 8; }
    void* kargs[] = {&a};
    hipError_t e = hipLaunchCooperativeKernel((const void*)mega, dim3(grid_blocks), dim3(NTHR), kargs, LDS_BYTES, stream);
    if (e != hipSuccess) fprintf(stderr, "kernel_launch: cooperative launch failed: %s (grid %d)\n", hipGetErrorString(e), grid_blocks);
}
```

```cpp
#include <hip/hip_runtime.h>
#include <cstdio>
#include <cstdint>
#include <utility>

constexpr int D = 1024, NB = 8, S = 2048, T = NB * S;
constexpr int HD = 64, NH = 8, DNW = 512, NAW = 512;
constexpr int INW = 3616;
constexpr int GW = 64, ROWS = S / GW;
constexpr int NE = 32, DE = 512;
constexpr float EPS = 1e-6f;
constexpr int SEGPAD = 256;
constexpr int MAXROWS = 2 * T + NE * SEGPAD;

constexpr int C_Q = 0, C_K = 512, C_V = 1024, C_Z = 1536, C_AF = 2048, C_AB = 2056, C_BF = 2064, C_BB = 2072, C_NQ = 2080, C_NK = 2592, C_NV = 3104;

__device__ __forceinline__ float silu_f(float x) { return x * __builtin_amdgcn_rcpf(1.f + __expf(-x)); }
__device__ __forceinline__ float sigmoid_f(float x) { return __builtin_amdgcn_rcpf(1.f + __expf(-x)); }
__device__ __forceinline__ float softplus_f(float x) { return x > 20.f ? x : log1pf(__expf(x)); }

__device__ __forceinline__ float wave_sum(float v) {
#pragma unroll
    for (int o = 1; o < 64; o <<= 1) v += __shfl_xor(v, o);
    return v;
}
__device__ __forceinline__ float block_sum256(float v, float* red) {
    v = wave_sum(v);
    __syncthreads();
    if ((threadIdx.x & 63) == 0) red[threadIdx.x >> 6] = v;
    __syncthreads();
    return red[0] + red[1] + red[2] + red[3];
}


#include <hip/hip_cooperative_groups.h>
#define GAS __attribute__((address_space(1)))
#define LAS __attribute__((address_space(3)))
typedef unsigned short bf16;
typedef unsigned v4u __attribute__((ext_vector_type(4)));
typedef unsigned v2u __attribute__((ext_vector_type(2)));
typedef float f32x4 __attribute__((ext_vector_type(4)));
typedef float f32x16 __attribute__((ext_vector_type(16)));
typedef short bf16x8 __attribute__((ext_vector_type(8)));
typedef short bf16x4 __attribute__((ext_vector_type(4)));
#define LDS_WAIT() asm volatile("s_waitcnt lgkmcnt(0)" ::: "memory")
#define VM_WAIT() asm volatile("s_waitcnt vmcnt(0)" ::: "memory")
__device__ __forceinline__ unsigned f2bf(float f) { unsigned u = __builtin_bit_cast(unsigned, f); return (u + 0x7fffu + ((u >> 16) & 1u)) >> 16; }
__device__ __forceinline__ unsigned pk2(float lo, float hi) { return f2bf(lo) | (f2bf(hi) << 16); }
typedef float f32x2_t __attribute__((ext_vector_type(2))); typedef __bf16 bf16x2_t __attribute__((ext_vector_type(2)));
__device__ __forceinline__ unsigned cvtpk(float lo, float hi) { f32x2_t v = {lo, hi}; bf16x2_t b = __builtin_convertvector(v, bf16x2_t); return __builtin_bit_cast(unsigned, b); }
__device__ __forceinline__ float bf2f(unsigned short b) { return __builtin_bit_cast(float, (unsigned)b << 16); }
__device__ __forceinline__ float bflo(unsigned w) { return __builtin_bit_cast(float, w << 16); }
__device__ __forceinline__ float bfhi(unsigned w) { return __builtin_bit_cast(float, w & 0xffff0000u); }

constexpr int NWAVES = 8, NTHR = 512;
constexpr int NIN = 3840;
constexpr int RING_BYTES = 131072;
constexpr int LDS_BYTES = 163840;

struct Args {
    const float* in[22]; float* out; unsigned char* ws;
    float* ada; unsigned* bar;
    bf16* WinT; bf16* WoutT; bf16* WguT; bf16* WdT; bf16* WrT;
    bf16* H; bf16* QKV; bf16* Z; bf16* NAQ; bf16* NAK; bf16* NAVT; float* GATES;
    bf16* PREP; bf16* MIX; float* Y; bf16* YB; float* X1; bf16* H2; bf16* HE; bf16* Y2S;
    int* cnt; int* tok_e; float* tok_w; int* tok_pos; int* perm;
    int ph_lo, ph_hi;
};

template <int CTRL, int RMASK> __device__ __forceinline__ float dppf(float v) { return __builtin_bit_cast(float, __builtin_amdgcn_update_dpp(0, __builtin_bit_cast(int, v), CTRL, RMASK, 0xF, false)); }
__device__ __forceinline__ float wave_sum_hi(float v) {
    v += dppf<0xB1, 0xF>(v); v += dppf<0x4E, 0xF>(v); v += dppf<0x141, 0xF>(v); v += dppf<0x140, 0xF>(v);
    v += dppf<0x142, 0xA>(v); v += dppf<0x143, 0xC>(v);
    return v;
}

#define XB_TMO      128
#define XB_XCNT(j)  (256  + 64 * (j))
#define XB_XSUB(j)  (1280 + 64 * (j))
#define XB_XGEN(j)  (2304 + 64 * (j))
#define XB_TOP      3328
#define XB_TOPGEN   3392
#define XCD_BAR_WORDS 3456
#define XB_SPIN_CAP (1u << 18)

__device__ __forceinline__ unsigned xb_ld(unsigned* p)              { return __hip_atomic_load(p, __ATOMIC_RELAXED, __HIP_MEMORY_SCOPE_AGENT); }
__device__ __forceinline__ unsigned xb_add(unsigned* p, unsigned v) { return __hip_atomic_fetch_add(p, v, __ATOMIC_RELAXED, __HIP_MEMORY_SCOPE_AGENT); }
__device__ __forceinline__ unsigned xb_xcc_id() { return (unsigned)__builtin_amdgcn_s_getreg((3 << 11) | 20) & 0xFu; }
#define XB_SPIN(cond, bar) do { unsigned _sp = 0; while (cond) { __builtin_amdgcn_s_sleep(1); \
    if ((++_sp & 255u) == 0u) { if (xb_ld(&(bar)[XB_TMO])) break; if (_sp > XB_SPIN_CAP) { atomicAdd(&(bar)[XB_TMO], 1u); break; } } } } while (0)

struct XcdBarrier {
    unsigned* bar; unsigned x;
    volatile LAS unsigned* st;
};

__device__ __forceinline__ XcdBarrier xcd_barrier_post(unsigned* bar, volatile LAS unsigned* st) {
    XcdBarrier b; b.bar = bar; b.x = xb_xcc_id(); b.st = st;
    if (threadIdx.x == 0) (void)xb_add(&bar[XB_XCNT(b.x)], 1u);
    return b;
}
__device__ __forceinline__ void xcd_barrier_complete(unsigned* bar, unsigned x, unsigned& nloc, unsigned& nx) {
    const unsigned G = gridDim.x * gridDim.y * gridDim.z;
    unsigned sum, cnt, mine, sp = 0u;
    for (;;) {
        sum = 0u; cnt = 0u; mine = 0u;
#pragma unroll
        for (unsigned j = 0; j < 16; ++j) { const unsigned c = xb_ld(&bar[XB_XCNT(j)]); sum += c; cnt += (c > 0u) ? 1u : 0u; mine = (j == x) ? c : mine; }
        if (sum == G) break;
        __builtin_amdgcn_s_sleep(1);
        if ((++sp & 255u) == 0u) { if (xb_ld(&bar[XB_TMO])) break; if (sp > XB_SPIN_CAP) { atomicAdd(&bar[XB_TMO], 1u); break; } }
    }
    nloc = mine > 0u ? mine : 1u; nx = cnt > 0u ? cnt : 1u;
}

__device__ __forceinline__ void xcd_barrier(const XcdBarrier& b) {
    asm volatile("s_waitcnt vmcnt(0)" ::: "memory");
    __syncthreads();
    if (threadIdx.x == 0) {
        unsigned* bar = b.bar;
        __builtin_amdgcn_s_waitcnt(0);
        unsigned nloc = b.st[0], nx = b.st[1];
        if (nloc == 0u) { xcd_barrier_complete(bar, b.x, nloc, nx); b.st[0] = nloc; b.st[1] = nx; }
        const unsigned old = xb_add(&bar[XB_XSUB(b.x)], 1u);
        const unsigned gen = old / nloc;
        if (old + 1u == (gen + 1u) * nloc) {
            __builtin_amdgcn_fence(__ATOMIC_RELEASE, "agent");
            asm volatile("s_waitcnt vmcnt(0)" ::: "memory");
            const unsigned og = xb_add(&bar[XB_TOP], 1u);
            const unsigned tg = og / nx;
            if (og + 1u == (tg + 1u) * nx) xb_add(&bar[XB_TOPGEN], 1u);
            else XB_SPIN(xb_ld(&bar[XB_TOPGEN]) == tg, bar);
            __builtin_amdgcn_fence(__ATOMIC_ACQUIRE, "agent");
            xb_add(&bar[XB_XGEN(b.x)], 1u);
            asm volatile("s_waitcnt vmcnt(0)" ::: "memory");
        } else {
            XB_SPIN(xb_ld(&bar[XB_XGEN(b.x)]) == gen, bar);
            __builtin_amdgcn_fence(__ATOMIC_ACQUIRE, "agent");
            asm volatile("s_waitcnt vmcnt(0)" ::: "memory");
        }
    }
    __syncthreads();
}

namespace pg8 {
#define PG8_LAS __attribute__((address_space(3)))
typedef unsigned short bf16_t;
typedef short bf16x8 __attribute__((ext_vector_type(8)));
typedef float f32x4 __attribute__((ext_vector_type(4)));
typedef unsigned u32x4 __attribute__((ext_vector_type(4)));
constexpr int BM = 256, BK = 64, HALF = 128, HTB = HALF * BK * 2  , STAGE_BYTES = 8 * HTB, NXCD = 8, WGM = 8;

__host__ __device__ __forceinline__ int lds_byte(int r, int c) { const int st = (r >> 4) * 2 + (c >> 5), rr = r & 15, cc = c & 31, ob = rr * 64 + cc * 2; return st * 1024 + (ob ^ (((ob >> 9) & 1) << 5)); }
__host__ __device__ __forceinline__ void stage_rc(int b, int& R, int& C) { const int st = b / 1024, sb = b % 1024, swz = sb ^ (((sb >> 9) & 1) << 5); R = (st >> 1) * 16 + swz / 64; C = (st & 1) * 32 + (swz % 64) / 2; }
__host__ __device__ __forceinline__ int perm32(int rho) { const int n = rho >> 4, i = rho & 15; return 8 * (i >> 2) + 4 * n + (i & 3); }

struct Unit { int pm, pn; };
struct Gemm { const bf16_t* A; const bf16_t* Bt; int M, N, K; };

struct StaticOrder {
    int nM, nN, nwg, G, c;
    __host__ __device__ void init(int M, int N, int G_, int c_) { nM = M / BM; nN = N / BM; nwg = nM * nN; G = G_; c = c_; }
    __host__ __device__ bool next(int i, Unit& u) const {
        const long L = (long)i * G + c; if (L >= nwg) return false;
        int wgid = (int)L; { const int q = nwg / NXCD, r = nwg % NXCD, xcd = wgid % NXCD, off = wgid / NXCD; wgid = (xcd < r ? xcd * (q + 1) : r * (q + 1) + (xcd - r) * q) + off; }
        const int nig = WGM * nN, gid = wgid / nig, fm = gid * WGM, gsz = (nM - fm) < WGM ? (nM - fm) : WGM;
        u.pm = fm + ((wgid % nig) % gsz); u.pn = (wgid % nig) / gsz; return true;
    }
    __device__ __forceinline__ void a_ready(const Unit&) const {}
    __device__ __forceinline__ void done(const Unit&) const {}
};


__device__ __forceinline__ unsigned cvt_pk_bf16(float lo, float hi) { unsigned r; asm volatile("v_cvt_pk_bf16_f32 %0, %1, %2" : "=v"(r) : "v"(lo), "v"(hi)); return r; }

template <class Epi, class Sched, bool ALIGN_EPI = false, bool SP2 = false>
__device__ __forceinline__ void gemm_phase(PG8_LAS unsigned char* lds, const Gemm g, const Sched& S, const Epi& E) {
    const int tid = threadIdx.x, wid = __builtin_amdgcn_readfirstlane(tid >> 6), lane = tid & 63, wr = wid >> 2, wc = wid & 3, fr = lane & 15, fq = lane >> 4;
    const int K = g.K, nt = K / BK;
    unsigned voffA[2], voffB[2];
#pragma unroll
    for (int i = 0; i < 2; ++i) { int R, C; stage_rc(tid * 16 + i * 8192, R, C); const int Rb = Epi::PERM ? ((R & ~31) + perm32(R & 31)) : R;
        voffA[i] = (unsigned)(R * K + C) * 2u; voffB[i] = (unsigned)(Rb * K + C) * 2u; }
    const size_t kstep = (size_t)(BK * 2);
    const size_t hstep = (size_t)HALF * K * 2;
    const size_t tstep = 2 * hstep;
    const unsigned ldsw = (unsigned)wid * 1024u;
    const int aoff = lds_byte(wr * 64 + fr, fq * 8), boff = lds_byte(wc * 32 + fr, fq * 8);
#define PG8_SA(b, h) (((b) * 2 + (h)) * HTB)
#define PG8_SB(b, h) ((4 + (b) * 2 + (h)) * HTB)
#define PG8_STAGE(bufoff, gbase, voff) do { _Pragma("unroll") for (int _i = 0; _i < 2; ++_i) \
        __builtin_amdgcn_global_load_lds((const unsigned*)((const char*)(gbase) + (voff)[_i]), (PG8_LAS unsigned*)(lds + (bufoff) + ldsw + _i * 8192), 16, 0, 0); } while (0)
#define PG8_LDA(dst, b, h) do { _Pragma("unroll") for (int m = 0; m < 4; ++m) _Pragma("unroll") for (int k = 0; k < 2; ++k) dst[m][k] = *(const PG8_LAS bf16x8*)(lds + PG8_SA(b, h) + aoff + m * 2048 + k * 1024); } while (0)
#define PG8_LDB(dst, b, h) do { _Pragma("unroll") for (int n = 0; n < 2; ++n) _Pragma("unroll") for (int k = 0; k < 2; ++k) dst[n][k] = *(const PG8_LAS bf16x8*)(lds + PG8_SB(b, h) + boff + n * 2048 + k * 1024); } while (0)
#define PG8_MMA(ai, bj, At, Bt) do { __builtin_amdgcn_s_setprio(1); _Pragma("unroll") for (int m = 0; m < 4; ++m) _Pragma("unroll") for (int n = 0; n < 2; ++n) _Pragma("unroll") for (int k = 0; k < 2; ++k) \
        acc[ai][bj][m][n] = __builtin_amdgcn_mfma_f32_16x16x32_bf16(Bt[n][k], At[m][k], acc[ai][bj][m][n], 0, 0, 0); __builtin_amdgcn_s_setprio(0); } while (0)
#define PG8_WAIT_V(n) asm volatile("s_waitcnt vmcnt(" #n ")" ::: "memory")
#define PG8_WAIT_L(n) asm volatile("s_waitcnt lgkmcnt(" #n ")" ::: "memory")
#define PG8_BAR __builtin_amdgcn_s_barrier()
#define PG8_SCHED __builtin_amdgcn_sched_barrier(0)
    Unit cur, nxt; int ui = 0;
    if (!S.next(0, cur)) return;
    f32x4 acc[2][2][4][2];
#pragma unroll
    for (int a = 0; a < 2; ++a)
#pragma unroll
        for (int b = 0; b < 2; ++b)
#pragma unroll
            for (int m = 0; m < 4; ++m)
#pragma unroll
                for (int n = 0; n < 2; ++n) acc[a][b][m][n] = (f32x4){0.f, 0.f, 0.f, 0.f};
    bf16x8 At[4][2], B0[2][2], B1[2][2];
    const char* cA = (const char*)g.A + (size_t)cur.pm * tstep; const char* cB = (const char*)g.Bt + (size_t)cur.pn * tstep;
    S.a_ready(cur);
    if constexpr (SP2) {
        PG8_STAGE(PG8_SB(0, 0), cB, voffB); PG8_STAGE(PG8_SB(0, 1), cB + hstep, voffB); PG8_STAGE(PG8_SA(0, 0), cA, voffA); PG8_STAGE(PG8_SA(0, 1), cA + hstep, voffA);
        if (wr == 1) PG8_BAR;
        PG8_WAIT_V(2); PG8_BAR;
        PG8_STAGE(PG8_SB(1, 0), cB + kstep, voffB); PG8_STAGE(PG8_SA(1, 0), cA + kstep, voffA); PG8_STAGE(PG8_SB(1, 1), cB + hstep + kstep, voffB);
        PG8_WAIT_V(6); PG8_BAR;
    } else {
        PG8_STAGE(PG8_SB(0, 0), cB, voffB); PG8_STAGE(PG8_SA(0, 0), cA, voffA); PG8_STAGE(PG8_SB(0, 1), cB + hstep, voffB); PG8_STAGE(PG8_SA(0, 1), cA + hstep, voffA);
        if (wr == 1) PG8_BAR;
        PG8_WAIT_V(4); PG8_BAR;
        PG8_STAGE(PG8_SB(1, 0), cB + kstep, voffB); PG8_STAGE(PG8_SA(1, 0), cA + kstep, voffA); PG8_STAGE(PG8_SB(1, 1), cB + hstep + kstep, voffB);
        PG8_WAIT_V(6); PG8_BAR;
    }
    for (;;) {
        const bool has_next = S.next(ui + 1, nxt);
        const char* nA = has_next ? (const char*)g.A + (size_t)nxt.pm * tstep : cA; const char* nB = has_next ? (const char*)g.Bt + (size_t)nxt.pn * tstep : cB;
        for (int t = 0; t < nt; t += 2) {
            const bool last = (t == nt - 2);
            const char* a1 = cA + (size_t)(t + 1) * kstep;
            const char* a2 = last ? nA : cA + (size_t)(t + 2) * kstep; const char* b2 = last ? nB : cB + (size_t)(t + 2) * kstep;
            const char* a3 = a2 + kstep; const char* b3 = b2 + kstep;
            if (last && has_next) S.a_ready(nxt);
            if constexpr (SP2) {
            PG8_LDB(B0, 0, 0); PG8_LDB(B1, 0, 1); PG8_SCHED; PG8_LDA(At, 0, 0); PG8_STAGE(PG8_SA(1, 1), a1 + hstep, voffA);
            PG8_WAIT_V(8); PG8_WAIT_L(0); PG8_BAR; PG8_MMA(0, 0, At, B0); PG8_MMA(0, 1, At, B1); PG8_BAR; PG8_SCHED;
            PG8_LDA(At, 0, 1); PG8_STAGE(PG8_SB(0, 0), b2, voffB); PG8_STAGE(PG8_SB(0, 1), b2 + hstep, voffB); PG8_STAGE(PG8_SA(0, 0), a2, voffA);
            PG8_WAIT_V(8); PG8_WAIT_L(0); PG8_BAR; PG8_MMA(1, 0, At, B0); PG8_MMA(1, 1, At, B1); PG8_BAR; PG8_SCHED;
            PG8_LDB(B0, 1, 0); PG8_LDB(B1, 1, 1); PG8_SCHED; PG8_LDA(At, 1, 0); PG8_STAGE(PG8_SA(0, 1), a2 + hstep, voffA);
            PG8_WAIT_V(8); PG8_WAIT_L(0); PG8_BAR; PG8_MMA(0, 0, At, B0); PG8_MMA(0, 1, At, B1); PG8_BAR; PG8_SCHED;
            PG8_LDA(At, 1, 1); PG8_STAGE(PG8_SB(1, 0), b3, voffB); PG8_STAGE(PG8_SB(1, 1), b3 + hstep, voffB); PG8_STAGE(PG8_SA(1, 0), a3, voffA);
            PG8_WAIT_V(8); PG8_WAIT_L(0); PG8_BAR; PG8_MMA(1, 0, At, B0); PG8_MMA(1, 1, At, B1); PG8_BAR; PG8_SCHED;
            } else {
            PG8_LDB(B0, 0, 0); PG8_SCHED; PG8_LDA(At, 0, 0); PG8_STAGE(PG8_SA(1, 1), a1 + hstep, voffA);
            PG8_WAIT_L(8); PG8_BAR; PG8_WAIT_L(0); PG8_MMA(0, 0, At, B0); PG8_BAR; PG8_SCHED;
            PG8_LDB(B1, 0, 1); PG8_STAGE(PG8_SB(0, 0), b2, voffB);
            PG8_BAR; PG8_WAIT_L(0); PG8_MMA(0, 1, At, B1); PG8_BAR;
            PG8_LDA(At, 0, 1); PG8_STAGE(PG8_SA(0, 0), a2, voffA);
            PG8_BAR; PG8_WAIT_L(0); PG8_MMA(1, 0, At, B0); PG8_BAR; PG8_SCHED;
            PG8_STAGE(PG8_SB(0, 1), b2 + hstep, voffB);
            PG8_WAIT_V(6); PG8_BAR; PG8_MMA(1, 1, At, B1); PG8_BAR;
            PG8_LDB(B0, 1, 0); PG8_SCHED; PG8_LDA(At, 1, 0); PG8_STAGE(PG8_SA(0, 1), a2 + hstep, voffA);
            PG8_WAIT_L(8); PG8_BAR; PG8_WAIT_L(0); PG8_MMA(0, 0, At, B0); PG8_BAR; PG8_SCHED;
            PG8_LDB(B1, 1, 1); PG8_STAGE(PG8_SB(1, 0), b3, voffB);
            PG8_BAR; PG8_WAIT_L(0); PG8_MMA(0, 1, At, B1); PG8_BAR;
            PG8_LDA(At, 1, 1); PG8_STAGE(PG8_SA(1, 0), a3, voffA);
            PG8_BAR; PG8_WAIT_L(0); PG8_MMA(1, 0, At, B0); PG8_BAR; PG8_SCHED;
            PG8_STAGE(PG8_SB(1, 1), b3 + hstep, voffB);
            PG8_WAIT_V(6); PG8_BAR; PG8_MMA(1, 1, At, B1); PG8_BAR;
            }
        }
        if constexpr (ALIGN_EPI) { if (wr == 0) PG8_BAR; }
        if constexpr (!Epi::AFTER_DRAIN) { E(acc, cur, wr, wc, fr, fq); S.done(cur); }
        if (!has_next) break;
#pragma unroll
        for (int a = 0; a < 2; ++a)
#pragma unroll
            for (int b = 0; b < 2; ++b)
#pragma unroll
                for (int m = 0; m < 4; ++m)
#pragma unroll
                    for (int n = 0; n < 2; ++n) acc[a][b][m][n] = (f32x4){0.f, 0.f, 0.f, 0.f};
        cur = nxt; cA = nA; cB = nB; ++ui;
        if constexpr (ALIGN_EPI) { if (wr == 1) PG8_BAR; }
    }
    PG8_WAIT_V(0);
    if constexpr (!ALIGN_EPI) { if (wr == 0) PG8_BAR; }
    PG8_BAR;
    if constexpr (Epi::AFTER_DRAIN) { E.fused(acc, cur, wr, wc, fr, fq, lds, wid, lane); S.done(cur); }
#undef PG8_SA
#undef PG8_SB
#undef PG8_STAGE
#undef PG8_LDA
#undef PG8_LDB
#undef PG8_MMA
#undef PG8_WAIT_V
#undef PG8_WAIT_L
#undef PG8_BAR
#undef PG8_SCHED
}
}

namespace pg8 {
template <class Epi, class Sched, bool ALIGN_EPI>
__device__ __forceinline__ void gemm_phase_gather(PG8_LAS unsigned char* lds, const Gemm g, const PG8_LAS int* tok, const Sched& S, const Epi& E) {
    const int tid = threadIdx.x, wid = __builtin_amdgcn_readfirstlane(tid >> 6), lane = tid & 63, wr = wid >> 2, wc = wid & 3, fr = lane & 15, fq = lane >> 4;
    const int K = g.K, nt = K / BK;
    unsigned voffB[2]; int RA[2], CA[2];
#pragma unroll
    for (int i = 0; i < 2; ++i) { int R, C; stage_rc(tid * 16 + i * 8192, R, C); const int Rb = Epi::PERM ? ((R & ~31) + perm32(R & 31)) : R;
        RA[i] = R; CA[i] = C; voffB[i] = (unsigned)(Rb * K + C) * 2u; }
    const size_t kstep = (size_t)(BK * 2);
    const size_t hstep = (size_t)HALF * K * 2;
    const size_t tstep = 2 * hstep;
    const unsigned ldsw = (unsigned)wid * 1024u;
    const int aoff = lds_byte(wr * 64 + fr, fq * 8), boff = lds_byte(wc * 32 + fr, fq * 8);
#define PG8_SA(b, h) (((b) * 2 + (h)) * HTB)
#define PG8_SB(b, h) ((4 + (b) * 2 + (h)) * HTB)
#define PG8_STAGE(bufoff, gbase, voff) do { _Pragma("unroll") for (int _i = 0; _i < 2; ++_i) \
        __builtin_amdgcn_global_load_lds((const unsigned*)((const char*)(gbase) + (voff)[_i]), (PG8_LAS unsigned*)(lds + (bufoff) + ldsw + _i * 8192), 16, 0, 0); } while (0)
#define PG8_LDA(dst, b, h) do { _Pragma("unroll") for (int m = 0; m < 4; ++m) _Pragma("unroll") for (int k = 0; k < 2; ++k) dst[m][k] = *(const PG8_LAS bf16x8*)(lds + PG8_SA(b, h) + aoff + m * 2048 + k * 1024); } while (0)
#define PG8_LDB(dst, b, h) do { _Pragma("unroll") for (int n = 0; n < 2; ++n) _Pragma("unroll") for (int k = 0; k < 2; ++k) dst[n][k] = *(const PG8_LAS bf16x8*)(lds + PG8_SB(b, h) + boff + n * 2048 + k * 1024); } while (0)
#define PG8_MMA(ai, bj, At, Bt) do { __builtin_amdgcn_s_setprio(1); _Pragma("unroll") for (int m = 0; m < 4; ++m) _Pragma("unroll") for (int n = 0; n < 2; ++n) _Pragma("unroll") for (int k = 0; k < 2; ++k) \
        acc[ai][bj][m][n] = __builtin_amdgcn_mfma_f32_16x16x32_bf16(Bt[n][k], At[m][k], acc[ai][bj][m][n], 0, 0, 0); __builtin_amdgcn_s_setprio(0); } while (0)
#define PG8_WAIT_V(n) asm volatile("s_waitcnt vmcnt(" #n ")" ::: "memory")
#define PG8_WAIT_L(n) asm volatile("s_waitcnt lgkmcnt(" #n ")" ::: "memory")
#define PG8_BAR __builtin_amdgcn_s_barrier()
#define PG8_SCHED __builtin_amdgcn_sched_barrier(0)
#define PG8_GOFF(ui_, o0, o1) do { _Pragma("unroll") for (int _i = 0; _i < 2; ++_i) { \
        o0[_i] = (unsigned)(tok[(ui_) * 256 + RA[_i]] * K + CA[_i]) * 2u; o1[_i] = (unsigned)(tok[(ui_) * 256 + 128 + RA[_i]] * K + CA[_i]) * 2u; } } while (0)
    Unit cur, nxt; int ui = 0;
    if (!S.next(0, cur)) return;
    f32x4 acc[2][2][4][2];
#pragma unroll
    for (int a = 0; a < 2; ++a)
#pragma unroll
        for (int b = 0; b < 2; ++b)
#pragma unroll
            for (int m = 0; m < 4; ++m)
#pragma unroll
                for (int n = 0; n < 2; ++n) acc[a][b][m][n] = (f32x4){0.f, 0.f, 0.f, 0.f};
    bf16x8 At[4][2], B0[2][2], B1[2][2];
    const char* gA = (const char*)g.A; const char* cB = (const char*)g.Bt + (size_t)cur.pn * tstep;
    unsigned c0[2], c1[2], n0[2], n1[2];
    PG8_GOFF(0, c0, c1);
    S.a_ready(cur);
    PG8_STAGE(PG8_SB(0, 0), cB, voffB); PG8_STAGE(PG8_SB(0, 1), cB + hstep, voffB); PG8_STAGE(PG8_SA(0, 0), gA, c0); PG8_STAGE(PG8_SA(0, 1), gA, c1);
    if (wr == 1) PG8_BAR;
    PG8_WAIT_V(2); PG8_BAR;
    PG8_STAGE(PG8_SB(1, 0), cB + kstep, voffB); PG8_STAGE(PG8_SA(1, 0), gA + kstep, c0); PG8_STAGE(PG8_SB(1, 1), cB + hstep + kstep, voffB);
    PG8_WAIT_V(6); PG8_BAR;
    for (;;) {
        const bool has_next = S.next(ui + 1, nxt);
        const char* nB = has_next ? (const char*)g.Bt + (size_t)nxt.pn * tstep : cB;
        if (has_next) { PG8_GOFF(ui + 1, n0, n1); } else { n0[0] = c0[0]; n0[1] = c0[1]; n1[0] = c1[0]; n1[1] = c1[1]; }
        for (int t = 0; t < nt; t += 2) {
            const bool last = (t == nt - 2);
            const char* a1 = gA + (size_t)(t + 1) * kstep;
            const char* a2 = last ? gA : gA + (size_t)(t + 2) * kstep; const char* b2 = last ? nB : cB + (size_t)(t + 2) * kstep;
            const char* a3 = a2 + kstep; const char* b3 = b2 + kstep;
            unsigned s0[2], s1[2];
            s0[0] = last ? n0[0] : c0[0]; s0[1] = last ? n0[1] : c0[1]; s1[0] = last ? n1[0] : c1[0]; s1[1] = last ? n1[1] : c1[1];
            if (last && has_next) S.a_ready(nxt);
            PG8_LDB(B0, 0, 0); PG8_LDB(B1, 0, 1); PG8_SCHED; PG8_LDA(At, 0, 0); PG8_STAGE(PG8_SA(1, 1), a1, c1);
            PG8_WAIT_V(8); PG8_WAIT_L(0); PG8_BAR; PG8_MMA(0, 0, At, B0); PG8_MMA(0, 1, At, B1); PG8_BAR; PG8_SCHED;
            PG8_LDA(At, 0, 1); PG8_STAGE(PG8_SB(0, 0), b2, voffB); PG8_STAGE(PG8_SB(0, 1), b2 + hstep, voffB); PG8_STAGE(PG8_SA(0, 0), a2, s0);
            PG8_WAIT_V(8); PG8_WAIT_L(0); PG8_BAR; PG8_MMA(1, 0, At, B0); PG8_MMA(1, 1, At, B1); PG8_BAR; PG8_SCHED;
            PG8_LDB(B0, 1, 0); PG8_LDB(B1, 1, 1); PG8_SCHED; PG8_LDA(At, 1, 0); PG8_STAGE(PG8_SA(0, 1), a2, s1);
            PG8_WAIT_V(8); PG8_WAIT_L(0); PG8_BAR; PG8_MMA(0, 0, At, B0); PG8_MMA(0, 1, At, B1); PG8_BAR; PG8_SCHED;
            PG8_LDA(At, 1, 1); PG8_STAGE(PG8_SB(1, 0), b3, voffB); PG8_STAGE(PG8_SB(1, 1), b3 + hstep, voffB); PG8_STAGE(PG8_SA(1, 0), a3, s0);
            PG8_WAIT_V(8); PG8_WAIT_L(0); PG8_BAR; PG8_MMA(1, 0, At, B0); PG8_MMA(1, 1, At, B1); PG8_BAR; PG8_SCHED;
        }
        if constexpr (ALIGN_EPI) { if (wr == 0) PG8_BAR; }
        E(acc, cur, wr, wc, fr, fq); S.done(cur);
        if (!has_next) break;
#pragma unroll
        for (int a = 0; a < 2; ++a)
#pragma unroll
            for (int b = 0; b < 2; ++b)
#pragma unroll
                for (int m = 0; m < 4; ++m)
#pragma unroll
                    for (int n = 0; n < 2; ++n) acc[a][b][m][n] = (f32x4){0.f, 0.f, 0.f, 0.f};
        cur = nxt; cB = nB; ++ui; c0[0] = n0[0]; c0[1] = n0[1]; c1[0] = n1[0]; c1[1] = n1[1];
        if constexpr (ALIGN_EPI) { if (wr == 1) PG8_BAR; }
    }
    PG8_WAIT_V(0);
    if constexpr (!ALIGN_EPI) { if (wr == 0) PG8_BAR; }
    PG8_BAR;
#undef PG8_SA
#undef PG8_SB
#undef PG8_STAGE
#undef PG8_LDA
#undef PG8_LDB
#undef PG8_MMA
#undef PG8_WAIT_V
#undef PG8_WAIT_L
#undef PG8_BAR
#undef PG8_SCHED
#undef PG8_GOFF
}
}

__device__ __forceinline__ void transpose_item(const float* W, int ld, int c0, int k0, bf16* WT, int Kd, int r0, LAS float* scr, int lane) {
#pragma unroll 8
    for (int i = 0; i < 32; ++i) { const int kk = 2 * i + (lane >> 5); scr[kk * 33 + (lane & 31)] = __builtin_nontemporal_load(W + (size_t)(k0 + kk) * ld + c0 + (lane & 31)); }
    LDS_WAIT(); asm volatile("" ::: "memory");
    const int c = lane & 7;
#pragma unroll
    for (int j = 0; j < 4; ++j) { const int n = (lane >> 3) + 8 * j; const LAS float* s = scr + (8 * c) * 33 + n;
        v4u o; o.x = cvtpk(s[0 * 33], s[1 * 33]); o.y = cvtpk(s[2 * 33], s[3 * 33]); o.z = cvtpk(s[4 * 33], s[5 * 33]); o.w = cvtpk(s[6 * 33], s[7 * 33]);
        *(GAS v4u*)(WT + (size_t)(r0 + n) * Kd + k0 + 8 * c) = o; }
    LDS_WAIT(); asm volatile("" ::: "memory");
}
__device__ __forceinline__ int win_src_col(int n32) { const int n = n32 * 32; return n < 2048 ? n : (n < 3584 ? n + 32 : (n < 3616 ? n - 1536 : -1)); }

__device__ __forceinline__ void p0_prologue(const Args& a, LAS unsigned char* lds, int tid, int G, int bid) {
    const int lane = tid & 63, wave = tid >> 6;
    {
        LAS float* scr = (LAS float*)(lds + 32768 + wave * 8704);
        const int gw = bid * NWAVES + wave, NGW = G * NWAVES;
        constexpr int I_IN = (D / 64) * (NIN / 32), I_OUT = (D / 64) * (D / 32);
        for (int it = gw; it < I_IN + I_OUT; it += NGW) {
            if (it < I_IN) { const int kb = it / (NIN / 32), nb = it % (NIN / 32); const int sc = win_src_col(nb);
                if (sc >= 0) transpose_item(a.in[6], INW, sc, kb * 64, a.WinT, D, nb * 32, scr, lane);
                else { for (int j = 0; j < 4; ++j) { const int n = (lane >> 3) + 8 * j; *(GAS v4u*)(a.WinT + (size_t)(nb * 32 + n) * D + kb * 64 + 8 * (lane & 7)) = (v4u){0u, 0u, 0u, 0u}; } }
            } else { const int r = it - I_IN; const int kb = r / (D / 32), nb = r % (D / 32);
                transpose_item(a.in[12], D, nb * 32, kb * 64, a.WoutT, D, nb * 32, scr, lane); }
        }
    }
    for (int i = bid * NTHR + tid; i < 48 * D; i += G * NTHR) { const int o = i / D, k = i % D;
        const float w = o < 4 ? a.in[15][k * 4 + o] : (o < 36 ? a.in[17][k * 32 + (o - 4)] : 0.f);
        const unsigned hi = f2bf(w); const float lo = w - __builtin_bit_cast(float, hi << 16);
        a.WrT[i] = (bf16)hi; a.WrT[48 * D + i] = (bf16)f2bf(lo); }
    if (bid < 6 * D / 32) {
        LAS float* cs = (LAS float*)lds;
        __syncthreads();
        for (int i = tid; i < NB * D; i += NTHR) cs[i] = silu_f(a.in[1][i]);
        __syncthreads();
        const int col = bid * 32 + (tid & 31), ks = tid >> 5;
        float acc[NB];
#pragma unroll
        for (int b = 0; b < NB; ++b) acc[b] = 0.f;
        const float* wp = a.in[2] + (size_t)(ks * 64) * (6 * D) + col;
        float wv[64];
#pragma unroll
        for (int k = 0; k < 64; ++k) wv[k] = wp[(size_t)k * (6 * D)];
#pragma unroll
        for (int k = 0; k < 64; ++k) {
#pragma unroll
            for (int b = 0; b < NB; ++b) acc[b] += cs[b * D + ks * 64 + k] * wv[k]; }
        LAS float* red = (LAS float*)(lds + 32768);
        __syncthreads();
#pragma unroll
        for (int b = 0; b < NB; ++b) red[(ks * NB + b) * 32 + (tid & 31)] = acc[b];
        __syncthreads();
        if (tid < 256) { const int b = tid >> 5, c = tid & 31; float s = 0.f;
#pragma unroll
            for (int k = 0; k < 16; ++k) s += red[(k * NB + b) * 32 + c];
            a.ada[b * 6 * D + bid * 32 + c] = s + a.in[3][bid * 32 + c]; }
        __syncthreads();
    }
}

__device__ __forceinline__ void p1_rows(const Args& a, int tid, int G, int bid) {
    const int lane = tid & 63, wave = tid >> 6;
    const int gw = bid * NWAVES + wave, NGW = G * NWAVES;
    const float* g = a.in[4];
    f32x4 nx[4];
    if (gw < T) {
#pragma unroll
        for (int j = 0; j < 4; ++j) nx[j] = __builtin_nontemporal_load((const GAS f32x4*)(a.in[0] + (size_t)gw * D) + lane + 64 * j); }
    for (int t = gw; t < T; t += NGW) {
        const int b = t / S;
        f32x4 v[4]; float ss = 0.f;
#pragma unroll
        for (int j = 0; j < 4; ++j) v[j] = nx[j];
        if (t + NGW < T) {
#pragma unroll
            for (int j = 0; j < 4; ++j) nx[j] = __builtin_nontemporal_load((const GAS f32x4*)(a.in[0] + (size_t)(t + NGW) * D) + lane + 64 * j); }
#pragma unroll
        for (int j = 0; j < 4; ++j) ss += (v[j].x * v[j].x + v[j].y * v[j].y) + (v[j].z * v[j].z + v[j].w * v[j].w);
        const float rstd = rsqrtf(wave_sum(ss) * (1.f / D) + EPS);
        GAS v2u* o8 = (GAS v2u*)(a.H + (size_t)t * D) + lane;
        const float* sh = a.ada + b * 6 * D, *sc = sh + D;
#pragma unroll
        for (int j = 0; j < 4; ++j) { const int k = 4 * lane + 256 * j;
            const f32x4 gg = *(const f32x4*)(g + k), s1 = *(const f32x4*)(sc + k), h1 = *(const f32x4*)(sh + k);
            const float o0 = v[j].x * rstd * gg.x * (1.f + s1.x) + h1.x, o1 = v[j].y * rstd * gg.y * (1.f + s1.y) + h1.y;
            const float o2 = v[j].z * rstd * gg.z * (1.f + s1.z) + h1.z, o3 = v[j].w * rstd * gg.w * (1.f + s1.w) + h1.w;
            o8[64 * j] = (v2u){cvtpk(o0, o1), cvtpk(o2, o3)}; }
    }
}

struct EpiG1 {
    static constexpr bool PERM = true, AFTER_DRAIN = false;
    bf16* qkv; bf16* z; bf16* naq; bf16* nak; bf16* navt; float* gates;
    __device__ __forceinline__ void operator()(const pg8::f32x4 (&acc)[2][2][4][2], const pg8::Unit& u, int wr, int wc, int fr, int fq) const {
        const int row0 = u.pm * 256 + wr * 64 + fr, pn = u.pn;
        if (pn < 10) {
            bf16* base; int ldc, colt;
            if (pn < 6) { base = qkv; ldc = 1536; colt = pn * 256; }
            else if (pn < 8) { base = z; ldc = 512; colt = (pn - 6) * 256; }
            else { base = naq; ldc = 512; colt = (pn - 8) * 256; }
            const int col0 = colt + wc * 32 + 8 * fq;
#pragma unroll
            for (int ai = 0; ai < 2; ++ai)
#pragma unroll
                for (int m = 0; m < 4; ++m) { bf16* rowp = base + (size_t)(row0 + ai * 128 + m * 16) * ldc + col0;
#pragma unroll
                    for (int bj = 0; bj < 2; ++bj) { const pg8::f32x4 v0 = acc[ai][bj][m][0], v1 = acc[ai][bj][m][1];
                        v4u w; w.x = pg8::cvt_pk_bf16(v0[0], v0[1]); w.y = pg8::cvt_pk_bf16(v0[2], v0[3]); w.z = pg8::cvt_pk_bf16(v1[0], v1[1]); w.w = pg8::cvt_pk_bf16(v1[2], v1[3]);
                        *(v4u*)(rowp + bj * 128) = w; } }
        } else if (pn < 12) {
#pragma unroll
            for (int ai = 0; ai < 2; ++ai)
#pragma unroll
                for (int m = 0; m < 4; ++m) { const int t = row0 + ai * 128 + m * 16, b = t >> 11, sidx = t & 2047, R = sidx >> 6, colk = sidx & 63;
#pragma unroll
                    for (int bj = 0; bj < 2; ++bj) { const int c = (pn - 10) * 256 + bj * 128 + wc * 32 + 8 * fq, hd = c >> 6, d0 = c & 63;
                        const size_t off = ((((((size_t)((b * 8 + hd) * 32 + R) * 8 + (colk >> 3)) * 2 + ((colk >> 2) & 1)) * 2 + (d0 >> 5)) * 4 + (colk & 3)) * 4 + ((d0 >> 3) & 3)) * 8;
                        const pg8::f32x4 v0 = acc[ai][bj][m][0], v1 = acc[ai][bj][m][1];
                        v4u w; w.x = pg8::cvt_pk_bf16(v0[0], v0[1]); w.y = pg8::cvt_pk_bf16(v0[2], v0[3]); w.z = pg8::cvt_pk_bf16(v1[0], v1[1]); w.w = pg8::cvt_pk_bf16(v1[2], v1[3]);
                        *(v4u*)(nak + off) = w; } }
        } else if (pn < 14) {
#pragma unroll
            for (int ai = 0; ai < 2; ++ai)
#pragma unroll
                for (int m = 0; m < 4; ++m) { const int t = row0 + ai * 128 + m * 16, b = t >> 11, sidx = t & 2047, R = sidx >> 6, colk = sidx & 63;
#pragma unroll
                    for (int bj = 0; bj < 2; ++bj)
#pragma unroll
                        for (int n = 0; n < 2; ++n)
#pragma unroll
                            for (int r = 0; r < 4; ++r) { const int c = (pn - 12) * 256 + bj * 128 + wc * 32 + 8 * fq + 4 * n + r, hd = c >> 6, d = c & 63;
                                navt[(((((size_t)((b * 8 + hd) * 32 + R) * 4 + (d >> 4)) * 8 + (colk >> 3)) * 16 + (d & 15)) * 8) + (colk & 7)] = (bf16)f2bf(acc[ai][bj][m][n][r]); } }
        } else {
            if (wc == 0) {
#pragma unroll
                for (int ai = 0; ai < 2; ++ai)
#pragma unroll
                    for (int m = 0; m < 4; ++m) { float* gp = gates + (size_t)(row0 + ai * 128 + m * 16) * 32 + 8 * fq;
                        *(pg8::f32x4*)gp = acc[ai][0][m][0]; *(pg8::f32x4*)(gp + 4) = acc[ai][0][m][1]; }
            }
        }
    }
};

__device__ __forceinline__ void p3_na(const Args& a, LAS unsigned char* lds, int tid, int G, int bid) {
    LAS float* tab = (LAS float*)(lds + 256);
    for (int i = tid; i < 8 * 465 + 128; i += NTHR) tab[i - 64] = (i >= 64 && i < 8 * 465 + 64) ? a.in[11][i - 64] : 0.f;
    __syncthreads();
    const int lane = tid & 63, wave = tid >> 6, q = lane & 15, g = lane >> 4;
    const int pi0 = 8 * (q >> 2) + (q & 3);
    const int xg = bid & 7, gs8 = (G >> 3) * NWAVES, slot = (bid >> 3) * NWAVES + wave;
    for (int it = slot; it < 8 * ROWS * 4; it += gs8) {
        const int pair = xg * 8 + (it >> 7), j = it & 3, r = (it >> 2) & 31, h = pair & 7, b = pair >> 3;
        int r0 = r - 4; r0 = r0 < 0 ? 0 : (r0 > ROWS - 8 ? ROWS - 8 : r0);
        const int start = j == 0 ? 0 : (j == 1 ? 8 : (j == 2 ? 24 : 32));
        const int c = 16 * j + q; int c0 = c - 8; c0 = c0 < 0 ? 0 : (c0 > GW - 16 ? GW - 16 : c0);
        const size_t tq = (size_t)b * S + r * GW + c;
        const bf16* qp = a.NAQ + tq * 512 + h * 64 + 8 * g;
        const bf16x8 qf0 = *(const bf16x8*)qp, qf1 = *(const bf16x8*)(qp + 32);
        f32x4 sc[8][2];
        {
            bf16x8 kf[8][4];
#pragma unroll
            for (int kr = 0; kr < 8; ++kr) {
                const bf16* kp = a.NAK + ((size_t)((b * 8 + h) * 32 + r0 + kr) * 512 + (size_t)((start >> 3) + (q >> 2)) * 64 + (q & 3) * 4 + g) * 8;
                kf[kr][0] = *(const bf16x8*)kp; kf[kr][1] = *(const bf16x8*)(kp + 128); kf[kr][2] = *(const bf16x8*)(kp + 256); kf[kr][3] = *(const bf16x8*)(kp + 384);
            }
            __builtin_amdgcn_sched_barrier(0);
#pragma unroll
            for (int kr = 0; kr < 8; ++kr) {
                f32x4 s0 = {0.f, 0.f, 0.f, 0.f}, s1 = {0.f, 0.f, 0.f, 0.f};
                s0 = __builtin_amdgcn_mfma_f32_16x16x32_bf16(kf[kr][0], qf0, s0, 0, 0, 0); s0 = __builtin_amdgcn_mfma_f32_16x16x32_bf16(kf[kr][1], qf1, s0, 0, 0, 0);
                s1 = __builtin_amdgcn_mfma_f32_16x16x32_bf16(kf[kr][2], qf0, s1, 0, 0, 0); s1 = __builtin_amdgcn_mfma_f32_16x16x32_bf16(kf[kr][3], qf1, s1, 0, 0, 0);
                sc[kr][0] = s0; sc[kr][1] = s1;
            }
        }
        bf16x8 vf[8][4];
        {
            const bf16* vbase = a.NAVT + ((size_t)((b * 8 + h) * 32 + r0) * 512 + (size_t)((start >> 3) + g) * 16 + q) * 8;
#pragma unroll
            for (int kr = 0; kr < 8; ++kr)
#pragma unroll
                for (int dt = 0; dt < 4; ++dt) vf[kr][dt] = *(const bf16x8*)(vbase + (size_t)kr * 4096 + dt * 1024);
        }
        __builtin_amdgcn_sched_barrier(0);
        float m = -1e30f;
#pragma unroll
        for (int kr = 0; kr < 8; ++kr) {
            const LAS float* bp = tab + (h * 15 + (r0 + kr - r + 7)) * 31 + (start + 8 * g - c + 15);
#pragma unroll
            for (int jj = 0; jj < 8; ++jj) { const int kc = start + 8 * g + jj; const bool ok = (kc >= c0) && (kc < c0 + 16);
                const float v = ok ? sc[kr][jj >> 2][jj & 3] * 0.125f + bp[jj] : -1e30f;
                sc[kr][jj >> 2][jj & 3] = v; m = fmaxf(m, v); }
        }
        m = fmaxf(m, __shfl_xor(m, 16)); m = fmaxf(m, __shfl_xor(m, 32));
        float l = 0.f;
        bf16x8 pf[8];
#pragma unroll
        for (int kr = 0; kr < 8; ++kr) {
            float p[8];
#pragma unroll
            for (int jj = 0; jj < 8; ++jj) { const float v = sc[kr][jj >> 2][jj & 3]; p[jj] = v > -1e29f ? __expf(v - m) : 0.f; l += p[jj]; }
            v4u w; w.x = cvtpk(p[0], p[1]); w.y = cvtpk(p[2], p[3]); w.z = cvtpk(p[4], p[5]); w.w = cvtpk(p[6], p[7]);
            pf[kr] = __builtin_bit_cast(bf16x8, w);
        }
        l += __shfl_xor(l, 16); l += __shfl_xor(l, 32);
        f32x4 o[4];
#pragma unroll
        for (int dt = 0; dt < 4; ++dt) o[dt] = (f32x4){0.f, 0.f, 0.f, 0.f};
#pragma unroll
        for (int kr = 0; kr < 8; ++kr) {
#pragma unroll
            for (int dt = 0; dt < 4; ++dt) o[dt] = __builtin_amdgcn_mfma_f32_16x16x32_bf16(vf[kr][dt], pf[kr], o[dt], 0, 0, 0);
        }
        const float inv = __builtin_amdgcn_rcpf(l);
        bf16* op = a.MIX + tq * D + 512 + h * 64 + 4 * g;
#pragma unroll
        for (int dt = 0; dt < 4; ++dt) *(v2u*)(op + 16 * dt) = (v2u){cvtpk(o[dt][0] * inv, o[dt][1] * inv), cvtpk(o[dt][2] * inv, o[dt][3] * inv)};
    }
}

__device__ __forceinline__ int crow(int reg, int hh) { return (reg & 3) + 8 * (reg >> 2) + 4 * hh; }
#define MFMA32(a, b, c) __builtin_amdgcn_mfma_f32_32x32x16_bf16((a), (b), (c), 0, 0, 0)
__device__ __forceinline__ bf16x8 pack8(const f32x16& x, int s) {
    v4u p; p.x = cvtpk(x[8 * s], x[8 * s + 1]); p.y = cvtpk(x[8 * s + 2], x[8 * s + 3]); p.z = cvtpk(x[8 * s + 4], x[8 * s + 5]); p.w = cvtpk(x[8 * s + 6], x[8 * s + 7]);
    return __builtin_bit_cast(bf16x8, p);
}
constexpr int IMG = 72;
constexpr int L_KB = 0, L_QB = 9216, L_VB = 18432, L_KT = 27648, L_UT = 36864, L_WT = 46080, L_M = 55296, L_G = 71680, L_DIR = 73728;
constexpr int PREP_REC = 32768;

__device__ __forceinline__ bf16x8 frag_nat(const LAS bf16* img, int row, int ks, int hh) { return *(const LAS bf16x8*)(img + row * IMG + 16 * ks + 8 * hh); }
__device__ __forceinline__ bf16x8 frag_kap(const LAS bf16* img, int row, int base, int s, int hh) {
    const v2u lo = *(const LAS v2u*)(img + row * IMG + base + 16 * s + 4 * hh), hi = *(const LAS v2u*)(img + row * IMG + base + 16 * s + 8 + 4 * hh);
    return __builtin_bit_cast(bf16x8, (v4u){lo.x, lo.y, hi.x, hi.y});
}

typedef float f32x2v __attribute__((ext_vector_type(2)));
__device__ __forceinline__ void pkfnma(f32x2v& acc, f32x2v m, f32x2v xx) { asm("v_pk_fma_f32 %0, %1, %2, %0 op_sel_hi:[0,1,1] neg_lo:[1,0,0] neg_hi:[1,0,0]" : "+v"(acc) : "v"(xx), "v"(m)); }
__device__ __forceinline__ float fnma(float acc, float m, float x) { asm("v_fma_f32 %0, -%1, %2, %0" : "+v"(acc) : "v"(m), "v"(x)); return acc; }
template <int B0, int JJ> __device__ __forceinline__ void dn_tri_step(f32x2v (&acc)[32], f32x4 (&mc)[8], const LAS float* MT) {
    constexpr int j = B0 + JJ;
    f32x4 mn[8];
    if (JJ + 1 < 31) {
#pragma unroll
        for (int i4 = (JJ + 2) / 4; i4 < 8; ++i4) mn[i4] = *(const LAS f32x4*)(MT + (j + 1) * 64 + B0 + 4 * i4);
    }
    __builtin_amdgcn_sched_barrier(0);
    const float xj = (j & 1) ? acc[j >> 1].y : acc[j >> 1].x;
    const f32x2v xx = {xj, xj};
#pragma unroll
    for (int i4 = (JJ + 1) / 4; i4 < 8; ++i4) {
        const f32x4 m = mc[i4]; const int ia = B0 + 4 * i4;
        if (ia > j) pkfnma(acc[ia >> 1], (f32x2v){m.x, m.y}, xx);
        else if (ia + 1 > j) acc[ia >> 1].y = fnma(acc[ia >> 1].y, m.y, xj);
        if (ia + 2 > j) pkfnma(acc[(ia >> 1) + 1], (f32x2v){m.z, m.w}, xx);
        else if (ia + 3 > j) acc[(ia >> 1) + 1].y = fnma(acc[(ia >> 1) + 1].y, m.w, xj);
    }
    __builtin_amdgcn_sched_barrier(0);
    if (JJ + 1 < 31) {
#pragma unroll
        for (int i4 = (JJ + 2) / 4; i4 < 8; ++i4) mc[i4] = mn[i4];
    }
}
template <int B0, int... JJ> __device__ __forceinline__ void dn_tri_steps(f32x2v (&acc)[32], f32x4 (&mc)[8], const LAS float* MT, std::integer_sequence<int, JJ...>) { (dn_tri_step<B0, JJ>(acc, mc, MT), ...); }
template <int B0> __device__ __forceinline__ void dn_tri32(f32x2v (&acc)[32], const LAS float* MT) {
    f32x4 mc[8];
#pragma unroll
    for (int i4 = 0; i4 < 8; ++i4) mc[i4] = *(const LAS f32x4*)(MT + B0 * 64 + B0 + 4 * i4);
    dn_tri_steps<B0>(acc, mc, MT, std::make_integer_sequence<int, 31>{});
}
__device__ __forceinline__ void dn_store32(const f32x2v (&acc)[32], int half, LAS bf16* out_img, int lane) {
#pragma unroll
    for (int i8 = 0; i8 < 4; ++i8) { const int k = 16 * half + 4 * i8;
        v4u w; w.x = cvtpk(acc[k].x, acc[k].y); w.y = cvtpk(acc[k + 1].x, acc[k + 1].y); w.z = cvtpk(acc[k + 2].x, acc[k + 2].y); w.w = cvtpk(acc[k + 3].x, acc[k + 3].y);
        *(LAS v4u*)(out_img + lane * IMG + 32 * half + 8 * i8) = w; }
}
__device__ __forceinline__ void dn_solve(const LAS float* MT, const LAS bf16* ML, const LAS bf16* rhs_img, const LAS float* rscale, LAS bf16* out_img, int lane) {
    f32x2v acc[32];
#pragma unroll
    for (int k = 0; k < 16; ++k) { acc[k].x = rscale[2 * k] * bf2f(rhs_img[(2 * k) * IMG + lane]); acc[k].y = rscale[2 * k + 1] * bf2f(rhs_img[(2 * k + 1) * IMG + lane]); }
    dn_tri32<0>(acc, MT);
    dn_store32(acc, 0, out_img, lane);
    __builtin_amdgcn_sched_barrier(0);
#pragma unroll
    for (int k = 16; k < 32; ++k) { acc[k].x = rscale[2 * k] * bf2f(rhs_img[(2 * k) * IMG + lane]); acc[k].y = rscale[2 * k + 1] * bf2f(rhs_img[(2 * k + 1) * IMG + lane]); }
    asm volatile("s_waitcnt lgkmcnt(0)" ::: "memory");
    {
        const int col = lane & 31, hh = lane >> 5;
        f32x16 d0, d1;
#pragma unroll
        for (int r = 0; r < 16; ++r) { d0[r] = 0.f; d1[r] = 0.f; }
#pragma unroll
        for (int ks = 0; ks < 2; ++ks) { const bf16x8 af = *(const LAS bf16x8*)(ML + col * 128 + 16 * ks + 8 * hh);
            d0 = MFMA32(af, frag_nat(out_img, col, ks, hh), d0); d1 = MFMA32(af, frag_nat(out_img, 32 + col, ks, hh), d1); }
#pragma unroll
        for (int r = 0; r < 16; ++r) { const float t0 = __shfl_xor(d0[r], 32), t1 = __shfl_xor(d1[r], 32);
            const float n0 = hh ? t1 : d0[r], n1 = hh ? d1[r] : t0; d0[r] = n0; d1[r] = n1; }
#pragma unroll
        for (int r = 0; r < 16; ++r) { const int i0r = 32 + crow(r, 0), i1r = 32 + crow(r, 1);
            if (i0r & 1) acc[i0r >> 1].y -= d0[r]; else acc[i0r >> 1].x -= d0[r];
            if (i1r & 1) acc[i1r >> 1].y -= d1[r]; else acc[i1r >> 1].x -= d1[r]; }
    }
    dn_tri32<32>(acc, MT);
    dn_store32(acc, 1, out_img, lane);
}

__device__ __forceinline__ void p3_dnprep(const Args& a, LAS unsigned char* lds, int tid, int G, int bid) {
    const float* wconv = a.in[7];
    LAS float* WCV = (LAS float*)(lds + 2 * L_DIR);
    int hcur = -1;
    float pg_a = 0.f, pg_b = 0.f; v4u raw[3][5];
#define PREP_PF_GATES(it) do { if ((tid >> 6) < 2 && (it) < NB * NH * 32) { const int _c = (it) & 31, _h = ((it) >> 5) & 7, _b = (it) >> 8, _d = tid >> 6, _l = tid & 63; \
        const float* _gp = a.GATES + (size_t)(_b * S + 64 * _c + (_d ? 63 - _l : _l)) * 32; pg_a = _gp[_d * 8 + _h]; pg_b = _gp[16 + _d * 8 + _h]; } } while (0)
#define PREP_PF_RAW(it) do { if ((it) < NB * NH * 32) { const int _c = (it) & 31, _h = ((it) >> 5) & 7, _b = (it) >> 8, _s = 64 * _c + (tid >> 3); \
        _Pragma("unroll") for (int _m = 0; _m < 3; ++_m) _Pragma("unroll") for (int _t = 0; _t < 5; ++_t) { const int _ss = _s + _t - 2; \
            raw[_m][_t] = (_ss >= 0 && _ss < S) ? *(const v4u*)(a.QKV + (size_t)(_b * S + _ss) * 1536 + _m * 512 + _h * 64 + 8 * (tid & 7)) : (v4u){0u, 0u, 0u, 0u}; } } } while (0)
    PREP_PF_GATES(bid); PREP_PF_RAW(bid);
    for (int item = bid; item < NB * NH * 32; item += G) {
        int tid_ = tid; asm volatile("" : "+v"(tid_));
        const int lane = tid_ & 63, wave = tid_ >> 6, dir = wave & 1, w4 = wave >> 1;
        const int col = lane & 31, hh = lane >> 5;
        LAS unsigned char* ld = lds + dir * L_DIR;
        LAS bf16* KB = (LAS bf16*)(ld + L_KB); LAS bf16* QB = (LAS bf16*)(ld + L_QB); LAS bf16* VB = (LAS bf16*)(ld + L_VB); LAS bf16* KT = (LAS bf16*)(ld + L_KT);
        LAS bf16* UT = (LAS bf16*)(ld + L_UT); LAS bf16* WT = (LAS bf16*)(ld + L_WT); LAS float* M = (LAS float*)(ld + L_M); LAS float* GT = (LAS float*)(ld + L_G);
        const int chunk = item & 31, h = (item >> 5) & 7, b = item >> 8;
        const int tok0 = b * S + 64 * chunk;
        __syncthreads();
        if (wave < 2) {
            const float av = pg_a, bv = pg_b;
            const float g = -__expf(a.in[8][dir * 8 + h]) * softplus_f(av + a.in[9][dir * 8 + h]);
            const float beta = sigmoid_f(bv);
            float v = g;
#pragma unroll
            for (int o = 1; o < 64; o <<= 1) { const float u = __shfl_up(v, o); if (lane >= o) v += u; }
            const float gl = __shfl(v, 63);
            const float e = __expf(v);
            GT[lane] = beta; GT[64 + lane] = v; GT[128 + lane] = e; GT[192 + lane] = __expf(gl - v); GT[256 + lane] = beta * e;
            if (lane == 0) GT[320] = __expf(gl);
        }
        if (h != hcur) { for (int i = tid; i < 5 * 192; i += NTHR) { const int tp = i / 192, cc = i % 192; WCV[i] = wconv[tp * 1536 + (cc >> 6) * 512 + h * 64 + (cc & 63)]; } hcur = h; }
        PREP_PF_GATES(item + G);
        __syncthreads();
        {
            const int p = tid_ >> 3, d0 = 8 * (tid_ & 7);
#pragma unroll
            for (int mat = 0; mat < 3; ++mat) {
                float acc[8];
#pragma unroll
                for (int e = 0; e < 8; ++e) acc[e] = 0.f;
#pragma unroll
                for (int tap = 0; tap < 5; ++tap) {
                    const v4u rw = raw[mat][tap];
                    const f32x4 w0 = *(const LAS f32x4*)(WCV + tap * 192 + mat * 64 + d0), w1 = *(const LAS f32x4*)(WCV + tap * 192 + mat * 64 + d0 + 4);
                    acc[0] += w0.x * bflo(rw.x); acc[1] += w0.y * bfhi(rw.x); acc[2] += w0.z * bflo(rw.y); acc[3] += w0.w * bfhi(rw.y);
                    acc[4] += w1.x * bflo(rw.z); acc[5] += w1.y * bfhi(rw.z); acc[6] += w1.z * bflo(rw.w); acc[7] += w1.w * bfhi(rw.w);
                }
                float ss2 = 0.f;
#pragma unroll
                for (int e = 0; e < 8; ++e) { acc[e] = silu_f(acc[e]); ss2 += acc[e] * acc[e]; }
                if (mat < 2) {
                    ss2 += __shfl_xor(ss2, 1); ss2 += __shfl_xor(ss2, 2); ss2 += __shfl_xor(ss2, 4);
                    const float sc = rsqrtf(ss2 + EPS);
#pragma unroll
                    for (int e = 0; e < 8; ++e) acc[e] *= sc;
                }
                const v4u w = (v4u){cvtpk(acc[0], acc[1]), cvtpk(acc[2], acc[3]), cvtpk(acc[4], acc[5]), cvtpk(acc[6], acc[7])};
                const int off = mat == 0 ? L_QB : (mat == 1 ? L_KB : L_VB);
                *(LAS v4u*)((LAS bf16*)(lds + off) + p * IMG + d0) = w;
                *(LAS v4u*)((LAS bf16*)(lds + L_DIR + off) + (63 - p) * IMG + d0) = w;
                if (mat == 1) {
                    const float e0 = ((LAS float*)(lds + L_G))[192 + p], e1 = ((LAS float*)(lds + L_DIR + L_G))[192 + 63 - p];
                    LAS bf16* kt0 = (LAS bf16*)(lds + L_KT); LAS bf16* kt1 = (LAS bf16*)(lds + L_DIR + L_KT);
#pragma unroll
                    for (int e = 0; e < 8; ++e) { const float kv = bf2f((unsigned short)(e & 1 ? (w[e >> 1] >> 16) : (w[e >> 1] & 0xffffu)));
                        kt0[(d0 + e) * IMG + p] = (bf16)f2bf(kv * e0); kt1[(d0 + e) * IMG + 63 - p] = (bf16)f2bf(kv * e1); }
                }
            }
        }
        __syncthreads();
        if (w4 < 3) {
            const int bi = w4 == 0 ? 0 : 1, bj = w4 == 2 ? 1 : 0;
            f32x16 acc;
#pragma unroll
            for (int r = 0; r < 16; ++r) acc[r] = 0.f;
#pragma unroll
            for (int ks = 0; ks < 4; ++ks) acc = MFMA32(frag_nat(KB, 32 * bi + col, ks, hh), frag_nat(KB, 32 * bj + col, ks, hh), acc);
            const int j = 32 * bj + col; const float gcj = GT[64 + j];
            if (w4 == 1) {
#pragma unroll
                for (int r = 0; r < 16; ++r) { const int ip = crow(r, hh), i = 32 + ip;
                    ((LAS bf16*)((LAS unsigned char*)M + 128))[ip * 128 + j] = (bf16)f2bf(GT[i] * acc[r] * __expf(GT[64 + i] - gcj)); }
            } else {
#pragma unroll
            for (int r4 = 0; r4 < 4; ++r4) { const int i0 = 32 * bi + 8 * r4 + 4 * hh; f32x4 mv;
#pragma unroll
                for (int k = 0; k < 4; ++k) { const int i = i0 + k; mv[k] = (i > j) ? GT[i] * acc[4 * r4 + k] * __expf(GT[64 + i] - gcj) : 0.f; }
                *(LAS f32x4*)(M + j * 64 + i0) = mv; }
            }
        }
        __syncthreads();
        if (w4 < 2) dn_solve(M, (const LAS bf16*)((const LAS unsigned char*)M + 128), w4 == 0 ? VB : KB, w4 == 0 ? GT : GT + 256, w4 == 0 ? UT : WT, lane);
        __syncthreads();
        __builtin_amdgcn_sched_barrier(0);
        PREP_PF_RAW(item + G);
        __builtin_amdgcn_sched_barrier(0);
        {
            int col5 = lane & 31; asm volatile("" : "+v"(col5));
            const int col = col5;
            const int I = w4 >> 1, c = w4 & 1;
            unsigned char* rec = (unsigned char*)a.PREP + ((size_t)((b * 8 + h) * 2 + dir) * 32 + chunk) * PREP_REC;
            bf16x8 Xf[2][2];
            const int i_tok = 32 * I + col; const float gci = GT[64 + i_tok];
#pragma unroll
            for (int J = 0; J < 2; ++J) {
                if (J <= I) {
                    f32x16 acc;
#pragma unroll
                    for (int r = 0; r < 16; ++r) acc[r] = 0.f;
#pragma unroll
                    for (int ks = 0; ks < 4; ++ks) acc = MFMA32(frag_nat(KB, 32 * J + col, ks, hh), frag_nat(QB, 32 * I + col, ks, hh), acc);
#pragma unroll
                    for (int r = 0; r < 16; ++r) { const int j = 32 * J + crow(r, hh); acc[r] = (j <= i_tok) ? acc[r] * 0.125f * __expf(gci - GT[64 + j]) : 0.f; }
                    Xf[J][0] = pack8(acc, 0); Xf[J][1] = pack8(acc, 1);
                }
            }
            {
                f32x16 acc;
#pragma unroll
                for (int r = 0; r < 16; ++r) acc[r] = 0.f;
#pragma unroll
                for (int J = 0; J < 2; ++J) if (J <= I) {
#pragma unroll
                    for (int s = 0; s < 2; ++s) acc = MFMA32(Xf[J][s], frag_kap(UT, 32 * c + col, 32 * J, s, hh), acc); }
                v4u* dst = (v4u*)(rec + 24576 + (I * 2 + c) * 2048 + lane * 32);
                dst[0] = (v4u){cvtpk(acc[0], acc[1]), cvtpk(acc[2], acc[3]), cvtpk(acc[4], acc[5]), cvtpk(acc[6], acc[7])};
                dst[1] = (v4u){cvtpk(acc[8], acc[9]), cvtpk(acc[10], acc[11]), cvtpk(acc[12], acc[13]), cvtpk(acc[14], acc[15])};
            }
            {
                f32x16 acc;
#pragma unroll
                for (int r = 0; r < 16; ++r) acc[r] = 0.f;
#pragma unroll
                for (int J = 0; J < 2; ++J) if (J <= I) {
#pragma unroll
                    for (int s = 0; s < 2; ++s) acc = MFMA32(frag_kap(WT, 32 * c + col, 32 * J, s, hh), Xf[J][s], acc); }
                const float ei = GT[128 + i_tok] * 0.125f;
#pragma unroll
                for (int r4 = 0; r4 < 4; ++r4) { const v2u qv = *(const LAS v2u*)(QB + i_tok * IMG + 32 * c + 8 * r4 + 4 * hh);
                    acc[4 * r4 + 0] = ei * bflo(qv.x) - acc[4 * r4 + 0]; acc[4 * r4 + 1] = ei * bfhi(qv.x) - acc[4 * r4 + 1];
                    acc[4 * r4 + 2] = ei * bflo(qv.y) - acc[4 * r4 + 2]; acc[4 * r4 + 3] = ei * bfhi(qv.y) - acc[4 * r4 + 3]; }
                *(bf16x8*)(rec + ((I * 2 + c) * 2 + 0) * 1024 + lane * 16) = pack8(acc, 0);
                *(bf16x8*)(rec + ((I * 2 + c) * 2 + 1) * 1024 + lane * 16) = pack8(acc, 1);
            }
            {
                f32x16 acc;
#pragma unroll
                for (int r = 0; r < 16; ++r) acc[r] = 0.f;
#pragma unroll
                for (int ks = 0; ks < 4; ++ks) acc = MFMA32(frag_nat(WT, 32 * I + col, ks, hh), frag_nat(KT, 32 * c + col, ks, hh), acc);
                const float egl = GT[320];
#pragma unroll
                for (int r = 0; r < 16; ++r) acc[r] = ((32 * I + crow(r, hh)) == (32 * c + col) ? egl : 0.f) - acc[r];
                *(bf16x8*)(rec + 8192 + ((c * 2 + I) * 2 + 0) * 1024 + lane * 16) = pack8(acc, 0);
                *(bf16x8*)(rec + 8192 + ((c * 2 + I) * 2 + 1) * 1024 + lane * 16) = pack8(acc, 1);
            }
            {
                f32x16 acc;
#pragma unroll
                for (int r = 0; r < 16; ++r) acc[r] = 0.f;
#pragma unroll
                for (int ks = 0; ks < 4; ++ks) acc = MFMA32(frag_nat(KT, 32 * I + col, ks, hh), frag_nat(UT, 32 * c + col, ks, hh), acc);
                v4u* dst = (v4u*)(rec + 16384 + (I * 2 + c) * 2048 + lane * 32);
                dst[0] = (v4u){cvtpk(acc[0], acc[1]), cvtpk(acc[2], acc[3]), cvtpk(acc[4], acc[5]), cvtpk(acc[6], acc[7])};
                dst[1] = (v4u){cvtpk(acc[8], acc[9]), cvtpk(acc[10], acc[11]), cvtpk(acc[12], acc[13]), cvtpk(acc[14], acc[15])};
            }
        }
    }
}

#undef PREP_PF_GATES
#undef PREP_PF_RAW
constexpr int SCAN_BUF = 24576, SCAN_OFF = 71680;
__device__ __forceinline__ void scan_dma(const unsigned char* rec, LAS unsigned char* buf, int DV, int lane) {
    const unsigned char* src = rec + lane * 16;
#pragma unroll
    for (int p = 0; p < 8; ++p) __builtin_amdgcn_global_load_lds((const unsigned*)(src + 8192 + p * 1024), (LAS unsigned*)(buf + p * 1024), 16, 0, 0);
#pragma unroll
    for (int p = 0; p < 8; ++p) __builtin_amdgcn_global_load_lds((const unsigned*)(src + p * 1024), (LAS unsigned*)(buf + 8192 + p * 1024), 16, 0, 0);
#pragma unroll
    for (int blk = 0; blk < 2; ++blk)
#pragma unroll
        for (int hf = 0; hf < 2; ++hf) {
            __builtin_amdgcn_global_load_lds((const unsigned*)(src + 16384 + (blk * 2 + DV) * 2048 + hf * 1024), (LAS unsigned*)(buf + 16384 + blk * 2048 + hf * 1024), 16, 0, 0);
            __builtin_amdgcn_global_load_lds((const unsigned*)(src + 24576 + (blk * 2 + DV) * 2048 + hf * 1024), (LAS unsigned*)(buf + 20480 + blk * 2048 + hf * 1024), 16, 0, 0);
        }
}
__device__ __forceinline__ void unpack16(f32x16& d, const LAS unsigned char* p) {
    const v4u c0 = *(const LAS v4u*)p, c1 = *(const LAS v4u*)(p + 16);
    d[0] = bflo(c0.x); d[1] = bfhi(c0.x); d[2] = bflo(c0.y); d[3] = bfhi(c0.y); d[4] = bflo(c0.z); d[5] = bfhi(c0.z); d[6] = bflo(c0.w); d[7] = bfhi(c0.w);
    d[8] = bflo(c1.x); d[9] = bfhi(c1.x); d[10] = bflo(c1.y); d[11] = bfhi(c1.y); d[12] = bflo(c1.z); d[13] = bfhi(c1.z); d[14] = bflo(c1.w); d[15] = bfhi(c1.w);
}
__device__ __forceinline__ void p4_scan_wave(const Args& a, LAS unsigned char* lds, int id, int lane) {
    const int DV = id & 1, dir = (id >> 1) & 1, h = (id >> 2) & 7, b = id >> 5;
    const int col = lane & 31, hh = lane >> 5;
    f32x16 S0, S1;
#pragma unroll
    for (int r = 0; r < 16; ++r) { S0[r] = 0.f; S1[r] = 0.f; }
    const unsigned char* chain = (const unsigned char*)a.PREP + (size_t)((b * 8 + h) * 2 + dir) * 32 * PREP_REC;
    LAS unsigned char* ring = lds + SCAN_OFF;
    scan_dma(chain + (size_t)(dir ? 31 : 0) * PREP_REC, ring, DV, lane);
    scan_dma(chain + (size_t)(dir ? 30 : 1) * PREP_REC, ring + SCAN_BUF, DV, lane);
    for (int st = 0; st < 32; ++st) {
        const int chunk = dir ? 31 - st : st;
        asm volatile("s_waitcnt lgkmcnt(0)" ::: "memory");
        { const int s2 = st + 2 < 32 ? st + 2 : 31; scan_dma(chain + (size_t)(dir ? 31 - s2 : s2) * PREP_REC, ring + ((st + 2) % 3) * SCAN_BUF, DV, lane); }
        asm volatile("s_waitcnt vmcnt(48)" ::: "memory");
        __builtin_amdgcn_sched_barrier(0);
        const LAS unsigned char* buf = ring + (st % 3) * SCAN_BUF;
        bf16x8 Sb[2][2];
        Sb[0][0] = pack8(S0, 0); Sb[0][1] = pack8(S0, 1); Sb[1][0] = pack8(S1, 0); Sb[1][1] = pack8(S1, 1);
        f32x16 o[2], n[2];
#pragma unroll
        for (int I = 0; I < 2; ++I) {
            unpack16(o[I], buf + 20480 + I * 2048 + lane * 32);
#pragma unroll
            for (int DK = 0; DK < 2; ++DK)
#pragma unroll
                for (int s = 0; s < 2; ++s) o[I] = MFMA32(*(const LAS bf16x8*)(buf + 8192 + ((I * 2 + DK) * 2 + s) * 1024 + lane * 16), Sb[DK][s], o[I]);
        }
#pragma unroll
        for (int DKp = 0; DKp < 2; ++DKp) {
            unpack16(n[DKp], buf + 16384 + DKp * 2048 + lane * 32);
#pragma unroll
            for (int DK = 0; DK < 2; ++DK)
#pragma unroll
                for (int s = 0; s < 2; ++s) n[DKp] = MFMA32(*(const LAS bf16x8*)(buf + ((DKp * 2 + DK) * 2 + s) * 1024 + lane * 16), Sb[DK][s], n[DKp]);
        }
        S0 = n[0]; S1 = n[1];
        bf16* ofb = (bf16*)a.Y + ((size_t)dir * T + (size_t)b * S + 64 * chunk) * 512 + h * 64 + 32 * DV + col;
#pragma unroll
        for (int I = 0; I < 2; ++I)
#pragma unroll
            for (int r = 0; r < 16; ++r) { const int nn = 32 * I + crow(r, hh); const int p = dir ? 63 - nn : nn; ofb[(size_t)p * 512] = (bf16)f2bf(o[I][r]); }
    }
    asm volatile("s_waitcnt vmcnt(0)" ::: "memory");
}

__device__ __forceinline__ void p4b_dnout(const Args& a, int tid, int G, int bid) {
    const bf16* ofb = (const bf16*)a.Y;
    const int d0 = 8 * (tid & 7);
    const f32x4 g0 = *(const f32x4*)(a.in[10] + d0), g1 = *(const f32x4*)(a.in[10] + d0 + 4);
    for (size_t u = (size_t)bid * NTHR + tid; u < (size_t)T * 64; u += (size_t)G * NTHR) {
        const size_t th = u >> 3;
        const v4u pf = __builtin_nontemporal_load((const v4u*)(ofb + th * 64 + d0)), pb = __builtin_nontemporal_load((const v4u*)(ofb + ((size_t)T * 8 + th) * 64 + d0)), zz = __builtin_nontemporal_load((const v4u*)(a.Z + th * 64 + d0));
        float x[8];
        x[0] = bflo(pf.x) + bflo(pb.x); x[1] = bfhi(pf.x) + bfhi(pb.x); x[2] = bflo(pf.y) + bflo(pb.y); x[3] = bfhi(pf.y) + bfhi(pb.y);
        x[4] = bflo(pf.z) + bflo(pb.z); x[5] = bfhi(pf.z) + bfhi(pb.z); x[6] = bflo(pf.w) + bflo(pb.w); x[7] = bfhi(pf.w) + bfhi(pb.w);
        float ss = 0.f;
#pragma unroll
        for (int e = 0; e < 8; ++e) ss += x[e] * x[e];
        ss += __shfl_xor(ss, 1); ss += __shfl_xor(ss, 2); ss += __shfl_xor(ss, 4);
        const float rs = rsqrtf(ss * (1.f / 64.f) + EPS);
        const float z[8] = {bflo(zz.x), bfhi(zz.x), bflo(zz.y), bfhi(zz.y), bflo(zz.z), bfhi(zz.z), bflo(zz.w), bfhi(zz.w)};
        const float gg[8] = {g0.x, g0.y, g0.z, g0.w, g1.x, g1.y, g1.z, g1.w};
        float o[8];
#pragma unroll
        for (int e = 0; e < 8; ++e) o[e] = x[e] * rs * gg[e] * silu_f(z[e]);
        const size_t t = th >> 3; const int h = (int)(th & 7);
        *(v4u*)(a.MIX + t * D + h * 64 + d0) = (v4u){cvtpk(o[0], o[1]), cvtpk(o[2], o[3]), cvtpk(o[4], o[5]), cvtpk(o[6], o[7])};
    }
}

namespace pp {
constexpr int I_K = 0, I_Q = 9216, I_V = 18432, I_KT = 27648  , INP = 46080;
constexpr int W_BASE = 2 * INP, W_UT = 0, W_WT = 9216, W_MT = 18432, W_ML = 26624, W_DIR = 29184;
constexpr int G_BASE = W_BASE + 2 * W_DIR, G_SZ = 2048;
constexpr int WCV_OFF = G_BASE + 4 * G_SZ;
static_assert(WCV_OFF + 3840 <= LDS_BYTES - 16, "prep LDS map");
constexpr int MLP = 40;

template <int B0, int JJ> __device__ __forceinline__ void tri_step(f32x2v (&acc)[32], f32x4 (&mc)[8], const LAS float* MTb) {
    constexpr int j = B0 + JJ;
    f32x4 mn[8];
    if (JJ + 1 < 31) {
#pragma unroll
        for (int i4 = (JJ + 2) / 4; i4 < 8; ++i4) mn[i4] = *(const LAS f32x4*)(MTb + (JJ + 1) * 32 + 4 * i4);
    }
    __builtin_amdgcn_sched_barrier(0);
    const float xj = (j & 1) ? acc[j >> 1].y : acc[j >> 1].x;
    const f32x2v xx = {xj, xj};
#pragma unroll
    for (int i4 = (JJ + 1) / 4; i4 < 8; ++i4) {
        const f32x4 m = mc[i4]; const int ia = B0 + 4 * i4;
        if (ia > j) pkfnma(acc[ia >> 1], (f32x2v){m.x, m.y}, xx);
        else if (ia + 1 > j) acc[ia >> 1].y = fnma(acc[ia >> 1].y, m.y, xj);
        if (ia + 2 > j) pkfnma(acc[(ia >> 1) + 1], (f32x2v){m.z, m.w}, xx);
        else if (ia + 3 > j) acc[(ia >> 1) + 1].y = fnma(acc[(ia >> 1) + 1].y, m.w, xj);
    }
    __builtin_amdgcn_sched_barrier(0);
    if (JJ + 1 < 31) {
#pragma unroll
        for (int i4 = (JJ + 2) / 4; i4 < 8; ++i4) mc[i4] = mn[i4];
    }
}
template <int B0, int... JJ> __device__ __forceinline__ void tri_steps(f32x2v (&acc)[32], f32x4 (&mc)[8], const LAS float* MTb, std::integer_sequence<int, JJ...>) { (tri_step<B0, JJ>(acc, mc, MTb), ...); }
template <int B0> __device__ __forceinline__ void tri32(f32x2v (&acc)[32], const LAS float* MT) {
    const LAS float* MTb = MT + (B0 / 32) * 1024;
    f32x4 mc[8];
#pragma unroll
    for (int i4 = 0; i4 < 8; ++i4) mc[i4] = *(const LAS f32x4*)(MTb + 4 * i4);
    tri_steps<B0>(acc, mc, MTb, std::make_integer_sequence<int, 31>{});
}
__device__ __forceinline__ void solve(const LAS float* MT, const LAS bf16* ML, const LAS bf16* rhs_img, int rev, const LAS float* rscale, LAS bf16* out_img, int lane) {
    f32x2v acc[32];
    const LAS bf16* rp = rhs_img + (rev ? 63 * IMG : 0) + lane; const int rstep = rev ? -IMG : IMG;
#pragma unroll
    for (int k = 0; k < 16; ++k) { acc[k].x = rscale[2 * k] * bf2f(rp[(2 * k) * rstep]); acc[k].y = rscale[2 * k + 1] * bf2f(rp[(2 * k + 1) * rstep]); }
    tri32<0>(acc, MT);
    dn_store32(acc, 0, out_img, lane);
    __builtin_amdgcn_sched_barrier(0);
#pragma unroll
    for (int k = 16; k < 32; ++k) { acc[k].x = rscale[2 * k] * bf2f(rp[(2 * k) * rstep]); acc[k].y = rscale[2 * k + 1] * bf2f(rp[(2 * k + 1) * rstep]); }
    asm volatile("s_waitcnt lgkmcnt(0)" ::: "memory");
    {
        const int col = lane & 31, hh = lane >> 5;
        f32x16 d0, d1;
#pragma unroll
        for (int r = 0; r < 16; ++r) { d0[r] = 0.f; d1[r] = 0.f; }
#pragma unroll
        for (int ks = 0; ks < 2; ++ks) { const bf16x8 af = *(const LAS bf16x8*)(ML + col * MLP + 16 * ks + 8 * hh);
            d0 = MFMA32(af, frag_nat(out_img, col, ks, hh), d0); d1 = MFMA32(af, frag_nat(out_img, 32 + col, ks, hh), d1); }
#pragma unroll
        for (int r = 0; r < 16; ++r) { const float t0 = __shfl_xor(d0[r], 32), t1 = __shfl_xor(d1[r], 32);
            const float n0 = hh ? t1 : d0[r], n1 = hh ? d1[r] : t0; d0[r] = n0; d1[r] = n1; }
#pragma unroll
        for (int r = 0; r < 16; ++r) { const int i0r = 32 + crow(r, 0), i1r = 32 + crow(r, 1);
            if (i0r & 1) acc[i0r >> 1].y -= d0[r]; else acc[i0r >> 1].x -= d0[r];
            if (i1r & 1) acc[i1r >> 1].y -= d1[r]; else acc[i1r >> 1].x -= d1[r]; }
    }
    tri32<32>(acc, MT);
    dn_store32(acc, 1, out_img, lane);
}

__device__ __forceinline__ void gates(const Args& a, LAS float* GT, int item, int dir, int lane) {
    const int chunk = item & 31, h = (item >> 5) & 7, b = item >> 8;
    const int p = dir ? 63 - lane : lane;
    const float* gp = a.GATES + (size_t)(b * S + 64 * chunk + p) * 32;
    const float av = gp[dir * 8 + h], bv = gp[16 + dir * 8 + h];
    const float g = -__expf(a.in[8][dir * 8 + h]) * softplus_f(av + a.in[9][dir * 8 + h]);
    const float beta = sigmoid_f(bv);
    float v = g;
#pragma unroll
    for (int o = 1; o < 64; o <<= 1) { const float u = __shfl_up(v, o); if (lane >= o) v += u; }
    const float gl = __shfl(v, 63);
    const float e = __expf(v);
    GT[lane] = beta; GT[64 + lane] = v; GT[128 + lane] = e; GT[192 + lane] = __expf(gl - v); GT[256 + lane] = beta * e;
    if (lane == 0) GT[320] = __expf(gl);
}
__device__ __forceinline__ void conv(const Args& a, LAS unsigned char* inp, const LAS float* WCV, int item, int t) {
    const int chunk = item & 31, h = (item >> 5) & 7, b = item >> 8;
    const int p = t >> 2, d0 = 16 * (t & 3), s = 64 * chunk + p;
#pragma unroll
    for (int mat = 0; mat < 3; ++mat) {
        float acc[16];
#pragma unroll
        for (int e = 0; e < 16; ++e) acc[e] = 0.f;
#pragma unroll
        for (int tap = 0; tap < 5; ++tap) {
            const int ss = s + tap - 2;
            if (ss >= 0 && ss < S) {
                const bf16* src = a.QKV + (size_t)(b * S + ss) * 1536 + mat * 512 + h * 64 + d0;
                const v4u r0 = *(const v4u*)src, r1 = *(const v4u*)(src + 8);
                const LAS float* wp = WCV + tap * 192 + mat * 64 + d0;
                const f32x4 w0 = *(const LAS f32x4*)wp, w1 = *(const LAS f32x4*)(wp + 4), w2 = *(const LAS f32x4*)(wp + 8), w3 = *(const LAS f32x4*)(wp + 12);
                acc[0] += w0.x * bflo(r0.x); acc[1] += w0.y * bfhi(r0.x); acc[2] += w0.z * bflo(r0.y); acc[3] += w0.w * bfhi(r0.y);
                acc[4] += w1.x * bflo(r0.z); acc[5] += w1.y * bfhi(r0.z); acc[6] += w1.z * bflo(r0.w); acc[7] += w1.w * bfhi(r0.w);
                acc[8] += w2.x * bflo(r1.x); acc[9] += w2.y * bfhi(r1.x); acc[10] += w2.z * bflo(r1.y); acc[11] += w2.w * bfhi(r1.y);
                acc[12] += w3.x * bflo(r1.z); acc[13] += w3.y * bfhi(r1.z); acc[14] += w3.z * bflo(r1.w); acc[15] += w3.w * bfhi(r1.w);
            }
        }
        float ss2 = 0.f;
#pragma unroll
        for (int e = 0; e < 16; ++e) { acc[e] = silu_f(acc[e]); ss2 += acc[e] * acc[e]; }
        if (mat < 2) {
            ss2 += __shfl_xor(ss2, 1); ss2 += __shfl_xor(ss2, 2);
            const float sc = rsqrtf(ss2 + EPS);
#pragma unroll
            for (int e = 0; e < 16; ++e) acc[e] *= sc;
        }
        LAS bf16* img = (LAS bf16*)(inp + (mat == 0 ? I_Q : (mat == 1 ? I_K : I_V))) + p * IMG + d0;
        *(LAS v4u*)img = (v4u){cvtpk(acc[0], acc[1]), cvtpk(acc[2], acc[3]), cvtpk(acc[4], acc[5]), cvtpk(acc[6], acc[7])};
        *(LAS v4u*)(img + 8) = (v4u){cvtpk(acc[8], acc[9]), cvtpk(acc[10], acc[11]), cvtpk(acc[12], acc[13]), cvtpk(acc[14], acc[15])};
    }
}
__device__ __forceinline__ void mkt(LAS unsigned char* lds, LAS unsigned char* inp, int set, int tid) {
    const int lane = tid & 63, wave = tid >> 6, dir = wave & 1, w4 = wave >> 1, col = lane & 31, hh = lane >> 5;
    const LAS bf16* KB = (const LAS bf16*)(inp + I_K);
    const LAS float* GT = (const LAS float*)(lds + G_BASE + (set * 2 + dir) * G_SZ);
    LAS unsigned char* wk = lds + W_BASE + dir * W_DIR;
    if (w4 < 3) {
        const int bi = w4 == 0 ? 0 : 1, bj = w4 == 2 ? 1 : 0;
        const int ra = 32 * bi + col, rb = 32 * bj + col;
        f32x16 acc;
#pragma unroll
        for (int r = 0; r < 16; ++r) acc[r] = 0.f;
#pragma unroll
        for (int ks = 0; ks < 4; ++ks) acc = MFMA32(frag_nat(KB, dir ? 63 - ra : ra, ks, hh), frag_nat(KB, dir ? 63 - rb : rb, ks, hh), acc);
        const int j = 32 * bj + col; const float gcj = GT[64 + j];
        if (w4 == 1) {
            LAS bf16* ML = (LAS bf16*)(wk + W_ML);
#pragma unroll
            for (int r = 0; r < 16; ++r) { const int ip = crow(r, hh), i = 32 + ip; ML[ip * MLP + j] = (bf16)f2bf(GT[i] * acc[r] * __expf(GT[64 + i] - gcj)); }
        } else {
            LAS float* MTb = (LAS float*)(wk + W_MT) + bi * 1024;
#pragma unroll
            for (int r4 = 0; r4 < 4; ++r4) { const int ip0 = 8 * r4 + 4 * hh; f32x4 mv;
#pragma unroll
                for (int k = 0; k < 4; ++k) { const int i = 32 * bi + ip0 + k; mv[k] = (i > j) ? GT[i] * acc[4 * r4 + k] * __expf(GT[64 + i] - gcj) : 0.f; }
                *(LAS f32x4*)(MTb + col * 32 + ip0) = mv; }
        }
    }
    {
        const int p = tid >> 3, d0 = 8 * (tid & 7);
        const v4u kv = *(const LAS v4u*)(KB + p * IMG + d0);
        const float e0 = ((const LAS float*)(lds + G_BASE + (set * 2 + 0) * G_SZ))[192 + p], e1 = ((const LAS float*)(lds + G_BASE + (set * 2 + 1) * G_SZ))[192 + 63 - p];
        LAS bf16* kt0 = (LAS bf16*)(inp + I_KT); LAS bf16* kt1 = (LAS bf16*)(inp + I_KT + 9216);
        const float kf[8] = {bflo(kv.x), bfhi(kv.x), bflo(kv.y), bfhi(kv.y), bflo(kv.z), bfhi(kv.z), bflo(kv.w), bfhi(kv.w)};
#pragma unroll
        for (int e = 0; e < 8; ++e) { kt0[(d0 + e) * IMG + p] = (bf16)f2bf(kf[e] * e0); kt1[(d0 + e) * IMG + 63 - p] = (bf16)f2bf(kf[e] * e1); }
    }
}
__device__ __forceinline__ void stage5(const Args& a, LAS unsigned char* lds, LAS unsigned char* inp, int set, int item, int tid) {
    const int lane = tid & 63, wave = tid >> 6, dir = wave & 1, w4 = wave >> 1, hh = lane >> 5;
    int col5 = lane & 31; asm volatile("" : "+v"(col5));
    const int col = col5;
    const int chunk = item & 31, h = (item >> 5) & 7, b = item >> 8;
    const LAS bf16* KB = (const LAS bf16*)(inp + I_K); const LAS bf16* QB = (const LAS bf16*)(inp + I_Q); const LAS bf16* KT = (const LAS bf16*)(inp + I_KT + dir * 9216);
    LAS unsigned char* wk = lds + W_BASE + dir * W_DIR;
    const LAS bf16* UT = (const LAS bf16*)(wk + W_UT); const LAS bf16* WT = (const LAS bf16*)(wk + W_WT);
    const LAS float* GT = (const LAS float*)(lds + G_BASE + (set * 2 + dir) * G_SZ);
    const int I = w4 >> 1, c = w4 & 1;
    unsigned char* rec = (unsigned char*)a.PREP + ((size_t)((b * 8 + h) * 2 + dir) * 32 + chunk) * PREP_REC;
    bf16x8 Xf[2][2];
    const int i_tok = 32 * I + col, i_row = dir ? 63 - i_tok : i_tok; const float gci = GT[64 + i_tok];
#pragma unroll
    for (int J = 0; J < 2; ++J) {
        if (J <= I) {
            const int jr = 32 * J + col;
            f32x16 acc;
#pragma unroll
            for (int r = 0; r < 16; ++r) acc[r] = 0.f;
#pragma unroll
            for (int ks = 0; ks < 4; ++ks) acc = MFMA32(frag_nat(KB, dir ? 63 - jr : jr, ks, hh), frag_nat(QB, i_row, ks, hh), acc);
#pragma unroll
            for (int r = 0; r < 16; ++r) { const int j = 32 * J + crow(r, hh); acc[r] = (j <= i_tok) ? acc[r] * 0.125f * __expf(gci - GT[64 + j]) : 0.f; }
            Xf[J][0] = pack8(acc, 0); Xf[J][1] = pack8(acc, 1);
        }
    }
    {
        f32x16 acc;
#pragma unroll
        for (int r = 0; r < 16; ++r) acc[r] = 0.f;
#pragma unroll
        for (int J = 0; J < 2; ++J) if (J <= I) {
#pragma unroll
            for (int s = 0; s < 2; ++s) acc = MFMA32(Xf[J][s], frag_kap(UT, 32 * c + col, 32 * J, s, hh), acc); }
        v4u* dst = (v4u*)(rec + 24576 + (I * 2 + c) * 2048 + lane * 32);
        dst[0] = (v4u){cvtpk(acc[0], acc[1]), cvtpk(acc[2], acc[3]), cvtpk(acc[4], acc[5]), cvtpk(acc[6], acc[7])};
        dst[1] = (v4u){cvtpk(acc[8], acc[9]), cvtpk(acc[10], acc[11]), cvtpk(acc[12], acc[13]), cvtpk(acc[14], acc[15])};
    }
    {
        f32x16 acc;
#pragma unroll
        for (int r = 0; r < 16; ++r) acc[r] = 0.f;
#pragma unroll
        for (int J = 0; J < 2; ++J) if (J <= I) {
#pragma unroll
            for (int s = 0; s < 2; ++s) acc = MFMA32(frag_kap(WT, 32 * c + col, 32 * J, s, hh), Xf[J][s], acc); }
        const float ei = GT[128 + i_tok] * 0.125f;
#pragma unroll
        for (int r4 = 0; r4 < 4; ++r4) { const v2u qv = *(const LAS v2u*)(QB + i_row * IMG + 32 * c + 8 * r4 + 4 * hh);
            acc[4 * r4 + 0] = ei * bflo(qv.x) - acc[4 * r4 + 0]; acc[4 * r4 + 1] = ei * bfhi(qv.x) - acc[4 * r4 + 1];
            acc[4 * r4 + 2] = ei * bflo(qv.y) - acc[4 * r4 + 2]; acc[4 * r4 + 3] = ei * bfhi(qv.y) - acc[4 * r4 + 3]; }
        *(bf16x8*)(rec + ((I * 2 + c) * 2 + 0) * 1024 + lane * 16) = pack8(acc, 0);
        *(bf16x8*)(rec + ((I * 2 + c) * 2 + 1) * 1024 + lane * 16) = pack8(acc, 1);
    }
    {
        f32x16 acc;
#pragma unroll
        for (int r = 0; r < 16; ++r) acc[r] = 0.f;
#pragma unroll
        for (int ks = 0; ks < 4; ++ks) acc = MFMA32(frag_nat(WT, 32 * I + col, ks, hh), frag_nat(KT, 32 * c + col, ks, hh), acc);
        const float egl = GT[320];
#pragma unroll
        for (int r = 0; r < 16; ++r) acc[r] = ((32 * I + crow(r, hh)) == (32 * c + col) ? egl : 0.f) - acc[r];
        *(bf16x8*)(rec + 8192 + ((c * 2 + I) * 2 + 0) * 1024 + lane * 16) = pack8(acc, 0);
        *(bf16x8*)(rec + 8192 + ((c * 2 + I) * 2 + 1) * 1024 + lane * 16) = pack8(acc, 1);
    }
    {
        f32x16 acc;
#pragma unroll
        for (int r = 0; r < 16; ++r) acc[r] = 0.f;
#pragma unroll
        for (int ks = 0; ks < 4; ++ks) acc = MFMA32(frag_nat(KT, 32 * I + col, ks, hh), frag_nat(UT, 32 * c + col, ks, hh), acc);
        v4u* dst = (v4u*)(rec + 16384 + (I * 2 + c) * 2048 + lane * 32);
        dst[0] = (v4u){cvtpk(acc[0], acc[1]), cvtpk(acc[2], acc[3]), cvtpk(acc[4], acc[5]), cvtpk(acc[6], acc[7])};
        dst[1] = (v4u){cvtpk(acc[8], acc[9]), cvtpk(acc[10], acc[11]), cvtpk(acc[12], acc[13]), cvtpk(acc[14], acc[15])};
    }
}
}

__device__ __forceinline__ void p3_dnprep2(const Args& a, LAS unsigned char* lds, int tid, int G, int bid) {
    using namespace pp;
    const int NIT = NB * NH * 32;
    LAS float* WCV = (LAS float*)(lds + WCV_OFF);
    const int wave = tid >> 6, lane = tid & 63;
    if (bid >= NIT) return;
    const int h0 = (bid >> 5) & 7;
    __syncthreads();
    for (int i = tid; i < 5 * 192; i += NTHR) { const int tp = i / 192, cc = i % 192; WCV[i] = a.in[7][tp * 1536 + (cc >> 6) * 512 + h0 * 64 + (cc & 63)]; }
    if (wave == 4 || wave == 5) gates(a, (LAS float*)(lds + G_BASE + (0 * 2 + (wave - 4)) * G_SZ), bid, wave - 4, lane);
    __syncthreads();
    if (wave >= 4) conv(a, lds + 0 * INP, WCV, bid, tid - 256);
    __syncthreads();
    mkt(lds, lds + 0 * INP, 0, tid);
    __syncthreads();
    int k = 0;
    for (int item = bid; item < NIT; item += G, ++k) {
        const int set = k & 1, nitem = item + G;
        LAS unsigned char* inp = lds + set * INP; LAS unsigned char* ninp = lds + (set ^ 1) * INP;
        if (wave < 4) {
            const int dir = wave & 1, w4 = wave >> 1;
            LAS unsigned char* wk = lds + W_BASE + dir * W_DIR;
            const LAS float* GT = (const LAS float*)(lds + G_BASE + (set * 2 + dir) * G_SZ);
            solve((const LAS float*)(wk + W_MT), (const LAS bf16*)(wk + W_ML), (const LAS bf16*)(inp + (w4 == 0 ? I_V : I_K)), dir, w4 == 0 ? GT : GT + 256, (LAS bf16*)(wk + (w4 == 0 ? W_UT : W_WT)), lane);
        } else if (nitem < NIT) {
            if (((nitem >> 5) & 7) != h0) { for (int i = tid - 256; i < 5 * 192; i += 256) { const int tp = i / 192, cc = i % 192; WCV[i] = a.in[7][tp * 1536 + (cc >> 6) * 512 + ((nitem >> 5) & 7) * 64 + (cc & 63)]; } }
            if (wave < 6) gates(a, (LAS float*)(lds + G_BASE + ((set ^ 1) * 2 + (wave - 4)) * G_SZ), nitem, wave - 4, lane);
            conv(a, ninp, WCV, nitem, tid - 256);
        }
        __syncthreads();
        stage5(a, lds, inp, set, item, tid);
        __syncthreads();
        if (nitem < NIT) mkt(lds, ninp, set ^ 1, tid);
        __syncthreads();
    }
}

struct EpiY {
    static constexpr bool PERM = true, AFTER_DRAIN = false;
    bf16* C; int ldc;
    __device__ __forceinline__ void operator()(const pg8::f32x4 (&acc)[2][2][4][2], const pg8::Unit& u, int wr, int wc, int fr, int fq) const {
        const int row0 = u.pm * 256 + wr * 64 + fr, col0 = u.pn * 256 + wc * 32 + 8 * fq;
#pragma unroll
        for (int ai = 0; ai < 2; ++ai)
#pragma unroll
            for (int m = 0; m < 4; ++m) { bf16* rowp = C + (size_t)(row0 + ai * 128 + m * 16) * ldc + col0;
#pragma unroll
                for (int bj = 0; bj < 2; ++bj) { const pg8::f32x4 v0 = acc[ai][bj][m][0], v1 = acc[ai][bj][m][1];
                    *(v4u*)(rowp + bj * 128) = (v4u){cvtpk(v0[0], v0[1]), cvtpk(v0[2], v0[3]), cvtpk(v1[0], v1[1]), cvtpk(v1[2], v1[3])}; } }
    }
};

constexpr int P7_HT = 0, P7_LGP = 131072, P7_LC = P7_LGP + 2 * 64 * 48 * 4;
__device__ __forceinline__ void p7_mid(const Args& a, LAS unsigned char* lds, int tid, int G, int bid) {
    const int lane = tid & 63, wave = tid >> 6;
    const float* gpost = a.in[5]; const float* gpre = a.in[13];
    for (int blk = bid; blk < T / 64; blk += G) {
        const int row0 = blk * 64;
        __syncthreads();
        v2u ny[4]; f32x4 nxx[4];
        { const int t0 = row0 + wave * 8;
#pragma unroll
          for (int j = 0; j < 4; ++j) { ny[j] = __builtin_nontemporal_load((const GAS v2u*)(a.YB + (size_t)t0 * D) + lane + 64 * j); nxx[j] = __builtin_nontemporal_load((const GAS f32x4*)(a.in[0] + (size_t)t0 * D) + lane + 64 * j); } }
        for (int k = 0; k < 8; ++k) {
            const int rl = wave * 8 + k, t = row0 + rl;
            const int b = t / S;
            const float* ad = a.ada + b * 6 * D;
            f32x4 yv[4], xv[4]; float ss = 0.f;
#pragma unroll
            for (int j = 0; j < 4; ++j) { yv[j] = (f32x4){bflo(ny[j].x), bfhi(ny[j].x), bflo(ny[j].y), bfhi(ny[j].y)}; xv[j] = nxx[j]; }
            if (k + 1 < 8) {
#pragma unroll
                for (int j = 0; j < 4; ++j) { ny[j] = __builtin_nontemporal_load((const GAS v2u*)(a.YB + (size_t)(t + 1) * D) + lane + 64 * j); nxx[j] = __builtin_nontemporal_load((const GAS f32x4*)(a.in[0] + (size_t)(t + 1) * D) + lane + 64 * j); } }
#pragma unroll
            for (int j = 0; j < 4; ++j) ss += (yv[j].x * yv[j].x + yv[j].y * yv[j].y) + (yv[j].z * yv[j].z + yv[j].w * yv[j].w);
            const float rstd = rsqrtf(wave_sum(ss) * (1.f / D) + EPS);
            float s2 = 0.f;
#pragma unroll
            for (int j = 0; j < 4; ++j) { const int kk = 4 * lane + 256 * j;
                const f32x4 gp = *(const f32x4*)(gpost + kk), gt = *(const f32x4*)(ad + 2 * D + kk);
                xv[j].x += gt.x * (yv[j].x * rstd * gp.x); xv[j].y += gt.y * (yv[j].y * rstd * gp.y); xv[j].z += gt.z * (yv[j].z * rstd * gp.z); xv[j].w += gt.w * (yv[j].w * rstd * gp.w);
                s2 += (xv[j].x * xv[j].x + xv[j].y * xv[j].y) + (xv[j].z * xv[j].z + xv[j].w * xv[j].w);
                __builtin_nontemporal_store(xv[j], (GAS f32x4*)(a.X1 + (size_t)t * D) + lane + 64 * j); }
            const float rstd2 = rsqrtf(wave_sum(s2) * (1.f / D) + EPS);
            GAS v2u* h8 = (GAS v2u*)(a.H2 + (size_t)t * D) + lane;
#pragma unroll
            for (int j = 0; j < 4; ++j) { const int kk = 4 * lane + 256 * j;
                const f32x4 gp = *(const f32x4*)(gpre + kk), sc = *(const f32x4*)(ad + 4 * D + kk), sh = *(const f32x4*)(ad + 3 * D + kk);
                const float h0 = xv[j].x * rstd2 * gp.x * (1.f + sc.x) + sh.x, h1 = xv[j].y * rstd2 * gp.y * (1.f + sc.y) + sh.y;
                const float h2v = xv[j].z * rstd2 * gp.z * (1.f + sc.z) + sh.z, h3 = xv[j].w * rstd2 * gp.w * (1.f + sc.w) + sh.w;
                const v2u pk = (v2u){cvtpk(h0, h1), cvtpk(h2v, h3)};
                h8[64 * j] = pk;
                *(LAS v2u*)(lds + P7_HT + rl * 2048 + ((((kk >> 3) ^ (rl & 15)) << 4) | ((lane & 1) << 3))) = pk; }
        }
        __syncthreads();
        {
            const int tt = wave & 3, kh = wave >> 2, q = lane & 15, g = lane >> 4, rl = 16 * tt + q;
            const bf16* whi = a.WrT + (size_t)q * D + 8 * g; const bf16* wlo = whi + 48 * D;
            f32x4 acc[3];
#pragma unroll
            for (int ot = 0; ot < 3; ++ot) acc[ot] = (f32x4){0.f, 0.f, 0.f, 0.f};
#pragma unroll 1
            for (int ks4 = 0; ks4 < 4; ++ks4) {
                bf16x8 ah[4][3], al[4][3], bfr[4];
#pragma unroll
                for (int kk = 0; kk < 4; ++kk) { const int ks = kh * 16 + ks4 * 4 + kk;
#pragma unroll
                    for (int ot = 0; ot < 3; ++ot) { ah[kk][ot] = *(const bf16x8*)(whi + (size_t)(16 * ot) * D + 32 * ks); al[kk][ot] = *(const bf16x8*)(wlo + (size_t)(16 * ot) * D + 32 * ks); }
                    bfr[kk] = *(const LAS bf16x8*)(lds + P7_HT + rl * 2048 + (((ks * 4 + g) ^ (rl & 15)) << 4)); }
#pragma unroll
                for (int kk = 0; kk < 4; ++kk)
#pragma unroll
                    for (int ot = 0; ot < 3; ++ot) { acc[ot] = __builtin_amdgcn_mfma_f32_16x16x32_bf16(ah[kk][ot], bfr[kk], acc[ot], 0, 0, 0); acc[ot] = __builtin_amdgcn_mfma_f32_16x16x32_bf16(al[kk][ot], bfr[kk], acc[ot], 0, 0, 0); }
            }
            LAS float* lgp = (LAS float*)(lds + P7_LGP) + (kh * 64 + rl) * 48 + 4 * g;
#pragma unroll
            for (int ot = 0; ot < 3; ++ot) *(LAS f32x4*)(lgp + 16 * ot) = acc[ot];
        }
        LAS int* LC = (LAS int*)(lds + P7_LC);
        if (tid < 64) LC[tid] = 0;
        __syncthreads();
        int e1 = 0, e2 = 0, q1 = 0, q2 = 0; float w1 = 0.f, w2 = 0.f;
        if (tid < 64) {
            const LAS float* l0 = (const LAS float*)(lds + P7_LGP) + tid * 48; const LAS float* l1 = l0 + 64 * 48;
            float lg[36];
#pragma unroll
            for (int o = 0; o < 36; ++o) lg[o] = l0[o] + l1[o] + (o < 4 ? a.in[16][o] : a.in[18][o - 4]);
            int g = 0; float gm = lg[0];
#pragma unroll
            for (int j = 1; j < 4; ++j) if (lg[j] > gm) { gm = lg[j]; g = j; }
            float gs = 0.f;
#pragma unroll
            for (int j = 0; j < 4; ++j) gs += __expf(lg[j] - gm);
            const float gpv = 1.f / gs;
            float el[8];
#pragma unroll
            for (int j = 0; j < 8; ++j) el[j] = g == 0 ? lg[4 + j] : (g == 1 ? lg[12 + j] : (g == 2 ? lg[20 + j] : lg[28 + j]));
            int i1 = 0; float l1v = el[0];
#pragma unroll
            for (int j = 1; j < 8; ++j) if (el[j] > l1v) { l1v = el[j]; i1 = j; }
            int i2 = -1; float l2v = -1e30f;
#pragma unroll
            for (int j = 0; j < 8; ++j) if (j != i1 && el[j] > l2v) { l2v = el[j]; i2 = j; }
            const float p2 = __expf(l2v - l1v);
            w1 = gpv / (1.f + p2); w2 = gpv * p2 / (1.f + p2);
            e1 = g * 8 + i1; e2 = g * 8 + i2;
            q1 = atomicAdd((int*)&LC[e1], 1); q2 = atomicAdd((int*)&LC[e2], 1);
        }
        __syncthreads();
        if (tid < NE) { const int c = LC[tid]; LC[32 + tid] = c ? atomicAdd(&a.cnt[tid], c) : 0; }
        __syncthreads();
        if (tid < 64) {
            const int trow = row0 + tid;
            q1 += LC[32 + e1]; q2 += LC[32 + e2];
            a.tok_w[trow * 2] = w1; a.tok_w[trow * 2 + 1] = w2;
            a.perm[(size_t)e1 * 2 * T + q1] = 2 * trow; a.perm[(size_t)e2 * 2 * T + q2] = 2 * trow + 1;
        }
    }
}

__device__ __forceinline__ void p4_moe_weights(const Args& a, LAS float* scr, int widx, int nw, int lane) {
    for (int it = widx; it < 24576; it += nw) {
        if (it < 16384) { const int e = it >> 9, src = (it >> 8) & 1, kb = (it >> 4) & 15, nb = it & 15, n0 = nb * 32;
            transpose_item((src ? a.in[20] : a.in[19]) + (size_t)e * D * DE, DE, n0, kb * 64, a.WguT + (size_t)e * 1024 * 1024, 1024, 256 * (n0 >> 7) + 128 * src + (n0 & 127), scr, lane);
        } else { const int r = it - 16384, e = r >> 8, kb = (r >> 5) & 7, nb = r & 31;
            transpose_item(a.in[21] + (size_t)e * DE * D, D, nb * 32, kb * 64, a.WdT + (size_t)e * 1024 * 512, 512, nb * 32, scr, lane); }
    }
}

constexpr int MOE_TB_OFF = RING_BYTES, MOE_TOK_OFF = RING_BYTES + 2048;
struct MoeOrder {
    const LAS int* TB; int lo, hi, j, gs;
    __device__ __forceinline__ void init(const LAS int* tb, int G, int bid) { TB = tb; const int NU = tb[0] * 4, x = bid & 7; lo = (x * NU) >> 3; hi = ((x + 1) * NU) >> 3; j = bid >> 3; gs = G >> 3; }
    __device__ __forceinline__ bool next(int i, pg8::Unit& u) const { const int L = lo + i * gs + j; if (L >= hi) return false; const int rt = L >> 2; u.pm = rt; u.pn = TB[4 + rt] * 4 + (L & 3); return true; }
    __device__ __forceinline__ void a_ready(const pg8::Unit&) const {}
    __device__ __forceinline__ void done(const pg8::Unit&) const {}
};
__device__ __forceinline__ void moe_setup(const Args& a, LAS unsigned char* lds, int tid, int G, int bid, bool need_tok) {
    LAS int* TB = (LAS int*)(lds + MOE_TB_OFF); LAS int* TOK = (LAS int*)(lds + MOE_TOK_OFF);
    __syncthreads();
    if (tid < NE) { int start = 0; for (int q = 0; q < tid; ++q) start += (a.cnt[q] + 255) >> 8; const int n = (a.cnt[tid] + 255) >> 8;
        for (int i = 0; i < n; ++i) { TB[4 + start + i] = tid; TB[164 + start + i] = i; }
        if (tid == NE - 1) TB[0] = start + n; }
    __syncthreads();
    if (need_tok) {
        MoeOrder O; O.init(TB, G, bid);
        for (int ui = 0; ui < 8; ++ui) { pg8::Unit u; if (!O.next(ui, u)) break;
            if (tid < 256) { const int e = u.pn >> 2, idx = 256 * TB[164 + u.pm] + tid; int pr = -1; if (idx < a.cnt[e]) pr = a.perm[(size_t)e * 2 * T + idx];
                TOK[ui * 256 + tid] = pr < 0 ? 0 : (pr >> 1); } }
        __syncthreads();
    }
}
struct EpiSwiglu {
    static constexpr bool PERM = true, AFTER_DRAIN = false;
    bf16* HE;
    __device__ __forceinline__ void operator()(const pg8::f32x4 (&acc)[2][2][4][2], const pg8::Unit& u, int wr, int wc, int fr, int fq) const {
        const int row0 = u.pm * 256 + wr * 64 + fr, col0 = (u.pn & 3) * 128 + wc * 32 + 8 * fq;
#pragma unroll
        for (int ai = 0; ai < 2; ++ai)
#pragma unroll
            for (int m = 0; m < 4; ++m) { bf16* rowp = HE + (size_t)(row0 + ai * 128 + m * 16) * DE + col0;
                const pg8::f32x4 g0 = acc[ai][0][m][0], g1 = acc[ai][0][m][1], u0 = acc[ai][1][m][0], u1 = acc[ai][1][m][1];
                v4u w; w.x = cvtpk(silu_f(g0[0]) * u0[0], silu_f(g0[1]) * u0[1]); w.y = cvtpk(silu_f(g0[2]) * u0[2], silu_f(g0[3]) * u0[3]);
                w.z = cvtpk(silu_f(g1[0]) * u1[0], silu_f(g1[1]) * u1[1]); w.w = cvtpk(silu_f(g1[2]) * u1[2], silu_f(g1[3]) * u1[3]);
                *(v4u*)rowp = w; }
    }
};
struct EpiScatter {
    static constexpr bool PERM = true, AFTER_DRAIN = false;
    bf16* Y2S; const int* perm; const float* tokw; const int* cnt; const LAS int* TB;
    __device__ __forceinline__ void operator()(const pg8::f32x4 (&acc)[2][2][4][2], const pg8::Unit& u, int wr, int wc, int fr, int fq) const {
        const int e = u.pn >> 2, lt = TB[164 + u.pm], ce = cnt[e];
        const int col0 = (u.pn & 3) * 256 + wc * 32 + 8 * fq;
#pragma unroll
        for (int ai = 0; ai < 2; ++ai)
#pragma unroll
            for (int m = 0; m < 4; ++m) { const int idx = 256 * lt + ai * 128 + wr * 64 + m * 16 + fr;
                if (idx < ce) { const int pr = perm[(size_t)e * 2 * T + idx]; const float w = tokw[pr];
                    bf16* rowp = Y2S + ((size_t)(pr & 1) * T + (pr >> 1)) * D + col0;
#pragma unroll
                    for (int bj = 0; bj < 2; ++bj) { const pg8::f32x4 v0 = acc[ai][bj][m][0], v1 = acc[ai][bj][m][1];
                        *(v4u*)(rowp + bj * 128) = (v4u){cvtpk(w * v0[0], w * v0[1]), cvtpk(w * v0[2], w * v0[3]), cvtpk(w * v1[0], w * v1[1]), cvtpk(w * v1[2], w * v1[3])}; } } }
    }
};
__device__ __forceinline__ void p10_final(const Args& a, int tid, int G, int bid) {
    const int lane = tid & 63, wave = tid >> 6;
    const float* gpost = a.in[14];
    const int t00 = bid * NWAVES + wave, tstep = G * NWAVES;
    v2u na[4], nb[4]; f32x4 nx[4];
    if (t00 < T) {
#pragma unroll
        for (int j = 0; j < 4; ++j) { na[j] = __builtin_nontemporal_load((const GAS v2u*)(a.Y2S + (size_t)t00 * D) + lane + 64 * j); nb[j] = __builtin_nontemporal_load((const GAS v2u*)(a.Y2S + ((size_t)T + t00) * D) + lane + 64 * j); nx[j] = __builtin_nontemporal_load((const GAS f32x4*)(a.out + (size_t)t00 * D) + lane + 64 * j); } }
    for (int t = t00; t < T; t += tstep) {
        const float* ad = a.ada + (t / S) * 6 * D + 5 * D;
        v2u pa[4], pb[4]; f32x4 xin[4];
#pragma unroll
        for (int j = 0; j < 4; ++j) { pa[j] = na[j]; pb[j] = nb[j]; xin[j] = nx[j]; }
        if (t + tstep < T) { const size_t tn = (size_t)t + tstep;
#pragma unroll
            for (int j = 0; j < 4; ++j) { na[j] = __builtin_nontemporal_load((const GAS v2u*)(a.Y2S + tn * D) + lane + 64 * j); nb[j] = __builtin_nontemporal_load((const GAS v2u*)(a.Y2S + ((size_t)T + tn) * D) + lane + 64 * j); nx[j] = __builtin_nontemporal_load((const GAS f32x4*)(a.out + tn * D) + lane + 64 * j); } }
        f32x4 yv[4]; float ss = 0.f;
#pragma unroll
        for (int j = 0; j < 4; ++j) { const v2u p = pa[j], q = pb[j];
            yv[j].x = bflo(p.x) + bflo(q.x); yv[j].y = bfhi(p.x) + bfhi(q.x); yv[j].z = bflo(p.y) + bflo(q.y); yv[j].w = bfhi(p.y) + bfhi(q.y);
            ss += (yv[j].x * yv[j].x + yv[j].y * yv[j].y) + (yv[j].z * yv[j].z + yv[j].w * yv[j].w); }
        const float rstd = rsqrtf(wave_sum(ss) * (1.f / D) + EPS);
        GAS f32x4* xo = (GAS f32x4*)(a.out + (size_t)t * D) + lane;
#pragma unroll
        for (int j = 0; j < 4; ++j) { const int k = 4 * lane + 256 * j; const f32x4 gp = *(const f32x4*)(gpost + k), gt = *(const f32x4*)(ad + k); f32x4 x = xin[j];
            x.x += gt.x * (yv[j].x * rstd * gp.x); x.y += gt.y * (yv[j].y * rstd * gp.y); x.z += gt.z * (yv[j].z * rstd * gp.z); x.w += gt.w * (yv[j].w * rstd * gp.w);
            __builtin_nontemporal_store(x, xo + 64 * j); }
    }
}


namespace cg = cooperative_groups;
__global__ void __launch_bounds__(NTHR, 2) mega(Args args) {
    extern __shared__ __attribute__((aligned(16))) unsigned char lds_raw[];
    LAS unsigned char* lds = (LAS unsigned char*)lds_raw;
    const int tid = threadIdx.x, G = gridDim.x, bid = blockIdx.x;
    const int lo = args.ph_lo, hi = args.ph_hi;
    cg::grid_group grid = cg::this_grid();
#define IN(k) (lo <= (k) && (k) < hi)
    volatile LAS unsigned* bst = (volatile LAS unsigned*)(lds + LDS_BYTES - 16);
    if (tid == 0) { bst[0] = 0u; bst[1] = 0u; }
    __syncthreads();
    const XcdBarrier xb = xcd_barrier_post(args.bar, bst);
#ifndef CG_SEAM
#define CG_SEAM 99
#endif
#define SEAM(k) do { if (IN(k) && IN((k) + 1)) { if ((k) == CG_SEAM) grid.sync(); else xcd_barrier(xb); } } while (0)
    if (IN(0)) { p0_prologue(args, lds, tid, G, bid); }
    SEAM(0);
    if (IN(1)) { p1_rows(args, tid, G, bid); }
    SEAM(1);
    if (IN(2)) {
        pg8::Gemm g{args.H, args.WinT, T, NIN, D}; pg8::StaticOrder So; So.init(T, NIN, G, bid);
        EpiG1 E{args.QKV, args.Z, args.NAQ, args.NAK, args.NAVT, args.GATES};
        pg8::gemm_phase<EpiG1, pg8::StaticOrder, true, true>(lds, g, So, E);
    }
    SEAM(2);
    if (IN(3)) { p3_dnprep2(args, lds, tid, G, bid); __syncthreads(); p3_na(args, lds, tid, G, bid); }
    SEAM(3);
    if (IN(4)) {
        if ((tid >> 6) == 0) { for (int id = bid; id < 256; id += G) p4_scan_wave(args, lds, id, tid & 63); }
        else p4_moe_weights(args, (LAS float*)(lds + (tid >> 6) * 8704), bid * 7 + (tid >> 6) - 1, G * 7, tid & 63);
    }
    SEAM(4);
    if (IN(5)) { p4b_dnout(args, tid, G, bid); }
    SEAM(5);
    if (IN(6)) {
        pg8::Gemm g{args.MIX, args.WoutT, T, D, D}; pg8::StaticOrder So; So.init(T, D, G, bid);
        EpiY E{args.YB, D};
        pg8::gemm_phase<EpiY, pg8::StaticOrder, true, true>(lds, g, So, E);
    }
    SEAM(6);
    if (IN(7)) { p7_mid(args, lds, tid, G, bid); }
    SEAM(7);
    if (IN(8)) {
        moe_setup(args, lds, tid, G, bid, true);
        pg8::Gemm g{args.H2, args.WguT, 0, 0, D}; MoeOrder Mo; Mo.init((const LAS int*)(lds + MOE_TB_OFF), G, bid);
        EpiSwiglu E{args.HE};
        pg8::gemm_phase_gather<EpiSwiglu, MoeOrder, true>(lds, g, (const LAS int*)(lds + MOE_TOK_OFF), Mo, E);
    }
    SEAM(8);
    if (IN(9)) {
        moe_setup(args, lds, tid, G, bid, false);
        pg8::Gemm g{args.HE, args.WdT, 0, 0, DE}; MoeOrder Mo; Mo.init((const LAS int*)(lds + MOE_TB_OFF), G, bid);
        EpiScatter E{args.Y2S, args.perm, args.tok_w, args.cnt, (const LAS int*)(lds + MOE_TB_OFF)};
        pg8::gemm_phase<EpiScatter, MoeOrder, true, true>(lds, g, Mo, E);
    }
    SEAM(9);
    if (IN(10)) { p10_final(args, tid, G, bid); }
#undef IN
#undef SEAM
}


static void fill_args(Args& a, void* const* d_in, void* d_out, void* d_ws) {
    const size_t MiB = 1u << 20; unsigned char* ws = (unsigned char*)d_ws;
    for (int i = 0; i < 22; ++i) a.in[i] = (const float*)d_in[i];
    a.out = (float*)d_out; a.ws = ws;
    a.bar = (unsigned*)(ws + 4096); a.cnt = (int*)ws;
    a.ada = (float*)(ws + 1 * MiB); a.tok_w = (float*)(ws + 1 * MiB + 256 * 1024); a.tok_e = (int*)(ws + 1 * MiB + 384 * 1024); a.tok_pos = (int*)(ws + 1 * MiB + 512 * 1024);
    a.WinT = (bf16*)(ws + 2 * MiB); a.WoutT = (bf16*)(ws + 10 * MiB); a.WrT = (bf16*)(ws + 1 * MiB + 640 * 1024);
    a.H = (bf16*)(ws + 12 * MiB); a.PREP = (bf16*)(ws + 12 * MiB); a.HE = (bf16*)(ws + 12 * MiB); a.Y2S = (bf16*)(ws + 52 * MiB);
    a.QKV = (bf16*)(ws + 140 * MiB); a.NAQ = (bf16*)(ws + 188 * MiB); a.NAK = (bf16*)(ws + 204 * MiB); a.NAVT = (bf16*)(ws + 220 * MiB);
    a.WguT = (bf16*)(ws + 140 * MiB); a.WdT = (bf16*)(ws + 204 * MiB);
    a.Z = (bf16*)(ws + 236 * MiB); a.GATES = (float*)(ws + 252 * MiB); a.MIX = (bf16*)(ws + 254 * MiB); a.H2 = (bf16*)(ws + 236 * MiB);
    a.perm = (int*)(ws + 286 * MiB);
    a.Y = (float*)d_out; a.X1 = (float*)d_out; a.YB = (bf16*)(ws + 12 * MiB);
}
extern "C" void kernel_launch(void* const* d_in, const int* in_sizes, int n_in, void* d_out, int out_size, void* d_ws, size_t ws_size, hipStream_t stream) {
    const size_t MiB = 1u << 20;
    if (ws_size < (size_t)290 * MiB) { fprintf(stderr, "kernel_launch: workspace too small: %zu\n", ws_size); return; }
    static int attr_done = 0;
    if (!attr_done) { (void)hipFuncSetAttribute((const void*)mega, hipFuncAttributeMaxDynamicSharedMemorySize, LDS_BYTES); attr_done = 1; }
    (void)hipMemsetAsync(d_ws, 0, 1 * MiB, stream);
    Args a{};
    fill_args(a, d_in, d_out, d_ws);
    a.ph_lo = 0; a.ph_hi = 11;
    static int grid_blocks = 0;
    if (!grid_blocks) { int dev = 0, cus = 0, per_cu = 0; (void)hipGetDevice(&dev); (void)hipDeviceGetAttribute(&cus, hipDeviceAttributeMultiprocessorCount, dev);
        (void)hipOccupancyMaxActiveBlocksPerMultiprocessor(&per_cu, (const void*)mega, NTHR, LDS_BYTES);
        if (per_cu < 1) { fprintf(stderr, "kernel_launch: occupancy query says %d blocks per CU\n", per_cu); per_cu = 1; }
        if (per_cu > 1) per_cu = 1;
        grid_blocks = cus * per_cu; if (grid_blocks % 8) grid_blocks -= grid_blocks % 8; }
    void* kargs[] = {&a};
    hipError_t e = hipLaunchCooperativeKernel((const void*)mega, dim3(grid_blocks), dim3(NTHR), kargs, LDS_BYTES, stream);
    if (e != hipSuccess) fprintf(stderr, "kernel_launch: cooperative launch failed: %s (grid %d)\n", hipGetErrorString(e), grid_blocks);
}
```

```cpp
#include <hip/hip_runtime.h>
#include <cstdio>
#include <cstdint>
#include <utility>

constexpr int D = 1024, NB = 8, S = 2048, T = NB * S;
constexpr int HD = 64, NH = 8, DNW = 512, NAW = 512;
constexpr int INW = 3616;
constexpr int GW = 64, ROWS = S / GW;
constexpr int NE = 32, DE = 512;
constexpr float EPS = 1e-6f;
constexpr int SEGPAD = 256;
constexpr int MAXROWS = 2 * T + NE * SEGPAD;

constexpr int C_Q = 0, C_K = 512, C_V = 1024, C_Z = 1536, C_AF = 2048, C_AB = 2056, C_BF = 2064, C_BB = 2072, C_NQ = 2080, C_NK = 2592, C_NV = 3104;

__device__ __forceinline__ float silu_f(float x) { return x * __builtin_amdgcn_rcpf(1.f + __expf(-x)); }
__device__ __forceinline__ float sigmoid_f(float x) { return __builtin_amdgcn_rcpf(1.f + __expf(-x)); }
__device__ __forceinline__ float softplus_f(float x) { return x > 20.f ? x : log1pf(__expf(x)); }

__device__ __forceinline__ float wave_sum(float v) {
#pragma unroll
    for (int o = 1; o < 64; o <<= 1) v += __shfl_xor(v, o);
    return v;
}
__device__ __forceinline__ float block_sum256(float v, float* red) {
    v = wave_sum(v);
    __syncthreads();
    if ((threadIdx.x & 63) == 0) red[threadIdx.x >> 6] = v;
    __syncthreads();
    return red[0] + red[1] + red[2] + red[3];
}


#include <hip/hip_cooperative_groups.h>
#define GAS __attribute__((address_space(1)))
#define LAS __attribute__((address_space(3)))
typedef unsigned short bf16;
typedef unsigned v4u __attribute__((ext_vector_type(4)));
typedef unsigned v2u __attribute__((ext_vector_type(2)));
typedef float f32x4 __attribute__((ext_vector_type(4)));
typedef float f32x16 __attribute__((ext_vector_type(16)));
typedef short bf16x8 __attribute__((ext_vector_type(8)));
typedef short bf16x4 __attribute__((ext_vector_type(4)));
#define LDS_WAIT() asm volatile("s_waitcnt lgkmcnt(0)" ::: "memory")
#define VM_WAIT() asm volatile("s_waitcnt vmcnt(0)" ::: "memory")
__device__ __forceinline__ unsigned f2bf(float f) { unsigned u = __builtin_bit_cast(unsigned, f); return (u + 0x7fffu + ((u >> 16) & 1u)) >> 16; }
__device__ __forceinline__ unsigned pk2(float lo, float hi) { return f2bf(lo) | (f2bf(hi) << 16); }
typedef float f32x2_t __attribute__((ext_vector_type(2))); typedef __bf16 bf16x2_t __attribute__((ext_vector_type(2)));
__device__ __forceinline__ unsigned cvtpk(float lo, float hi) { f32x2_t v = {lo, hi}; bf16x2_t b = __builtin_convertvector(v, bf16x2_t); return __builtin_bit_cast(unsigned, b); }
__device__ __forceinline__ float bf2f(unsigned short b) { return __builtin_bit_cast(float, (unsigned)b << 16); }
__device__ __forceinline__ float bflo(unsigned w) { return __builtin_bit_cast(float, w << 16); }
__device__ __forceinline__ float bfhi(unsigned w) { return __builtin_bit_cast(float, w & 0xffff0000u); }

constexpr int NWAVES = 8, NTHR = 512;
constexpr int NIN = 3840;
constexpr int RING_BYTES = 131072;
constexpr int LDS_BYTES = 163840;

struct Args {
    const float* in[22]; float* out; unsigned char* ws;
    float* ada; unsigned* bar;
    bf16* WinT; bf16* WoutT; bf16* WguT; bf16* WdT; bf16* WrT;
    bf16* H; bf16* QKV; bf16* Z; bf16* NAQ; bf16* NAK; bf16* NAVT; float* GATES;
    bf16* PREP; bf16* MIX; float* Y; bf16* YB; bf16* X1B; bf16* H2; bf16* HE; bf16* Y2S;
    int* cnt; int* tok_e; float* tok_w; int* tok_pos; int* perm;
    int ph_lo, ph_hi;
};

template <int CTRL, int RMASK> __device__ __forceinline__ float dppf(float v) { return __builtin_bit_cast(float, __builtin_amdgcn_update_dpp(0, __builtin_bit_cast(int, v), CTRL, RMASK, 0xF, false)); }
__device__ __forceinline__ float wave_sum_hi(float v) {
    v += dppf<0xB1, 0xF>(v); v += dppf<0x4E, 0xF>(v); v += dppf<0x141, 0xF>(v); v += dppf<0x140, 0xF>(v);
    v += dppf<0x142, 0xA>(v); v += dppf<0x143, 0xC>(v);
    return v;
}

#define XB_TMO      128
#define XB_XCNT(j)  (256  + 64 * (j))
#define XB_XSUB(j)  (1280 + 64 * (j))
#define XB_XGEN(j)  (2304 + 64 * (j))
#define XB_TOP      3328
#define XB_TOPGEN   3392
#define XCD_BAR_WORDS 3456
#define XB_SPIN_CAP (1u << 18)

__device__ __forceinline__ unsigned xb_ld(unsigned* p)              { return __hip_atomic_load(p, __ATOMIC_RELAXED, __HIP_MEMORY_SCOPE_AGENT); }
__device__ __forceinline__ unsigned xb_add(unsigned* p, unsigned v) { return __hip_atomic_fetch_add(p, v, __ATOMIC_RELAXED, __HIP_MEMORY_SCOPE_AGENT); }
__device__ __forceinline__ unsigned xb_xcc_id() { return (unsigned)__builtin_amdgcn_s_getreg((3 << 11) | 20) & 0xFu; }
#define XB_SPIN(cond, bar) do { unsigned _sp = 0; while (cond) { __builtin_amdgcn_s_sleep(1); \
    if ((++_sp & 255u) == 0u) { if (xb_ld(&(bar)[XB_TMO])) break; if (_sp > XB_SPIN_CAP) { atomicAdd(&(bar)[XB_TMO], 1u); break; } } } } while (0)

struct XcdBarrier {
    unsigned* bar; unsigned x;
    volatile LAS unsigned* st;
};

__device__ __forceinline__ XcdBarrier xcd_barrier_post(unsigned* bar, volatile LAS unsigned* st) {
    XcdBarrier b; b.bar = bar; b.x = xb_xcc_id(); b.st = st;
    if (threadIdx.x == 0) (void)xb_add(&bar[XB_XCNT(b.x)], 1u);
    return b;
}
__device__ __forceinline__ void xcd_barrier_complete(unsigned* bar, unsigned x, unsigned& nloc, unsigned& nx) {
    const unsigned G = gridDim.x * gridDim.y * gridDim.z;
    unsigned sum, cnt, mine, sp = 0u;
    for (;;) {
        sum = 0u; cnt = 0u; mine = 0u;
#pragma unroll
        for (unsigned j = 0; j < 16; ++j) { const unsigned c = xb_ld(&bar[XB_XCNT(j)]); sum += c; cnt += (c > 0u) ? 1u : 0u; mine = (j == x) ? c : mine; }
        if (sum == G) break;
        __builtin_amdgcn_s_sleep(1);
        if ((++sp & 255u) == 0u) { if (xb_ld(&bar[XB_TMO])) break; if (sp > XB_SPIN_CAP) { atomicAdd(&bar[XB_TMO], 1u); break; } }
    }
    nloc = mine > 0u ? mine : 1u; nx = cnt > 0u ? cnt : 1u;
}

__device__ __forceinline__ void xcd_barrier(const XcdBarrier& b) {
    asm volatile("s_waitcnt vmcnt(0)" ::: "memory");
    __syncthreads();
    if (threadIdx.x == 0) {
        unsigned* bar = b.bar;
        __builtin_amdgcn_s_waitcnt(0);
        unsigned nloc = b.st[0], nx = b.st[1];
        if (nloc == 0u) { xcd_barrier_complete(bar, b.x, nloc, nx); b.st[0] = nloc; b.st[1] = nx; }
        const unsigned old = xb_add(&bar[XB_XSUB(b.x)], 1u);
        const unsigned gen = old / nloc;
        if (old + 1u == (gen + 1u) * nloc) {
            __builtin_amdgcn_fence(__ATOMIC_RELEASE, "agent");
            asm volatile("s_waitcnt vmcnt(0)" ::: "memory");
            const unsigned og = xb_add(&bar[XB_TOP], 1u);
            const unsigned tg = og / nx;
            if (og + 1u == (tg + 1u) * nx) xb_add(&bar[XB_TOPGEN], 1u);
            else XB_SPIN(xb_ld(&bar[XB_TOPGEN]) == tg, bar);
            __builtin_amdgcn_fence(__ATOMIC_ACQUIRE, "agent");
            xb_add(&bar[XB_XGEN(b.x)], 1u);
            asm volatile("s_waitcnt vmcnt(0)" ::: "memory");
        } else {
            XB_SPIN(xb_ld(&bar[XB_XGEN(b.x)]) == gen, bar);
            __builtin_amdgcn_fence(__ATOMIC_ACQUIRE, "agent");
            asm volatile("s_waitcnt vmcnt(0)" ::: "memory");
        }
    }
    __syncthreads();
}

namespace pg8 {
#define PG8_LAS __attribute__((address_space(3)))
typedef unsigned short bf16_t;
typedef short bf16x8 __attribute__((ext_vector_type(8)));
typedef float f32x4 __attribute__((ext_vector_type(4)));
typedef unsigned u32x4 __attribute__((ext_vector_type(4)));
constexpr int BM = 256, BK = 64, HALF = 128, HTB = HALF * BK * 2  , STAGE_BYTES = 8 * HTB, NXCD = 8, WGM = 8;

__host__ __device__ __forceinline__ int lds_byte(int r, int c) { const int st = (r >> 4) * 2 + (c >> 5), rr = r & 15, cc = c & 31, ob = rr * 64 + cc * 2; return st * 1024 + (ob ^ (((ob >> 9) & 1) << 5)); }
__host__ __device__ __forceinline__ void stage_rc(int b, int& R, int& C) { const int st = b / 1024, sb = b % 1024, swz = sb ^ (((sb >> 9) & 1) << 5); R = (st >> 1) * 16 + swz / 64; C = (st & 1) * 32 + (swz % 64) / 2; }
__host__ __device__ __forceinline__ int perm32(int rho) { const int n = rho >> 4, i = rho & 15; return 8 * (i >> 2) + 4 * n + (i & 3); }

struct Unit { int pm, pn; };
struct Gemm { const bf16_t* A; const bf16_t* Bt; int M, N, K; };

struct StaticOrder {
    int nM, nN, nwg, G, c;
    __host__ __device__ void init(int M, int N, int G_, int c_) { nM = M / BM; nN = N / BM; nwg = nM * nN; G = G_; c = c_; }
    __host__ __device__ bool next(int i, Unit& u) const {
        const long L = (long)i * G + c; if (L >= nwg) return false;
        int wgid = (int)L; { const int q = nwg / NXCD, r = nwg % NXCD, xcd = wgid % NXCD, off = wgid / NXCD; wgid = (xcd < r ? xcd * (q + 1) : r * (q + 1) + (xcd - r) * q) + off; }
        const int nig = WGM * nN, gid = wgid / nig, fm = gid * WGM, gsz = (nM - fm) < WGM ? (nM - fm) : WGM;
        u.pm = fm + ((wgid % nig) % gsz); u.pn = (wgid % nig) / gsz; return true;
    }
    __device__ __forceinline__ void a_ready(const Unit&) const {}
    __device__ __forceinline__ void done(const Unit&) const {}
};


__device__ __forceinline__ unsigned cvt_pk_bf16(float lo, float hi) { unsigned r; asm volatile("v_cvt_pk_bf16_f32 %0, %1, %2" : "=v"(r) : "v"(lo), "v"(hi)); return r; }

template <class Epi, class Sched, bool ALIGN_EPI = false, bool SP2 = false>
__device__ __forceinline__ void gemm_phase(PG8_LAS unsigned char* lds, const Gemm g, const Sched& S, const Epi& E) {
    const int tid = threadIdx.x, wid = __builtin_amdgcn_readfirstlane(tid >> 6), lane = tid & 63, wr = wid >> 2, wc = wid & 3, fr = lane & 15, fq = lane >> 4;
    const int K = g.K, nt = K / BK;
    unsigned voffA[2], voffB[2];
#pragma unroll
    for (int i = 0; i < 2; ++i) { int R, C; stage_rc(tid * 16 + i * 8192, R, C); const int Rb = Epi::PERM ? ((R & ~31) + perm32(R & 31)) : R;
        voffA[i] = (unsigned)(R * K + C) * 2u; voffB[i] = (unsigned)(Rb * K + C) * 2u; }
    const size_t kstep = (size_t)(BK * 2);
    const size_t hstep = (size_t)HALF * K * 2;
    const size_t tstep = 2 * hstep;
    const unsigned ldsw = (unsigned)wid * 1024u;
    const int aoff = lds_byte(wr * 64 + fr, fq * 8), boff = lds_byte(wc * 32 + fr, fq * 8);
#define PG8_SA(b, h) (((b) * 2 + (h)) * HTB)
#define PG8_SB(b, h) ((4 + (b) * 2 + (h)) * HTB)
#define PG8_STAGE(bufoff, gbase, voff) do { _Pragma("unroll") for (int _i = 0; _i < 2; ++_i) \
        __builtin_amdgcn_global_load_lds((const unsigned*)((const char*)(gbase) + (voff)[_i]), (PG8_LAS unsigned*)(lds + (bufoff) + ldsw + _i * 8192), 16, 0, 0); } while (0)
#define PG8_LDA(dst, b, h) do { _Pragma("unroll") for (int m = 0; m < 4; ++m) _Pragma("unroll") for (int k = 0; k < 2; ++k) dst[m][k] = *(const PG8_LAS bf16x8*)(lds + PG8_SA(b, h) + aoff + m * 2048 + k * 1024); } while (0)
#define PG8_LDB(dst, b, h) do { _Pragma("unroll") for (int n = 0; n < 2; ++n) _Pragma("unroll") for (int k = 0; k < 2; ++k) dst[n][k] = *(const PG8_LAS bf16x8*)(lds + PG8_SB(b, h) + boff + n * 2048 + k * 1024); } while (0)
#define PG8_MMA(ai, bj, At, Bt) do { __builtin_amdgcn_s_setprio(1); _Pragma("unroll") for (int m = 0; m < 4; ++m) _Pragma("unroll") for (int n = 0; n < 2; ++n) _Pragma("unroll") for (int k = 0; k < 2; ++k) \
        acc[ai][bj][m][n] = __builtin_amdgcn_mfma_f32_16x16x32_bf16(Bt[n][k], At[m][k], acc[ai][bj][m][n], 0, 0, 0); __builtin_amdgcn_s_setprio(0); } while (0)
#define PG8_WAIT_V(n) asm volatile("s_waitcnt vmcnt(" #n ")" ::: "memory")
#define PG8_WAIT_L(n) asm volatile("s_waitcnt lgkmcnt(" #n ")" ::: "memory")
#define PG8_BAR __builtin_amdgcn_s_barrier()
#define PG8_SCHED __builtin_amdgcn_sched_barrier(0)
    Unit cur, nxt; int ui = 0;
    if (!S.next(0, cur)) return;
    f32x4 acc[2][2][4][2];
#pragma unroll
    for (int a = 0; a < 2; ++a)
#pragma unroll
        for (int b = 0; b < 2; ++b)
#pragma unroll
            for (int m = 0; m < 4; ++m)
#pragma unroll
                for (int n = 0; n < 2; ++n) acc[a][b][m][n] = (f32x4){0.f, 0.f, 0.f, 0.f};
    bf16x8 At[4][2], B0[2][2], B1[2][2];
    const char* cA = (const char*)g.A + (size_t)cur.pm * tstep; const char* cB = (const char*)g.Bt + (size_t)cur.pn * tstep;
    S.a_ready(cur);
    if constexpr (SP2) {
        PG8_STAGE(PG8_SB(0, 0), cB, voffB); PG8_STAGE(PG8_SB(0, 1), cB + hstep, voffB); PG8_STAGE(PG8_SA(0, 0), cA, voffA); PG8_STAGE(PG8_SA(0, 1), cA + hstep, voffA);
        if (wr == 1) PG8_BAR;
        PG8_WAIT_V(2); PG8_BAR;
        PG8_STAGE(PG8_SB(1, 0), cB + kstep, voffB); PG8_STAGE(PG8_SA(1, 0), cA + kstep, voffA); PG8_STAGE(PG8_SB(1, 1), cB + hstep + kstep, voffB);
        PG8_WAIT_V(6); PG8_BAR;
    } else {
        PG8_STAGE(PG8_SB(0, 0), cB, voffB); PG8_STAGE(PG8_SA(0, 0), cA, voffA); PG8_STAGE(PG8_SB(0, 1), cB + hstep, voffB); PG8_STAGE(PG8_SA(0, 1), cA + hstep, voffA);
        if (wr == 1) PG8_BAR;
        PG8_WAIT_V(4); PG8_BAR;
        PG8_STAGE(PG8_SB(1, 0), cB + kstep, voffB); PG8_STAGE(PG8_SA(1, 0), cA + kstep, voffA); PG8_STAGE(PG8_SB(1, 1), cB + hstep + kstep, voffB);
        PG8_WAIT_V(6); PG8_BAR;
    }
    for (;;) {
        const bool has_next = S.next(ui + 1, nxt);
        const char* nA = has_next ? (const char*)g.A + (size_t)nxt.pm * tstep : cA; const char* nB = has_next ? (const char*)g.Bt + (size_t)nxt.pn * tstep : cB;
        for (int t = 0; t < nt; t += 2) {
            const bool last = (t == nt - 2);
            const char* a1 = cA + (size_t)(t + 1) * kstep;
            const char* a2 = last ? nA : cA + (size_t)(t + 2) * kstep; const char* b2 = last ? nB : cB + (size_t)(t + 2) * kstep;
            const char* a3 = a2 + kstep; const char* b3 = b2 + kstep;
            if (last && has_next) S.a_ready(nxt);
            if constexpr (SP2) {
            PG8_LDB(B0, 0, 0); PG8_LDB(B1, 0, 1); PG8_SCHED; PG8_LDA(At, 0, 0); PG8_STAGE(PG8_SA(1, 1), a1 + hstep, voffA);
            PG8_WAIT_V(8); PG8_WAIT_L(0); PG8_BAR; PG8_MMA(0, 0, At, B0); PG8_MMA(0, 1, At, B1); PG8_BAR; PG8_SCHED;
            PG8_LDA(At, 0, 1); PG8_STAGE(PG8_SB(0, 0), b2, voffB); PG8_STAGE(PG8_SB(0, 1), b2 + hstep, voffB); PG8_STAGE(PG8_SA(0, 0), a2, voffA);
            PG8_WAIT_V(8); PG8_WAIT_L(0); PG8_BAR; PG8_MMA(1, 0, At, B0); PG8_MMA(1, 1, At, B1); PG8_BAR; PG8_SCHED;
            PG8_LDB(B0, 1, 0); PG8_LDB(B1, 1, 1); PG8_SCHED; PG8_LDA(At, 1, 0); PG8_STAGE(PG8_SA(0, 1), a2 + hstep, voffA);
            PG8_WAIT_V(8); PG8_WAIT_L(0); PG8_BAR; PG8_MMA(0, 0, At, B0); PG8_MMA(0, 1, At, B1); PG8_BAR; PG8_SCHED;
            PG8_LDA(At, 1, 1); PG8_STAGE(PG8_SB(1, 0), b3, voffB); PG8_STAGE(PG8_SB(1, 1), b3 + hstep, voffB); PG8_STAGE(PG8_SA(1, 0), a3, voffA);
            PG8_WAIT_V(8); PG8_WAIT_L(0); PG8_BAR; PG8_MMA(1, 0, At, B0); PG8_MMA(1, 1, At, B1); PG8_BAR; PG8_SCHED;
            } else {
            PG8_LDB(B0, 0, 0); PG8_SCHED; PG8_LDA(At, 0, 0); PG8_STAGE(PG8_SA(1, 1), a1 + hstep, voffA);
            PG8_WAIT_L(8); PG8_BAR; PG8_WAIT_L(0); PG8_MMA(0, 0, At, B0); PG8_BAR; PG8_SCHED;
            PG8_LDB(B1, 0, 1); PG8_STAGE(PG8_SB(0, 0), b2, voffB);
            PG8_BAR; PG8_WAIT_L(0); PG8_MMA(0, 1, At, B1); PG8_BAR;
            PG8_LDA(At, 0, 1); PG8_STAGE(PG8_SA(0, 0), a2, voffA);
            PG8_BAR; PG8_WAIT_L(0); PG8_MMA(1, 0, At, B0); PG8_BAR; PG8_SCHED;
            PG8_STAGE(PG8_SB(0, 1), b2 + hstep, voffB);
            PG8_WAIT_V(6); PG8_BAR; PG8_MMA(1, 1, At, B1); PG8_BAR;
            PG8_LDB(B0, 1, 0); PG8_SCHED; PG8_LDA(At, 1, 0); PG8_STAGE(PG8_SA(0, 1), a2 + hstep, voffA);
            PG8_WAIT_L(8); PG8_BAR; PG8_WAIT_L(0); PG8_MMA(0, 0, At, B0); PG8_BAR; PG8_SCHED;
            PG8_LDB(B1, 1, 1); PG8_STAGE(PG8_SB(1, 0), b3, voffB);
            PG8_BAR; PG8_WAIT_L(0); PG8_MMA(0, 1, At, B1); PG8_BAR;
            PG8_LDA(At, 1, 1); PG8_STAGE(PG8_SA(1, 0), a3, voffA);
            PG8_BAR; PG8_WAIT_L(0); PG8_MMA(1, 0, At, B0); PG8_BAR; PG8_SCHED;
            PG8_STAGE(PG8_SB(1, 1), b3 + hstep, voffB);
            PG8_WAIT_V(6); PG8_BAR; PG8_MMA(1, 1, At, B1); PG8_BAR;
            }
        }
        if constexpr (ALIGN_EPI) { if (wr == 0) PG8_BAR; }
        if constexpr (!Epi::AFTER_DRAIN) { E(acc, cur, wr, wc, fr, fq); S.done(cur); }
        if (!has_next) break;
#pragma unroll
        for (int a = 0; a < 2; ++a)
#pragma unroll
            for (int b = 0; b < 2; ++b)
#pragma unroll
                for (int m = 0; m < 4; ++m)
#pragma unroll
                    for (int n = 0; n < 2; ++n) acc[a][b][m][n] = (f32x4){0.f, 0.f, 0.f, 0.f};
        cur = nxt; cA = nA; cB = nB; ++ui;
        if constexpr (ALIGN_EPI) { if (wr == 1) PG8_BAR; }
    }
    PG8_WAIT_V(0);
    if constexpr (!ALIGN_EPI) { if (wr == 0) PG8_BAR; }
    PG8_BAR;
    if constexpr (Epi::AFTER_DRAIN) { E.fused(acc, cur, wr, wc, fr, fq, lds, wid, lane); S.done(cur); }
#undef PG8_SA
#undef PG8_SB
#undef PG8_STAGE
#undef PG8_LDA
#undef PG8_LDB
#undef PG8_MMA
#undef PG8_WAIT_V
#undef PG8_WAIT_L
#undef PG8_BAR
#undef PG8_SCHED
}
}

namespace pg8 {
template <class Epi, class Sched, bool ALIGN_EPI>
__device__ __forceinline__ void gemm_phase_gather(PG8_LAS unsigned char* lds, const Gemm g, const PG8_LAS int* tok, const Sched& S, const Epi& E) {
    const int tid = threadIdx.x, wid = __builtin_amdgcn_readfirstlane(tid >> 6), lane = tid & 63, wr = wid >> 2, wc = wid & 3, fr = lane & 15, fq = lane >> 4;
    const int K = g.K, nt = K / BK;
    unsigned voffB[2]; int RA[2], CA[2];
#pragma unroll
    for (int i = 0; i < 2; ++i) { int R, C; stage_rc(tid * 16 + i * 8192, R, C); const int Rb = Epi::PERM ? ((R & ~31) + perm32(R & 31)) : R;
        RA[i] = R; CA[i] = C; voffB[i] = (unsigned)(Rb * K + C) * 2u; }
    const size_t kstep = (size_t)(BK * 2);
    const size_t hstep = (size_t)HALF * K * 2;
    const size_t tstep = 2 * hstep;
    const unsigned ldsw = (unsigned)wid * 1024u;
    const int aoff = lds_byte(wr * 64 + fr, fq * 8), boff = lds_byte(wc * 32 + fr, fq * 8);
#define PG8_SA(b, h) (((b) * 2 + (h)) * HTB)
#define PG8_SB(b, h) ((4 + (b) * 2 + (h)) * HTB)
#define PG8_STAGE(bufoff, gbase, voff) do { _Pragma("unroll") for (int _i = 0; _i < 2; ++_i) \
        __builtin_amdgcn_global_load_lds((const unsigned*)((const char*)(gbase) + (voff)[_i]), (PG8_LAS unsigned*)(lds + (bufoff) + ldsw + _i * 8192), 16, 0, 0); } while (0)
#define PG8_LDA(dst, b, h) do { _Pragma("unroll") for (int m = 0; m < 4; ++m) _Pragma("unroll") for (int k = 0; k < 2; ++k) dst[m][k] = *(const PG8_LAS bf16x8*)(lds + PG8_SA(b, h) + aoff + m * 2048 + k * 1024); } while (0)
#define PG8_LDB(dst, b, h) do { _Pragma("unroll") for (int n = 0; n < 2; ++n) _Pragma("unroll") for (int k = 0; k < 2; ++k) dst[n][k] = *(const PG8_LAS bf16x8*)(lds + PG8_SB(b, h) + boff + n * 2048 + k * 1024); } while (0)
#define PG8_MMA(ai, bj, At, Bt) do { __builtin_amdgcn_s_setprio(1); _Pragma("unroll") for (int m = 0; m < 4; ++m) _Pragma("unroll") for (int n = 0; n < 2; ++n) _Pragma("unroll") for (int k = 0; k < 2; ++k) \
        acc[ai][bj][m][n] = __builtin_amdgcn_mfma_f32_16x16x32_bf16(Bt[n][k], At[m][k], acc[ai][bj][m][n], 0, 0, 0); __builtin_amdgcn_s_setprio(0); } while (0)
#define PG8_WAIT_V(n) asm volatile("s_waitcnt vmcnt(" #n ")" ::: "memory")
#define PG8_WAIT_L(n) asm volatile("s_waitcnt lgkmcnt(" #n ")" ::: "memory")
#define PG8_BAR __builtin_amdgcn_s_barrier()
#define PG8_SCHED __builtin_amdgcn_sched_barrier(0)
#define PG8_GOFF(ui_, o0, o1) do { _Pragma("unroll") for (int _i = 0; _i < 2; ++_i) { \
        o0[_i] = (unsigned)(tok[(ui_) * 256 + RA[_i]] * K + CA[_i]) * 2u; o1[_i] = (unsigned)(tok[(ui_) * 256 + 128 + RA[_i]] * K + CA[_i]) * 2u; } } while (0)
    Unit cur, nxt; int ui = 0;
    if (!S.next(0, cur)) return;
    f32x4 acc[2][2][4][2];
#pragma unroll
    for (int a = 0; a < 2; ++a)
#pragma unroll
        for (int b = 0; b < 2; ++b)
#pragma unroll
            for (int m = 0; m < 4; ++m)
#pragma unroll
                for (int n = 0; n < 2; ++n) acc[a][b][m][n] = (f32x4){0.f, 0.f, 0.f, 0.f};
    bf16x8 At[4][2], B0[2][2], B1[2][2];
    const char* gA = (const char*)g.A; const char* cB = (const char*)g.Bt + (size_t)cur.pn * tstep;
    unsigned c0[2], c1[2], n0[2], n1[2];
    PG8_GOFF(0, c0, c1);
    S.a_ready(cur);
    PG8_STAGE(PG8_SB(0, 0), cB, voffB); PG8_STAGE(PG8_SB(0, 1), cB + hstep, voffB); PG8_STAGE(PG8_SA(0, 0), gA, c0); PG8_STAGE(PG8_SA(0, 1), gA, c1);
    if (wr == 1) PG8_BAR;
    PG8_WAIT_V(2); PG8_BAR;
    PG8_STAGE(PG8_SB(1, 0), cB + kstep, voffB); PG8_STAGE(PG8_SA(1, 0), gA + kstep, c0); PG8_STAGE(PG8_SB(1, 1), cB + hstep + kstep, voffB);
    PG8_WAIT_V(6); PG8_BAR;
    for (;;) {
        const bool has_next = S.next(ui + 1, nxt);
        const char* nB = has_next ? (const char*)g.Bt + (size_t)nxt.pn * tstep : cB;
        if (has_next) { PG8_GOFF(ui + 1, n0, n1); } else { n0[0] = c0[0]; n0[1] = c0[1]; n1[0] = c1[0]; n1[1] = c1[1]; }
        for (int t = 0; t < nt; t += 2) {
            const bool last = (t == nt - 2);
            const char* a1 = gA + (size_t)(t + 1) * kstep;
            const char* a2 = last ? gA : gA + (size_t)(t + 2) * kstep; const char* b2 = last ? nB : cB + (size_t)(t + 2) * kstep;
            const char* a3 = a2 + kstep; const char* b3 = b2 + kstep;
            unsigned s0[2], s1[2];
            s0[0] = last ? n0[0] : c0[0]; s0[1] = last ? n0[1] : c0[1]; s1[0] = last ? n1[0] : c1[0]; s1[1] = last ? n1[1] : c1[1];
            if (last && has_next) S.a_ready(nxt);
            PG8_LDB(B0, 0, 0); PG8_LDB(B1, 0, 1); PG8_SCHED; PG8_LDA(At, 0, 0); PG8_STAGE(PG8_SA(1, 1), a1, c1);
            PG8_WAIT_V(8); PG8_WAIT_L(0); PG8_BAR; PG8_MMA(0, 0, At, B0); PG8_MMA(0, 1, At, B1); PG8_BAR; PG8_SCHED;
            PG8_LDA(At, 0, 1); PG8_STAGE(PG8_SB(0, 0), b2, voffB); PG8_STAGE(PG8_SB(0, 1), b2 + hstep, voffB); PG8_STAGE(PG8_SA(0, 0), a2, s0);
            PG8_WAIT_V(8); PG8_WAIT_L(0); PG8_BAR; PG8_MMA(1, 0, At, B0); PG8_MMA(1, 1, At, B1); PG8_BAR; PG8_SCHED;
            PG8_LDB(B0, 1, 0); PG8_LDB(B1, 1, 1); PG8_SCHED; PG8_LDA(At, 1, 0); PG8_STAGE(PG8_SA(0, 1), a2, s1);
            PG8_WAIT_V(8); PG8_WAIT_L(0); PG8_BAR; PG8_MMA(0, 0, At, B0); PG8_MMA(0, 1, At, B1); PG8_BAR; PG8_SCHED;
            PG8_LDA(At, 1, 1); PG8_STAGE(PG8_SB(1, 0), b3, voffB); PG8_STAGE(PG8_SB(1, 1), b3 + hstep, voffB); PG8_STAGE(PG8_SA(1, 0), a3, s0);
            PG8_WAIT_V(8); PG8_WAIT_L(0); PG8_BAR; PG8_MMA(1, 0, At, B0); PG8_MMA(1, 1, At, B1); PG8_BAR; PG8_SCHED;
        }
        if constexpr (ALIGN_EPI) { if (wr == 0) PG8_BAR; }
        E(acc, cur, wr, wc, fr, fq); S.done(cur);
        if (!has_next) break;
#pragma unroll
        for (int a = 0; a < 2; ++a)
#pragma unroll
            for (int b = 0; b < 2; ++b)
#pragma unroll
                for (int m = 0; m < 4; ++m)
#pragma unroll
                    for (int n = 0; n < 2; ++n) acc[a][b][m][n] = (f32x4){0.f, 0.f, 0.f, 0.f};
        cur = nxt; cB = nB; ++ui; c0[0] = n0[0]; c0[1] = n0[1]; c1[0] = n1[0]; c1[1] = n1[1];
        if constexpr (ALIGN_EPI) { if (wr == 1) PG8_BAR; }
    }
    PG8_WAIT_V(0);
    if constexpr (!ALIGN_EPI) { if (wr == 0) PG8_BAR; }
    PG8_BAR;
#undef PG8_SA
#undef PG8_SB
#undef PG8_STAGE
#undef PG8_LDA
#undef PG8_LDB
#undef PG8_MMA
#undef PG8_WAIT_V
#undef PG8_WAIT_L
#undef PG8_BAR
#undef PG8_SCHED
#undef PG8_GOFF
}
}

template <bool NTS = false> __device__ __forceinline__ void transpose_item(const float* W, int ld, int c0, int k0, bf16* WT, int Kd, int r0, LAS float* scr, int lane) {
#pragma unroll 8
    for (int i = 0; i < 32; ++i) { const int kk = 2 * i + (lane >> 5); scr[kk * 33 + (lane & 31)] = __builtin_nontemporal_load(W + (size_t)(k0 + kk) * ld + c0 + (lane & 31)); }
    LDS_WAIT(); asm volatile("" ::: "memory");
    const int c = lane & 7;
#pragma unroll
    for (int j = 0; j < 4; ++j) { const int n = (lane >> 3) + 8 * j; const LAS float* s = scr + (8 * c) * 33 + n;
        v4u o; o.x = cvtpk(s[0 * 33], s[1 * 33]); o.y = cvtpk(s[2 * 33], s[3 * 33]); o.z = cvtpk(s[4 * 33], s[5 * 33]); o.w = cvtpk(s[6 * 33], s[7 * 33]);
        if (NTS) __builtin_nontemporal_store(o, (GAS v4u*)(WT + (size_t)(r0 + n) * Kd + k0 + 8 * c)); else *(GAS v4u*)(WT + (size_t)(r0 + n) * Kd + k0 + 8 * c) = o; }
    LDS_WAIT(); asm volatile("" ::: "memory");
}
__device__ __forceinline__ int win_src_col(int n32) { const int n = n32 * 32; return n < 2048 ? n : (n < 3584 ? n + 32 : (n < 3616 ? n - 1536 : -1)); }

__device__ __forceinline__ void p0_prologue(const Args& a, LAS unsigned char* lds, int tid, int G, int bid) {
    const int lane = tid & 63, wave = tid >> 6;
    {
        LAS float* scr = (LAS float*)(lds + 32768 + wave * 8704);
        const int gw = bid * NWAVES + wave, NGW = G * NWAVES;
        constexpr int I_IN = (D / 64) * (NIN / 32), I_OUT = (D / 64) * (D / 32);
        for (int it = gw; it < I_IN + I_OUT; it += NGW) {
            if (it < I_IN) { const int kb = it / (NIN / 32), nb = it % (NIN / 32); const int sc = win_src_col(nb);
                if (sc >= 0) transpose_item(a.in[6], INW, sc, kb * 64, a.WinT, D, nb * 32, scr, lane);
                else { for (int j = 0; j < 4; ++j) { const int n = (lane >> 3) + 8 * j; *(GAS v4u*)(a.WinT + (size_t)(nb * 32 + n) * D + kb * 64 + 8 * (lane & 7)) = (v4u){0u, 0u, 0u, 0u}; } }
            } else { const int r = it - I_IN; const int kb = r / (D / 32), nb = r % (D / 32);
                transpose_item(a.in[12], D, nb * 32, kb * 64, a.WoutT, D, nb * 32, scr, lane); }
        }
    }
    for (int i = bid * NTHR + tid; i < 48 * D; i += G * NTHR) { const int o = i / D, k = i % D;
        const float w = o < 4 ? a.in[15][k * 4 + o] : (o < 36 ? a.in[17][k * 32 + (o - 4)] : 0.f);
        const unsigned hi = f2bf(w); const float lo = w - __builtin_bit_cast(float, hi << 16);
        a.WrT[i] = (bf16)hi; a.WrT[48 * D + i] = (bf16)f2bf(lo); }
    if (bid < 6 * D / 32) {
        LAS float* cs = (LAS float*)lds;
        __syncthreads();
        for (int i = tid; i < NB * D; i += NTHR) cs[i] = silu_f(a.in[1][i]);
        __syncthreads();
        const int col = bid * 32 + (tid & 31), ks = tid >> 5;
        float acc[NB];
#pragma unroll
        for (int b = 0; b < NB; ++b) acc[b] = 0.f;
        const float* wp = a.in[2] + (size_t)(ks * 64) * (6 * D) + col;
        float wv[64];
#pragma unroll
        for (int k = 0; k < 64; ++k) wv[k] = wp[(size_t)k * (6 * D)];
#pragma unroll
        for (int k = 0; k < 64; ++k) {
#pragma unroll
            for (int b = 0; b < NB; ++b) acc[b] += cs[b * D + ks * 64 + k] * wv[k]; }
        LAS float* red = (LAS float*)(lds + 32768);
        __syncthreads();
#pragma unroll
        for (int b = 0; b < NB; ++b) red[(ks * NB + b) * 32 + (tid & 31)] = acc[b];
        __syncthreads();
        if (tid < 256) { const int b = tid >> 5, c = tid & 31; float s = 0.f;
#pragma unroll
            for (int k = 0; k < 16; ++k) s += red[(k * NB + b) * 32 + c];
            a.ada[b * 6 * D + bid * 32 + c] = s + a.in[3][bid * 32 + c]; }
        __syncthreads();
    }
}

__device__ __forceinline__ void p1_rows(const Args& a, int tid, int G, int bid) {
    const int lane = tid & 63, wave = tid >> 6;
    const int gw = bid * NWAVES + wave, NGW = G * NWAVES;
    const float* g = a.in[4];
    f32x4 nx[4];
    if (gw < T) {
#pragma unroll
        for (int j = 0; j < 4; ++j) nx[j] = __builtin_nontemporal_load((const GAS f32x4*)(a.in[0] + (size_t)gw * D) + lane + 64 * j); }
    for (int t = gw; t < T; t += NGW) {
        const int b = t / S;
        f32x4 v[4]; float ss = 0.f;
#pragma unroll
        for (int j = 0; j < 4; ++j) v[j] = nx[j];
        if (t + NGW < T) {
#pragma unroll
            for (int j = 0; j < 4; ++j) nx[j] = __builtin_nontemporal_load((const GAS f32x4*)(a.in[0] + (size_t)(t + NGW) * D) + lane + 64 * j); }
#pragma unroll
        for (int j = 0; j < 4; ++j) ss += (v[j].x * v[j].x + v[j].y * v[j].y) + (v[j].z * v[j].z + v[j].w * v[j].w);
        const float rstd = rsqrtf(wave_sum(ss) * (1.f / D) + EPS);
        GAS v2u* o8 = (GAS v2u*)(a.H + (size_t)t * D) + lane;
        const float* sh = a.ada + b * 6 * D, *sc = sh + D;
#pragma unroll
        for (int j = 0; j < 4; ++j) { const int k = 4 * lane + 256 * j;
            const f32x4 gg = *(const f32x4*)(g + k), s1 = *(const f32x4*)(sc + k), h1 = *(const f32x4*)(sh + k);
            const float o0 = v[j].x * rstd * gg.x * (1.f + s1.x) + h1.x, o1 = v[j].y * rstd * gg.y * (1.f + s1.y) + h1.y;
            const float o2 = v[j].z * rstd * gg.z * (1.f + s1.z) + h1.z, o3 = v[j].w * rstd * gg.w * (1.f + s1.w) + h1.w;
            o8[64 * j] = (v2u){cvtpk(o0, o1), cvtpk(o2, o3)}; }
    }
}

struct EpiG1 {
    static constexpr bool PERM = true, AFTER_DRAIN = false;
    bf16* qkv; bf16* z; bf16* naq; bf16* nak; bf16* navt; float* gates;
    __device__ __forceinline__ void operator()(const pg8::f32x4 (&acc)[2][2][4][2], const pg8::Unit& u, int wr, int wc, int fr, int fq) const {
        const int row0 = u.pm * 256 + wr * 64 + fr, pn = u.pn;
        if (pn < 10) {
            bf16* base; int ldc, colt;
            if (pn < 6) { base = qkv; ldc = 1536; colt = pn * 256; }
            else if (pn < 8) { base = z; ldc = 512; colt = (pn - 6) * 256; }
            else { base = naq; ldc = 512; colt = (pn - 8) * 256; }
            const int col0 = colt + wc * 32 + 8 * fq;
#pragma unroll
            for (int ai = 0; ai < 2; ++ai)
#pragma unroll
                for (int m = 0; m < 4; ++m) { bf16* rowp = base + (size_t)(row0 + ai * 128 + m * 16) * ldc + col0;
#pragma unroll
                    for (int bj = 0; bj < 2; ++bj) { const pg8::f32x4 v0 = acc[ai][bj][m][0], v1 = acc[ai][bj][m][1];
                        v4u w; w.x = pg8::cvt_pk_bf16(v0[0], v0[1]); w.y = pg8::cvt_pk_bf16(v0[2], v0[3]); w.z = pg8::cvt_pk_bf16(v1[0], v1[1]); w.w = pg8::cvt_pk_bf16(v1[2], v1[3]);
                        *(v4u*)(rowp + bj * 128) = w; } }
        } else if (pn < 12) {
#pragma unroll
            for (int ai = 0; ai < 2; ++ai)
#pragma unroll
                for (int m = 0; m < 4; ++m) { const int t = row0 + ai * 128 + m * 16, b = t >> 11, sidx = t & 2047, R = sidx >> 6, colk = sidx & 63;
#pragma unroll
                    for (int bj = 0; bj < 2; ++bj) { const int c = (pn - 10) * 256 + bj * 128 + wc * 32 + 8 * fq, hd = c >> 6, d0 = c & 63;
                        const size_t off = ((((((size_t)((b * 8 + hd) * 32 + R) * 8 + (colk >> 3)) * 2 + ((colk >> 2) & 1)) * 2 + (d0 >> 5)) * 4 + (colk & 3)) * 4 + ((d0 >> 3) & 3)) * 8;
                        const pg8::f32x4 v0 = acc[ai][bj][m][0], v1 = acc[ai][bj][m][1];
                        v4u w; w.x = pg8::cvt_pk_bf16(v0[0], v0[1]); w.y = pg8::cvt_pk_bf16(v0[2], v0[3]); w.z = pg8::cvt_pk_bf16(v1[0], v1[1]); w.w = pg8::cvt_pk_bf16(v1[2], v1[3]);
                        *(v4u*)(nak + off) = w; } }
        } else if (pn < 14) {
#pragma unroll
            for (int ai = 0; ai < 2; ++ai)
#pragma unroll
                for (int m = 0; m < 4; ++m) { const int t = row0 + ai * 128 + m * 16, b = t >> 11, sidx = t & 2047, R = sidx >> 6, colk = sidx & 63;
#pragma unroll
                    for (int bj = 0; bj < 2; ++bj)
#pragma unroll
                        for (int n = 0; n < 2; ++n)
#pragma unroll
                            for (int r = 0; r < 4; ++r) { const int c = (pn - 12) * 256 + bj * 128 + wc * 32 + 8 * fq + 4 * n + r, hd = c >> 6, d = c & 63;
                                navt[(((((size_t)((b * 8 + hd) * 32 + R) * 4 + (d >> 4)) * 8 + (colk >> 3)) * 16 + (d & 15)) * 8) + (colk & 7)] = (bf16)f2bf(acc[ai][bj][m][n][r]); } }
        } else {
            if (wc == 0) {
#pragma unroll
                for (int ai = 0; ai < 2; ++ai)
#pragma unroll
                    for (int m = 0; m < 4; ++m) { float* gp = gates + (size_t)(row0 + ai * 128 + m * 16) * 32 + 8 * fq;
                        *(pg8::f32x4*)gp = acc[ai][0][m][0]; *(pg8::f32x4*)(gp + 4) = acc[ai][0][m][1]; }
            }
        }
    }
};


__device__ __forceinline__ void p3_na(const Args& a, LAS unsigned char* lds, int tid, int G, int bid) {
    LAS float* tab = (LAS float*)(lds + 256);
    for (int i = tid; i < 8 * 465 + 128; i += NTHR) tab[i - 64] = (i >= 64 && i < 8 * 465 + 64) ? a.in[11][i - 64] : 0.f;
    __syncthreads();
    const int lane = tid & 63, wave = tid >> 6, q = lane & 15, g = lane >> 4;
    const int pi0 = 8 * (q >> 2) + (q & 3);
    const int xg = bid & 7, gs8 = (G >> 3) * NWAVES, slot = (bid >> 3) * NWAVES + wave;
    for (int it = slot; it < 8 * ROWS * 4; it += gs8) {
        const int pair = xg * 8 + (it >> 7), j = it & 3, r = (it >> 2) & 31, h = pair & 7, b = pair >> 3;
        int r0 = r - 4; r0 = r0 < 0 ? 0 : (r0 > ROWS - 8 ? ROWS - 8 : r0);
        const int start = j == 0 ? 0 : (j == 1 ? 8 : (j == 2 ? 24 : 32));
        const int c = 16 * j + q; int c0 = c - 8; c0 = c0 < 0 ? 0 : (c0 > GW - 16 ? GW - 16 : c0);
        const size_t tq = (size_t)b * S + r * GW + c;
        const bf16* qp = a.NAQ + tq * 512 + h * 64 + 8 * g;
        const bf16x8 qf0 = *(const bf16x8*)qp, qf1 = *(const bf16x8*)(qp + 32);
        f32x4 sc[8][2];
        {
            bf16x8 kf[8][4];
#pragma unroll
            for (int kr = 0; kr < 8; ++kr) {
                const bf16* kp = a.NAK + ((size_t)((b * 8 + h) * 32 + r0 + kr) * 512 + (size_t)((start >> 3) + (q >> 2)) * 64 + (q & 3) * 4 + g) * 8;
                kf[kr][0] = *(const bf16x8*)kp; kf[kr][1] = *(const bf16x8*)(kp + 128); kf[kr][2] = *(const bf16x8*)(kp + 256); kf[kr][3] = *(const bf16x8*)(kp + 384);
            }
            __builtin_amdgcn_sched_barrier(0);
#pragma unroll
            for (int kr = 0; kr < 8; ++kr) {
                f32x4 s0 = {0.f, 0.f, 0.f, 0.f}, s1 = {0.f, 0.f, 0.f, 0.f};
                s0 = __builtin_amdgcn_mfma_f32_16x16x32_bf16(kf[kr][0], qf0, s0, 0, 0, 0); s0 = __builtin_amdgcn_mfma_f32_16x16x32_bf16(kf[kr][1], qf1, s0, 0, 0, 0);
                s1 = __builtin_amdgcn_mfma_f32_16x16x32_bf16(kf[kr][2], qf0, s1, 0, 0, 0); s1 = __builtin_amdgcn_mfma_f32_16x16x32_bf16(kf[kr][3], qf1, s1, 0, 0, 0);
                sc[kr][0] = s0; sc[kr][1] = s1;
            }
        }
        bf16x8 vf[8][4];
        {
            const bf16* vbase = a.NAVT + ((size_t)((b * 8 + h) * 32 + r0) * 512 + (size_t)((start >> 3) + g) * 16 + q) * 8;
#pragma unroll
            for (int kr = 0; kr < 8; ++kr)
#pragma unroll
                for (int dt = 0; dt < 4; ++dt) vf[kr][dt] = *(const bf16x8*)(vbase + (size_t)kr * 4096 + dt * 1024);
        }
        __builtin_amdgcn_sched_barrier(0);
        float m = -1e30f;
#pragma unroll
        for (int kr = 0; kr < 8; ++kr) {
            const LAS float* bp = tab + (h * 15 + (r0 + kr - r + 7)) * 31 + (start + 8 * g - c + 15);
#pragma unroll
            for (int jj = 0; jj < 8; ++jj) { const int kc = start + 8 * g + jj; const bool ok = (kc >= c0) && (kc < c0 + 16);
                const float v = ok ? sc[kr][jj >> 2][jj & 3] * 0.125f + bp[jj] : -1e30f;
                sc[kr][jj >> 2][jj & 3] = v; m = fmaxf(m, v); }
        }
        m = fmaxf(m, __shfl_xor(m, 16)); m = fmaxf(m, __shfl_xor(m, 32));
        float l = 0.f;
        bf16x8 pf[8];
#pragma unroll
        for (int kr = 0; kr < 8; ++kr) {
            float p[8];
#pragma unroll
            for (int jj = 0; jj < 8; ++jj) { const float v = sc[kr][jj >> 2][jj & 3]; p[jj] = v > -1e29f ? __expf(v - m) : 0.f; l += p[jj]; }
            v4u w; w.x = cvtpk(p[0], p[1]); w.y = cvtpk(p[2], p[3]); w.z = cvtpk(p[4], p[5]); w.w = cvtpk(p[6], p[7]);
            pf[kr] = __builtin_bit_cast(bf16x8, w);
        }
        l += __shfl_xor(l, 16); l += __shfl_xor(l, 32);
        f32x4 o[4];
#pragma unroll
        for (int dt = 0; dt < 4; ++dt) o[dt] = (f32x4){0.f, 0.f, 0.f, 0.f};
#pragma unroll
        for (int kr = 0; kr < 8; ++kr) {
#pragma unroll
            for (int dt = 0; dt < 4; ++dt) o[dt] = __builtin_amdgcn_mfma_f32_16x16x32_bf16(vf[kr][dt], pf[kr], o[dt], 0, 0, 0);
        }
        const float inv = __builtin_amdgcn_rcpf(l);
        bf16* op = a.MIX + tq * D + 512 + h * 64 + 4 * g;
#pragma unroll
        for (int dt = 0; dt < 4; ++dt) *(v2u*)(op + 16 * dt) = (v2u){cvtpk(o[dt][0] * inv, o[dt][1] * inv), cvtpk(o[dt][2] * inv, o[dt][3] * inv)};
    }
}

__device__ __forceinline__ int crow(int reg, int hh) { return (reg & 3) + 8 * (reg >> 2) + 4 * hh; }
#define MFMA32(a, b, c) __builtin_amdgcn_mfma_f32_32x32x16_bf16((a), (b), (c), 0, 0, 0)
__device__ __forceinline__ bf16x8 pack8(const f32x16& x, int s) {
    v4u p; p.x = cvtpk(x[8 * s], x[8 * s + 1]); p.y = cvtpk(x[8 * s + 2], x[8 * s + 3]); p.z = cvtpk(x[8 * s + 4], x[8 * s + 5]); p.w = cvtpk(x[8 * s + 6], x[8 * s + 7]);
    return __builtin_bit_cast(bf16x8, p);
}
constexpr int IMG = 72;
constexpr int PREP_REC = 32768;

__device__ __forceinline__ bf16x8 frag_nat(const LAS bf16* img, int row, int ks, int hh) { return *(const LAS bf16x8*)(img + row * IMG + 16 * ks + 8 * hh); }
__device__ __forceinline__ bf16x8 frag_kap(const LAS bf16* img, int row, int base, int s, int hh) {
    const v2u lo = *(const LAS v2u*)(img + row * IMG + base + 16 * s + 4 * hh), hi = *(const LAS v2u*)(img + row * IMG + base + 16 * s + 8 + 4 * hh);
    return __builtin_bit_cast(bf16x8, (v4u){lo.x, lo.y, hi.x, hi.y});
}

typedef float f32x2v __attribute__((ext_vector_type(2)));
__device__ __forceinline__ void pkfnma(f32x2v& acc, f32x2v m, f32x2v xx) { asm("v_pk_fma_f32 %0, %1, %2, %0 op_sel_hi:[0,1,1] neg_lo:[1,0,0] neg_hi:[1,0,0]" : "+v"(acc) : "v"(xx), "v"(m)); }
__device__ __forceinline__ float fnma(float acc, float m, float x) { asm("v_fma_f32 %0, -%1, %2, %0" : "+v"(acc) : "v"(m), "v"(x)); return acc; }
__device__ __forceinline__ void dn_store32(const f32x2v (&acc)[32], int half, LAS bf16* out_img, int lane) {
#pragma unroll
    for (int i8 = 0; i8 < 4; ++i8) { const int k = 16 * half + 4 * i8;
        v4u w; w.x = cvtpk(acc[k].x, acc[k].y); w.y = cvtpk(acc[k + 1].x, acc[k + 1].y); w.z = cvtpk(acc[k + 2].x, acc[k + 2].y); w.w = cvtpk(acc[k + 3].x, acc[k + 3].y);
        *(LAS v4u*)(out_img + lane * IMG + 32 * half + 8 * i8) = w; }
}
constexpr int SCAN_BUF = 24576, SCAN_OFF = 71680;
__device__ __forceinline__ void scan_dma(const unsigned char* rec, LAS unsigned char* buf, int DV, int lane) {
    const unsigned char* src = rec + lane * 16;
#pragma unroll
    for (int p = 0; p < 8; ++p) __builtin_amdgcn_global_load_lds((const unsigned*)(src + 8192 + p * 1024), (LAS unsigned*)(buf + p * 1024), 16, 0, 0);
#pragma unroll
    for (int p = 0; p < 8; ++p) __builtin_amdgcn_global_load_lds((const unsigned*)(src + p * 1024), (LAS unsigned*)(buf + 8192 + p * 1024), 16, 0, 0);
#pragma unroll
    for (int blk = 0; blk < 2; ++blk)
#pragma unroll
        for (int hf = 0; hf < 2; ++hf) {
            __builtin_amdgcn_global_load_lds((const unsigned*)(src + 16384 + (blk * 2 + DV) * 2048 + hf * 1024), (LAS unsigned*)(buf + 16384 + blk * 2048 + hf * 1024), 16, 0, 0);
            __builtin_amdgcn_global_load_lds((const unsigned*)(src + 24576 + (blk * 2 + DV) * 2048 + hf * 1024), (LAS unsigned*)(buf + 20480 + blk * 2048 + hf * 1024), 16, 0, 0);
        }
}
__device__ __forceinline__ void unpack16(f32x16& d, const LAS unsigned char* p) {
    const v4u c0 = *(const LAS v4u*)p, c1 = *(const LAS v4u*)(p + 16);
    d[0] = bflo(c0.x); d[1] = bfhi(c0.x); d[2] = bflo(c0.y); d[3] = bfhi(c0.y); d[4] = bflo(c0.z); d[5] = bfhi(c0.z); d[6] = bflo(c0.w); d[7] = bfhi(c0.w);
    d[8] = bflo(c1.x); d[9] = bfhi(c1.x); d[10] = bflo(c1.y); d[11] = bfhi(c1.y); d[12] = bflo(c1.z); d[13] = bfhi(c1.z); d[14] = bflo(c1.w); d[15] = bfhi(c1.w);
}
__device__ __forceinline__ void p4_scan_wave(const Args& a, LAS unsigned char* lds, int id, int lane) {
    const int DV = id & 1, dir = (id >> 1) & 1, h = (id >> 2) & 7, b = id >> 5;
    const int col = lane & 31, hh = lane >> 5;
    f32x16 S0, S1;
#pragma unroll
    for (int r = 0; r < 16; ++r) { S0[r] = 0.f; S1[r] = 0.f; }
    const unsigned char* chain = (const unsigned char*)a.PREP + (size_t)((b * 8 + h) * 2 + dir) * 32 * PREP_REC;
    LAS unsigned char* ring = lds + SCAN_OFF;
    scan_dma(chain + (size_t)(dir ? 31 : 0) * PREP_REC, ring, DV, lane);
    scan_dma(chain + (size_t)(dir ? 30 : 1) * PREP_REC, ring + SCAN_BUF, DV, lane);
    for (int st = 0; st < 32; ++st) {
        const int chunk = dir ? 31 - st : st;
        asm volatile("s_waitcnt lgkmcnt(0)" ::: "memory");
        { const int s2 = st + 2 < 32 ? st + 2 : 31; scan_dma(chain + (size_t)(dir ? 31 - s2 : s2) * PREP_REC, ring + ((st + 2) % 3) * SCAN_BUF, DV, lane); }
        asm volatile("s_waitcnt vmcnt(48)" ::: "memory");
        __builtin_amdgcn_sched_barrier(0);
        const LAS unsigned char* buf = ring + (st % 3) * SCAN_BUF;
        bf16x8 Sb[2][2];
        Sb[0][0] = pack8(S0, 0); Sb[0][1] = pack8(S0, 1); Sb[1][0] = pack8(S1, 0); Sb[1][1] = pack8(S1, 1);
        f32x16 o[2], n[2];
#pragma unroll
        for (int I = 0; I < 2; ++I) {
            unpack16(o[I], buf + 20480 + I * 2048 + lane * 32);
#pragma unroll
            for (int DK = 0; DK < 2; ++DK)
#pragma unroll
                for (int s = 0; s < 2; ++s) o[I] = MFMA32(*(const LAS bf16x8*)(buf + 8192 + ((I * 2 + DK) * 2 + s) * 1024 + lane * 16), Sb[DK][s], o[I]);
        }
#pragma unroll
        for (int DKp = 0; DKp < 2; ++DKp) {
            unpack16(n[DKp], buf + 16384 + DKp * 2048 + lane * 32);
#pragma unroll
            for (int DK = 0; DK < 2; ++DK)
#pragma unroll
                for (int s = 0; s < 2; ++s) n[DKp] = MFMA32(*(const LAS bf16x8*)(buf + ((DKp * 2 + DK) * 2 + s) * 1024 + lane * 16), Sb[DK][s], n[DKp]);
        }
        S0 = n[0]; S1 = n[1];
        bf16* ofb = (bf16*)a.Y + ((size_t)dir * T + (size_t)b * S + 64 * chunk) * 512 + h * 64 + 32 * DV + col;
#pragma unroll
        for (int I = 0; I < 2; ++I)
#pragma unroll
            for (int r = 0; r < 16; ++r) { const int nn = 32 * I + crow(r, hh); const int p = dir ? 63 - nn : nn; ofb[(size_t)p * 512] = (bf16)f2bf(o[I][r]); }
    }
    asm volatile("s_waitcnt vmcnt(0)" ::: "memory");
}

__device__ __forceinline__ void p4b_dnout(const Args& a, int tid, int G, int bid) {
    const bf16* ofb = (const bf16*)a.Y;
    const int d0 = 8 * (tid & 7);
    const f32x4 g0 = *(const f32x4*)(a.in[10] + d0), g1 = *(const f32x4*)(a.in[10] + d0 + 4);
    for (size_t u = (size_t)bid * NTHR + tid; u < (size_t)T * 64; u += (size_t)G * NTHR) {
        const size_t th = u >> 3;
        const v4u pf = __builtin_nontemporal_load((const v4u*)(ofb + th * 64 + d0)), pb = __builtin_nontemporal_load((const v4u*)(ofb + ((size_t)T * 8 + th) * 64 + d0)), zz = __builtin_nontemporal_load((const v4u*)(a.Z + th * 64 + d0));
        float x[8];
        x[0] = bflo(pf.x) + bflo(pb.x); x[1] = bfhi(pf.x) + bfhi(pb.x); x[2] = bflo(pf.y) + bflo(pb.y); x[3] = bfhi(pf.y) + bfhi(pb.y);
        x[4] = bflo(pf.z) + bflo(pb.z); x[5] = bfhi(pf.z) + bfhi(pb.z); x[6] = bflo(pf.w) + bflo(pb.w); x[7] = bfhi(pf.w) + bfhi(pb.w);
        float ss = 0.f;
#pragma unroll
        for (int e = 0; e < 8; ++e) ss += x[e] * x[e];
        ss += __shfl_xor(ss, 1); ss += __shfl_xor(ss, 2); ss += __shfl_xor(ss, 4);
        const float rs = rsqrtf(ss * (1.f / 64.f) + EPS);
        const float z[8] = {bflo(zz.x), bfhi(zz.x), bflo(zz.y), bfhi(zz.y), bflo(zz.z), bfhi(zz.z), bflo(zz.w), bfhi(zz.w)};
        const float gg[8] = {g0.x, g0.y, g0.z, g0.w, g1.x, g1.y, g1.z, g1.w};
        float o[8];
#pragma unroll
        for (int e = 0; e < 8; ++e) o[e] = x[e] * rs * gg[e] * silu_f(z[e]);
        const size_t t = th >> 3; const int h = (int)(th & 7);
        *(v4u*)(a.MIX + t * D + h * 64 + d0) = (v4u){cvtpk(o[0], o[1]), cvtpk(o[2], o[3]), cvtpk(o[4], o[5]), cvtpk(o[6], o[7])};
    }
}

namespace pp {
constexpr int I_K = 0, I_Q = 9216, I_V = 18432, I_KT = 27648  , INP = 46080;
constexpr int W_BASE = 2 * INP, W_UT = 0, W_WT = 9216, W_MT = 18432, W_ML = 26624, W_DIR = 29184;
constexpr int G_BASE = W_BASE + 2 * W_DIR, G_SZ = 2048;
constexpr int WCV_OFF = G_BASE + 4 * G_SZ;
static_assert(WCV_OFF + 3840 <= LDS_BYTES - 16, "prep LDS map");
constexpr int MLP = 40;

template <int B0, int JJ> __device__ __forceinline__ void tri_step(f32x2v (&acc)[32], f32x4 (&mc)[8], const LAS float* MTb) {
    constexpr int j = B0 + JJ;
    f32x4 mn[8];
    if (JJ + 1 < 31) {
#pragma unroll
        for (int i4 = (JJ + 2) / 4; i4 < 8; ++i4) mn[i4] = *(const LAS f32x4*)(MTb + (JJ + 1) * 32 + 4 * i4);
    }
    __builtin_amdgcn_sched_barrier(0);
    const float xj = (j & 1) ? acc[j >> 1].y : acc[j >> 1].x;
    const f32x2v xx = {xj, xj};
#pragma unroll
    for (int i4 = (JJ + 1) / 4; i4 < 8; ++i4) {
        const f32x4 m = mc[i4]; const int ia = B0 + 4 * i4;
        if (ia > j) pkfnma(acc[ia >> 1], (f32x2v){m.x, m.y}, xx);
        else if (ia + 1 > j) acc[ia >> 1].y = fnma(acc[ia >> 1].y, m.y, xj);
        if (ia + 2 > j) pkfnma(acc[(ia >> 1) + 1], (f32x2v){m.z, m.w}, xx);
        else if (ia + 3 > j) acc[(ia >> 1) + 1].y = fnma(acc[(ia >> 1) + 1].y, m.w, xj);
    }
    __builtin_amdgcn_sched_barrier(0);
    if (JJ + 1 < 31) {
#pragma unroll
        for (int i4 = (JJ + 2) / 4; i4 < 8; ++i4) mc[i4] = mn[i4];
    }
}
template <int B0, int... JJ> __device__ __forceinline__ void tri_steps(f32x2v (&acc)[32], f32x4 (&mc)[8], const LAS float* MTb, std::integer_sequence<int, JJ...>) { (tri_step<B0, JJ>(acc, mc, MTb), ...); }
template <int B0> __device__ __forceinline__ void tri32(f32x2v (&acc)[32], const LAS float* MT) {
    const LAS float* MTb = MT + (B0 / 32) * 1024;
    f32x4 mc[8];
#pragma unroll
    for (int i4 = 0; i4 < 8; ++i4) mc[i4] = *(const LAS f32x4*)(MTb + 4 * i4);
    tri_steps<B0>(acc, mc, MTb, std::make_integer_sequence<int, 31>{});
}
__device__ __forceinline__ void solve(const LAS float* MT, const LAS bf16* ML, const LAS bf16* rhs_img, int rev, const LAS float* rscale, LAS bf16* out_img, int lane) {
    f32x2v acc[32];
    const LAS bf16* rp = rhs_img + (rev ? 63 * IMG : 0) + lane; const int rstep = rev ? -IMG : IMG;
#pragma unroll
    for (int k = 0; k < 16; ++k) { acc[k].x = rscale[2 * k] * bf2f(rp[(2 * k) * rstep]); acc[k].y = rscale[2 * k + 1] * bf2f(rp[(2 * k + 1) * rstep]); }
    tri32<0>(acc, MT);
    dn_store32(acc, 0, out_img, lane);
    __builtin_amdgcn_sched_barrier(0);
#pragma unroll
    for (int k = 16; k < 32; ++k) { acc[k].x = rscale[2 * k] * bf2f(rp[(2 * k) * rstep]); acc[k].y = rscale[2 * k + 1] * bf2f(rp[(2 * k + 1) * rstep]); }
    asm volatile("s_waitcnt lgkmcnt(0)" ::: "memory");
    {
        const int col = lane & 31, hh = lane >> 5;
        f32x16 d0, d1;
#pragma unroll
        for (int r = 0; r < 16; ++r) { d0[r] = 0.f; d1[r] = 0.f; }
#pragma unroll
        for (int ks = 0; ks < 2; ++ks) { const bf16x8 af = *(const LAS bf16x8*)(ML + col * MLP + 16 * ks + 8 * hh);
            d0 = MFMA32(af, frag_nat(out_img, col, ks, hh), d0); d1 = MFMA32(af, frag_nat(out_img, 32 + col, ks, hh), d1); }
#pragma unroll
        for (int r = 0; r < 16; ++r) { const float t0 = __shfl_xor(d0[r], 32), t1 = __shfl_xor(d1[r], 32);
            const float n0 = hh ? t1 : d0[r], n1 = hh ? d1[r] : t0; d0[r] = n0; d1[r] = n1; }
#pragma unroll
        for (int r = 0; r < 16; ++r) { const int i0r = 32 + crow(r, 0), i1r = 32 + crow(r, 1);
            if (i0r & 1) acc[i0r >> 1].y -= d0[r]; else acc[i0r >> 1].x -= d0[r];
            if (i1r & 1) acc[i1r >> 1].y -= d1[r]; else acc[i1r >> 1].x -= d1[r]; }
    }
    tri32<32>(acc, MT);
    dn_store32(acc, 1, out_img, lane);
}

__device__ __forceinline__ void gates(const Args& a, LAS float* GT, int item, int dir, int lane) {
    const int chunk = item & 31, h = (item >> 5) & 7, b = item >> 8;
    const int p = dir ? 63 - lane : lane;
    const float* gp = a.GATES + (size_t)(b * S + 64 * chunk + p) * 32;
    const float av = gp[dir * 8 + h], bv = gp[16 + dir * 8 + h];
    const float g = -__expf(a.in[8][dir * 8 + h]) * softplus_f(av + a.in[9][dir * 8 + h]);
    const float beta = sigmoid_f(bv);
    float v = g;
#pragma unroll
    for (int o = 1; o < 64; o <<= 1) { const float u = __shfl_up(v, o); if (lane >= o) v += u; }
    const float gl = __shfl(v, 63);
    const float e = __expf(v);
    GT[lane] = beta; GT[64 + lane] = v; GT[128 + lane] = e; GT[192 + lane] = __expf(gl - v); GT[256 + lane] = beta * e;
    if (lane == 0) GT[320] = __expf(gl);
}
__device__ __forceinline__ void conv(const Args& a, LAS unsigned char* inp, const LAS float* WCV, int item, int t) {
    const int chunk = item & 31, h = (item >> 5) & 7, b = item >> 8;
    const int p = t >> 2, d0 = 16 * (t & 3), s = 64 * chunk + p;
#pragma unroll
    for (int mat = 0; mat < 3; ++mat) {
        float acc[16];
#pragma unroll
        for (int e = 0; e < 16; ++e) acc[e] = 0.f;
#pragma unroll
        for (int tap = 0; tap < 5; ++tap) {
            const int ss = s + tap - 2;
            if (ss >= 0 && ss < S) {
                const bf16* src = a.QKV + (size_t)(b * S + ss) * 1536 + mat * 512 + h * 64 + d0;
                const v4u r0 = *(const v4u*)src, r1 = *(const v4u*)(src + 8);
                const LAS float* wp = WCV + tap * 192 + mat * 64 + d0;
                const f32x4 w0 = *(const LAS f32x4*)wp, w1 = *(const LAS f32x4*)(wp + 4), w2 = *(const LAS f32x4*)(wp + 8), w3 = *(const LAS f32x4*)(wp + 12);
                acc[0] += w0.x * bflo(r0.x); acc[1] += w0.y * bfhi(r0.x); acc[2] += w0.z * bflo(r0.y); acc[3] += w0.w * bfhi(r0.y);
                acc[4] += w1.x * bflo(r0.z); acc[5] += w1.y * bfhi(r0.z); acc[6] += w1.z * bflo(r0.w); acc[7] += w1.w * bfhi(r0.w);
                acc[8] += w2.x * bflo(r1.x); acc[9] += w2.y * bfhi(r1.x); acc[10] += w2.z * bflo(r1.y); acc[11] += w2.w * bfhi(r1.y);
                acc[12] += w3.x * bflo(r1.z); acc[13] += w3.y * bfhi(r1.z); acc[14] += w3.z * bflo(r1.w); acc[15] += w3.w * bfhi(r1.w);
            }
        }
        float ss2 = 0.f;
#pragma unroll
        for (int e = 0; e < 16; ++e) { acc[e] = silu_f(acc[e]); ss2 += acc[e] * acc[e]; }
        if (mat < 2) {
            ss2 += __shfl_xor(ss2, 1); ss2 += __shfl_xor(ss2, 2);
            const float sc = rsqrtf(ss2 + EPS);
#pragma unroll
            for (int e = 0; e < 16; ++e) acc[e] *= sc;
        }
        LAS bf16* img = (LAS bf16*)(inp + (mat == 0 ? I_Q : (mat == 1 ? I_K : I_V))) + p * IMG + d0;
        *(LAS v4u*)img = (v4u){cvtpk(acc[0], acc[1]), cvtpk(acc[2], acc[3]), cvtpk(acc[4], acc[5]), cvtpk(acc[6], acc[7])};
        *(LAS v4u*)(img + 8) = (v4u){cvtpk(acc[8], acc[9]), cvtpk(acc[10], acc[11]), cvtpk(acc[12], acc[13]), cvtpk(acc[14], acc[15])};
    }
}
__device__ __forceinline__ void mkt(LAS unsigned char* lds, LAS unsigned char* inp, int set, int tid) {
    const int lane = tid & 63, wave = tid >> 6, dir = wave & 1, w4 = wave >> 1, col = lane & 31, hh = lane >> 5;
    const LAS bf16* KB = (const LAS bf16*)(inp + I_K);
    const LAS float* GT = (const LAS float*)(lds + G_BASE + (set * 2 + dir) * G_SZ);
    LAS unsigned char* wk = lds + W_BASE + dir * W_DIR;
    if (w4 < 3) {
        const int bi = w4 == 0 ? 0 : 1, bj = w4 == 2 ? 1 : 0;
        const int ra = 32 * bi + col, rb = 32 * bj + col;
        f32x16 acc;
#pragma unroll
        for (int r = 0; r < 16; ++r) acc[r] = 0.f;
#pragma unroll
        for (int ks = 0; ks < 4; ++ks) acc = MFMA32(frag_nat(KB, dir ? 63 - ra : ra, ks, hh), frag_nat(KB, dir ? 63 - rb : rb, ks, hh), acc);
        const int j = 32 * bj + col; const float gcj = GT[64 + j];
        if (w4 == 1) {
            LAS bf16* ML = (LAS bf16*)(wk + W_ML);
#pragma unroll
            for (int r = 0; r < 16; ++r) { const int ip = crow(r, hh), i = 32 + ip; ML[ip * MLP + j] = (bf16)f2bf(GT[i] * acc[r] * __expf(GT[64 + i] - gcj)); }
        } else {
            LAS float* MTb = (LAS float*)(wk + W_MT) + bi * 1024;
#pragma unroll
            for (int r4 = 0; r4 < 4; ++r4) { const int ip0 = 8 * r4 + 4 * hh; f32x4 mv;
#pragma unroll
                for (int k = 0; k < 4; ++k) { const int i = 32 * bi + ip0 + k; mv[k] = (i > j) ? GT[i] * acc[4 * r4 + k] * __expf(GT[64 + i] - gcj) : 0.f; }
                *(LAS f32x4*)(MTb + col * 32 + ip0) = mv; }
        }
    }
    {
        const int p = tid >> 3, d0 = 8 * (tid & 7);
        const v4u kv = *(const LAS v4u*)(KB + p * IMG + d0);
        const float e0 = ((const LAS float*)(lds + G_BASE + (set * 2 + 0) * G_SZ))[192 + p], e1 = ((const LAS float*)(lds + G_BASE + (set * 2 + 1) * G_SZ))[192 + 63 - p];
        LAS bf16* kt0 = (LAS bf16*)(inp + I_KT); LAS bf16* kt1 = (LAS bf16*)(inp + I_KT + 9216);
        const float kf[8] = {bflo(kv.x), bfhi(kv.x), bflo(kv.y), bfhi(kv.y), bflo(kv.z), bfhi(kv.z), bflo(kv.w), bfhi(kv.w)};
#pragma unroll
        for (int e = 0; e < 8; ++e) { kt0[(d0 + e) * IMG + p] = (bf16)f2bf(kf[e] * e0); kt1[(d0 + e) * IMG + 63 - p] = (bf16)f2bf(kf[e] * e1); }
    }
}
__device__ __forceinline__ void stage5(const Args& a, LAS unsigned char* lds, LAS unsigned char* inp, int set, int item, int tid) {
    const int lane = tid & 63, wave = tid >> 6, dir = wave & 1, w4 = wave >> 1, hh = lane >> 5;
    int col5 = lane & 31; asm volatile("" : "+v"(col5));
    const int col = col5;
    const int chunk = item & 31, h = (item >> 5) & 7, b = item >> 8;
    const LAS bf16* KB = (const LAS bf16*)(inp + I_K); const LAS bf16* QB = (const LAS bf16*)(inp + I_Q); const LAS bf16* KT = (const LAS bf16*)(inp + I_KT + dir * 9216);
    LAS unsigned char* wk = lds + W_BASE + dir * W_DIR;
    const LAS bf16* UT = (const LAS bf16*)(wk + W_UT); const LAS bf16* WT = (const LAS bf16*)(wk + W_WT);
    const LAS float* GT = (const LAS float*)(lds + G_BASE + (set * 2 + dir) * G_SZ);
    const int I = w4 >> 1, c = w4 & 1;
    unsigned char* rec = (unsigned char*)a.PREP + ((size_t)((b * 8 + h) * 2 + dir) * 32 + chunk) * PREP_REC;
    bf16x8 Xf[2][2];
    const int i_tok = 32 * I + col, i_row = dir ? 63 - i_tok : i_tok; const float gci = GT[64 + i_tok];
#pragma unroll
    for (int J = 0; J < 2; ++J) {
        if (J <= I) {
            const int jr = 32 * J + col;
            f32x16 acc;
#pragma unroll
            for (int r = 0; r < 16; ++r) acc[r] = 0.f;
#pragma unroll
            for (int ks = 0; ks < 4; ++ks) acc = MFMA32(frag_nat(KB, dir ? 63 - jr : jr, ks, hh), frag_nat(QB, i_row, ks, hh), acc);
#pragma unroll
            for (int r = 0; r < 16; ++r) { const int j = 32 * J + crow(r, hh); acc[r] = (j <= i_tok) ? acc[r] * 0.125f * __expf(gci - GT[64 + j]) : 0.f; }
            Xf[J][0] = pack8(acc, 0); Xf[J][1] = pack8(acc, 1);
        }
    }
    {
        f32x16 acc;
#pragma unroll
        for (int r = 0; r < 16; ++r) acc[r] = 0.f;
#pragma unroll
        for (int J = 0; J < 2; ++J) if (J <= I) {
#pragma unroll
            for (int s = 0; s < 2; ++s) acc = MFMA32(Xf[J][s], frag_kap(UT, 32 * c + col, 32 * J, s, hh), acc); }
        v4u* dst = (v4u*)(rec + 24576 + (I * 2 + c) * 2048 + lane * 32);
        dst[0] = (v4u){cvtpk(acc[0], acc[1]), cvtpk(acc[2], acc[3]), cvtpk(acc[4], acc[5]), cvtpk(acc[6], acc[7])};
        dst[1] = (v4u){cvtpk(acc[8], acc[9]), cvtpk(acc[10], acc[11]), cvtpk(acc[12], acc[13]), cvtpk(acc[14], acc[15])};
    }
    {
        f32x16 acc;
#pragma unroll
        for (int r = 0; r < 16; ++r) acc[r] = 0.f;
#pragma unroll
        for (int J = 0; J < 2; ++J) if (J <= I) {
#pragma unroll
            for (int s = 0; s < 2; ++s) acc = MFMA32(frag_kap(WT, 32 * c + col, 32 * J, s, hh), Xf[J][s], acc); }
        const float ei = GT[128 + i_tok] * 0.125f;
#pragma unroll
        for (int r4 = 0; r4 < 4; ++r4) { const v2u qv = *(const LAS v2u*)(QB + i_row * IMG + 32 * c + 8 * r4 + 4 * hh);
            acc[4 * r4 + 0] = ei * bflo(qv.x) - acc[4 * r4 + 0]; acc[4 * r4 + 1] = ei * bfhi(qv.x) - acc[4 * r4 + 1];
            acc[4 * r4 + 2] = ei * bflo(qv.y) - acc[4 * r4 + 2]; acc[4 * r4 + 3] = ei * bfhi(qv.y) - acc[4 * r4 + 3]; }
        *(bf16x8*)(rec + ((I * 2 + c) * 2 + 0) * 1024 + lane * 16) = pack8(acc, 0);
        *(bf16x8*)(rec + ((I * 2 + c) * 2 + 1) * 1024 + lane * 16) = pack8(acc, 1);
    }
    {
        f32x16 acc;
#pragma unroll
        for (int r = 0; r < 16; ++r) acc[r] = 0.f;
#pragma unroll
        for (int ks = 0; ks < 4; ++ks) acc = MFMA32(frag_nat(WT, 32 * I + col, ks, hh), frag_nat(KT, 32 * c + col, ks, hh), acc);
        const float egl = GT[320];
#pragma unroll
        for (int r = 0; r < 16; ++r) acc[r] = ((32 * I + crow(r, hh)) == (32 * c + col) ? egl : 0.f) - acc[r];
        *(bf16x8*)(rec + 8192 + ((c * 2 + I) * 2 + 0) * 1024 + lane * 16) = pack8(acc, 0);
        *(bf16x8*)(rec + 8192 + ((c * 2 + I) * 2 + 1) * 1024 + lane * 16) = pack8(acc, 1);
    }
    {
        f32x16 acc;
#pragma unroll
        for (int r = 0; r < 16; ++r) acc[r] = 0.f;
#pragma unroll
        for (int ks = 0; ks < 4; ++ks) acc = MFMA32(frag_nat(KT, 32 * I + col, ks, hh), frag_nat(UT, 32 * c + col, ks, hh), acc);
        v4u* dst = (v4u*)(rec + 16384 + (I * 2 + c) * 2048 + lane * 32);
        dst[0] = (v4u){cvtpk(acc[0], acc[1]), cvtpk(acc[2], acc[3]), cvtpk(acc[4], acc[5]), cvtpk(acc[6], acc[7])};
        dst[1] = (v4u){cvtpk(acc[8], acc[9]), cvtpk(acc[10], acc[11]), cvtpk(acc[12], acc[13]), cvtpk(acc[14], acc[15])};
    }
}
}

__device__ __forceinline__ void p3_dnprep2(const Args& a, LAS unsigned char* lds, int tid, int G, int bid) {
    using namespace pp;
    const int NIT = NB * NH * 32;
    LAS float* WCV = (LAS float*)(lds + WCV_OFF);
    const int wave = tid >> 6, lane = tid & 63;
    if (bid >= NIT) return;
    const int h0 = (bid >> 5) & 7;
    __syncthreads();
    for (int i = tid; i < 5 * 192; i += NTHR) { const int tp = i / 192, cc = i % 192; WCV[i] = a.in[7][tp * 1536 + (cc >> 6) * 512 + h0 * 64 + (cc & 63)]; }
    if (wave == 4 || wave == 5) gates(a, (LAS float*)(lds + G_BASE + (0 * 2 + (wave - 4)) * G_SZ), bid, wave - 4, lane);
    __syncthreads();
    if (wave >= 4) conv(a, lds + 0 * INP, WCV, bid, tid - 256);
    __syncthreads();
    mkt(lds, lds + 0 * INP, 0, tid);
    __syncthreads();
    int k = 0;
    for (int item = bid; item < NIT; item += G, ++k) {
        const int set = k & 1, nitem = item + G;
        LAS unsigned char* inp = lds + set * INP; LAS unsigned char* ninp = lds + (set ^ 1) * INP;
        if (wave < 4) {
            const int dir = wave & 1, w4 = wave >> 1;
            LAS unsigned char* wk = lds + W_BASE + dir * W_DIR;
            const LAS float* GT = (const LAS float*)(lds + G_BASE + (set * 2 + dir) * G_SZ);
            solve((const LAS float*)(wk + W_MT), (const LAS bf16*)(wk + W_ML), (const LAS bf16*)(inp + (w4 == 0 ? I_V : I_K)), dir, w4 == 0 ? GT : GT + 256, (LAS bf16*)(wk + (w4 == 0 ? W_UT : W_WT)), lane);
        } else if (nitem < NIT) {
            if (((nitem >> 5) & 7) != h0) { for (int i = tid - 256; i < 5 * 192; i += 256) { const int tp = i / 192, cc = i % 192; WCV[i] = a.in[7][tp * 1536 + (cc >> 6) * 512 + ((nitem >> 5) & 7) * 64 + (cc & 63)]; } }
            if (wave < 6) gates(a, (LAS float*)(lds + G_BASE + ((set ^ 1) * 2 + (wave - 4)) * G_SZ), nitem, wave - 4, lane);
            conv(a, ninp, WCV, nitem, tid - 256);
        }
        __syncthreads();
        stage5(a, lds, inp, set, item, tid);
        __syncthreads();
        if (nitem < NIT) mkt(lds, ninp, set ^ 1, tid);
        __syncthreads();
    }
}

struct EpiY {
    static constexpr bool PERM = true, AFTER_DRAIN = false;
    bf16* C; int ldc;
    __device__ __forceinline__ void operator()(const pg8::f32x4 (&acc)[2][2][4][2], const pg8::Unit& u, int wr, int wc, int fr, int fq) const {
        const int row0 = u.pm * 256 + wr * 64 + fr, col0 = u.pn * 256 + wc * 32 + 8 * fq;
#pragma unroll
        for (int ai = 0; ai < 2; ++ai)
#pragma unroll
            for (int m = 0; m < 4; ++m) { bf16* rowp = C + (size_t)(row0 + ai * 128 + m * 16) * ldc + col0;
#pragma unroll
                for (int bj = 0; bj < 2; ++bj) { const pg8::f32x4 v0 = acc[ai][bj][m][0], v1 = acc[ai][bj][m][1];
                    *(v4u*)(rowp + bj * 128) = (v4u){cvtpk(v0[0], v0[1]), cvtpk(v0[2], v0[3]), cvtpk(v1[0], v1[1]), cvtpk(v1[2], v1[3])}; } }
    }
};

constexpr int P7_HT = 0, P7_LGP = 131072, P7_LC = P7_LGP + 2 * 64 * 48 * 4;
__device__ __forceinline__ void p7_mid(const Args& a, LAS unsigned char* lds, int tid, int G, int bid) {
    const int lane = tid & 63, wave = tid >> 6;
    const float* gpost = a.in[5]; const float* gpre = a.in[13];
    for (int blk = bid; blk < T / 64; blk += G) {
        const int row0 = blk * 64;
        __syncthreads();
        v2u ny[4]; f32x4 nxx[4];
        { const int t0 = row0 + wave * 8;
#pragma unroll
          for (int j = 0; j < 4; ++j) { ny[j] = __builtin_nontemporal_load((const GAS v2u*)(a.YB + (size_t)t0 * D) + lane + 64 * j); nxx[j] = __builtin_nontemporal_load((const GAS f32x4*)(a.in[0] + (size_t)t0 * D) + lane + 64 * j); } }
        for (int k = 0; k < 8; ++k) {
            const int rl = wave * 8 + k, t = row0 + rl;
            const int b = t / S;
            const float* ad = a.ada + b * 6 * D;
            f32x4 yv[4], xv[4]; float ss = 0.f;
#pragma unroll
            for (int j = 0; j < 4; ++j) { yv[j] = (f32x4){bflo(ny[j].x), bfhi(ny[j].x), bflo(ny[j].y), bfhi(ny[j].y)}; xv[j] = nxx[j]; }
            if (k + 1 < 8) {
#pragma unroll
                for (int j = 0; j < 4; ++j) { ny[j] = __builtin_nontemporal_load((const GAS v2u*)(a.YB + (size_t)(t + 1) * D) + lane + 64 * j); nxx[j] = __builtin_nontemporal_load((const GAS f32x4*)(a.in[0] + (size_t)(t + 1) * D) + lane + 64 * j); } }
#pragma unroll
            for (int j = 0; j < 4; ++j) ss += (yv[j].x * yv[j].x + yv[j].y * yv[j].y) + (yv[j].z * yv[j].z + yv[j].w * yv[j].w);
            const float rstd = rsqrtf(wave_sum(ss) * (1.f / D) + EPS);
            float s2 = 0.f;
#pragma unroll
            for (int j = 0; j < 4; ++j) { const int kk = 4 * lane + 256 * j;
                const f32x4 gp = *(const f32x4*)(gpost + kk), gt = *(const f32x4*)(ad + 2 * D + kk);
                xv[j].x += gt.x * (yv[j].x * rstd * gp.x); xv[j].y += gt.y * (yv[j].y * rstd * gp.y); xv[j].z += gt.z * (yv[j].z * rstd * gp.z); xv[j].w += gt.w * (yv[j].w * rstd * gp.w);
                s2 += (xv[j].x * xv[j].x + xv[j].y * xv[j].y) + (xv[j].z * xv[j].z + xv[j].w * xv[j].w);
                __builtin_nontemporal_store((v2u){cvtpk(xv[j].x, xv[j].y), cvtpk(xv[j].z, xv[j].w)}, (GAS v2u*)(a.X1B + (size_t)t * D) + lane + 64 * j); }
            const float rstd2 = rsqrtf(wave_sum(s2) * (1.f / D) + EPS);
            GAS v2u* h8 = (GAS v2u*)(a.H2 + (size_t)t * D) + lane;
#pragma unroll
            for (int j = 0; j < 4; ++j) { const int kk = 4 * lane + 256 * j;
                const f32x4 gp = *(const f32x4*)(gpre + kk), sc = *(const f32x4*)(ad + 4 * D + kk), sh = *(const f32x4*)(ad + 3 * D + kk);
                const float h0 = xv[j].x * rstd2 * gp.x * (1.f + sc.x) + sh.x, h1 = xv[j].y * rstd2 * gp.y * (1.f + sc.y) + sh.y;
                const float h2v = xv[j].z * rstd2 * gp.z * (1.f + sc.z) + sh.z, h3 = xv[j].w * rstd2 * gp.w * (1.f + sc.w) + sh.w;
                const v2u pk = (v2u){cvtpk(h0, h1), cvtpk(h2v, h3)};
                h8[64 * j] = pk;
                *(LAS v2u*)(lds + P7_HT + rl * 2048 + ((((kk >> 3) ^ (rl & 15)) << 4) | ((lane & 1) << 3))) = pk; }
        }
        __syncthreads();
        {
            const int tt = wave & 3, kh = wave >> 2, q = lane & 15, g = lane >> 4, rl = 16 * tt + q;
            const bf16* whi = a.WrT + (size_t)q * D + 8 * g; const bf16* wlo = whi + 48 * D;
            f32x4 acc[3];
#pragma unroll
            for (int ot = 0; ot < 3; ++ot) acc[ot] = (f32x4){0.f, 0.f, 0.f, 0.f};
#pragma unroll 1
            for (int ks4 = 0; ks4 < 4; ++ks4) {
                bf16x8 ah[4][3], al[4][3], bfr[4];
#pragma unroll
                for (int kk = 0; kk < 4; ++kk) { const int ks = kh * 16 + ks4 * 4 + kk;
#pragma unroll
                    for (int ot = 0; ot < 3; ++ot) { ah[kk][ot] = *(const bf16x8*)(whi + (size_t)(16 * ot) * D + 32 * ks); al[kk][ot] = *(const bf16x8*)(wlo + (size_t)(16 * ot) * D + 32 * ks); }
                    bfr[kk] = *(const LAS bf16x8*)(lds + P7_HT + rl * 2048 + (((ks * 4 + g) ^ (rl & 15)) << 4)); }
#pragma unroll
                for (int kk = 0; kk < 4; ++kk)
#pragma unroll
                    for (int ot = 0; ot < 3; ++ot) { acc[ot] = __builtin_amdgcn_mfma_f32_16x16x32_bf16(ah[kk][ot], bfr[kk], acc[ot], 0, 0, 0); acc[ot] = __builtin_amdgcn_mfma_f32_16x16x32_bf16(al[kk][ot], bfr[kk], acc[ot], 0, 0, 0); }
            }
            LAS float* lgp = (LAS float*)(lds + P7_LGP) + (kh * 64 + rl) * 48 + 4 * g;
#pragma unroll
            for (int ot = 0; ot < 3; ++ot) *(LAS f32x4*)(lgp + 16 * ot) = acc[ot];
        }
        LAS int* LC = (LAS int*)(lds + P7_LC);
        if (tid < 64) LC[tid] = 0;
        __syncthreads();
        int e1 = 0, e2 = 0, q1 = 0, q2 = 0; float w1 = 0.f, w2 = 0.f;
        if (tid < 64) {
            const LAS float* l0 = (const LAS float*)(lds + P7_LGP) + tid * 48; const LAS float* l1 = l0 + 64 * 48;
            float lg[36];
#pragma unroll
            for (int o = 0; o < 36; ++o) lg[o] = l0[o] + l1[o] + (o < 4 ? a.in[16][o] : a.in[18][o - 4]);
            int g = 0; float gm = lg[0];
#pragma unroll
            for (int j = 1; j < 4; ++j) if (lg[j] > gm) { gm = lg[j]; g = j; }
            float gs = 0.f;
#pragma unroll
            for (int j = 0; j < 4; ++j) gs += __expf(lg[j] - gm);
            const float gpv = 1.f / gs;
            float el[8];
#pragma unroll
            for (int j = 0; j < 8; ++j) el[j] = g == 0 ? lg[4 + j] : (g == 1 ? lg[12 + j] : (g == 2 ? lg[20 + j] : lg[28 + j]));
            int i1 = 0; float l1v = el[0];
#pragma unroll
            for (int j = 1; j < 8; ++j) if (el[j] > l1v) { l1v = el[j]; i1 = j; }
            int i2 = -1; float l2v = -1e30f;
#pragma unroll
            for (int j = 0; j < 8; ++j) if (j != i1 && el[j] > l2v) { l2v = el[j]; i2 = j; }
            const float p2 = __expf(l2v - l1v);
            w1 = gpv / (1.f + p2); w2 = gpv * p2 / (1.f + p2);
            e1 = g * 8 + i1; e2 = g * 8 + i2;
            q1 = atomicAdd((int*)&LC[e1], 1); q2 = atomicAdd((int*)&LC[e2], 1);
        }
        __syncthreads();
        if (tid < NE) { const int c = LC[tid]; LC[32 + tid] = c ? atomicAdd(&a.cnt[tid], c) : 0; }
        __syncthreads();
        if (tid < 64) {
            const int trow = row0 + tid;
            q1 += LC[32 + e1]; q2 += LC[32 + e2];
            a.tok_w[trow * 2] = w1; a.tok_w[trow * 2 + 1] = w2;
            a.perm[(size_t)e1 * 2 * T + q1] = 2 * trow; a.perm[(size_t)e2 * 2 * T + q2] = 2 * trow + 1;
        }
    }
}

__device__ __forceinline__ void p4_moe_weights(const Args& a, LAS float* scr, int widx, int nw, int lane) {
    for (int it = widx; it < 24576; it += nw) {
        if (it < 16384) { const int e = it >> 9, src = (it >> 8) & 1, kb = (it >> 4) & 15, nb = it & 15, n0 = nb * 32;
            transpose_item<true>((src ? a.in[20] : a.in[19]) + (size_t)e * D * DE, DE, n0, kb * 64, a.WguT + (size_t)e * 1024 * 1024, 1024, 256 * (n0 >> 7) + 128 * src + (n0 & 127), scr, lane);
        } else { const int r = it - 16384, e = r >> 8, kb = (r >> 5) & 7, nb = r & 31;
            transpose_item<true>(a.in[21] + (size_t)e * DE * D, D, nb * 32, kb * 64, a.WdT + (size_t)e * 1024 * 512, 512, nb * 32, scr, lane); }
    }
}

constexpr int MOE_TB_OFF = RING_BYTES, MOE_TOK_OFF = RING_BYTES + 2048;
struct MoeOrder {
    const LAS int* TB; int lo, hi, j, gs;
    __device__ __forceinline__ void init(const LAS int* tb, int G, int bid) { TB = tb; const int NU = tb[0] * 4, x = bid & 7; lo = (x * NU) >> 3; hi = ((x + 1) * NU) >> 3; j = bid >> 3; gs = G >> 3; }
    __device__ __forceinline__ bool next(int i, pg8::Unit& u) const { const int L = lo + i * gs + j; if (L >= hi) return false; const int rt = L >> 2; u.pm = rt; u.pn = TB[4 + rt] * 4 + (L & 3); return true; }
    __device__ __forceinline__ void a_ready(const pg8::Unit&) const {}
    __device__ __forceinline__ void done(const pg8::Unit&) const {}
};
__device__ __forceinline__ void moe_setup(const Args& a, LAS unsigned char* lds, int tid, int G, int bid, bool need_tok) {
    LAS int* TB = (LAS int*)(lds + MOE_TB_OFF); LAS int* TOK = (LAS int*)(lds + MOE_TOK_OFF);
    __syncthreads();
    if (tid < NE) { int start = 0; for (int q = 0; q < tid; ++q) start += (a.cnt[q] + 255) >> 8; const int n = (a.cnt[tid] + 255) >> 8;
        for (int i = 0; i < n; ++i) { TB[4 + start + i] = tid; TB[164 + start + i] = i; }
        if (tid == NE - 1) TB[0] = start + n; }
    __syncthreads();
    if (need_tok) {
        MoeOrder O; O.init(TB, G, bid);
        for (int ui = 0; ui < 8; ++ui) { pg8::Unit u; if (!O.next(ui, u)) break;
            if (tid < 256) { const int e = u.pn >> 2, idx = 256 * TB[164 + u.pm] + tid; int pr = -1; if (idx < a.cnt[e]) pr = a.perm[(size_t)e * 2 * T + idx];
                TOK[ui * 256 + tid] = pr < 0 ? 0 : (pr >> 1); } }
        __syncthreads();
    }
}
struct EpiSwiglu {
    static constexpr bool PERM = true, AFTER_DRAIN = false;
    bf16* HE;
    __device__ __forceinline__ void operator()(const pg8::f32x4 (&acc)[2][2][4][2], const pg8::Unit& u, int wr, int wc, int fr, int fq) const {
        const int row0 = u.pm * 256 + wr * 64 + fr, col0 = (u.pn & 3) * 128 + wc * 32 + 8 * fq;
#pragma unroll
        for (int ai = 0; ai < 2; ++ai)
#pragma unroll
            for (int m = 0; m < 4; ++m) { bf16* rowp = HE + (size_t)(row0 + ai * 128 + m * 16) * DE + col0;
                const pg8::f32x4 g0 = acc[ai][0][m][0], g1 = acc[ai][0][m][1], u0 = acc[ai][1][m][0], u1 = acc[ai][1][m][1];
                v4u w; w.x = cvtpk(silu_f(g0[0]) * u0[0], silu_f(g0[1]) * u0[1]); w.y = cvtpk(silu_f(g0[2]) * u0[2], silu_f(g0[3]) * u0[3]);
                w.z = cvtpk(silu_f(g1[0]) * u1[0], silu_f(g1[1]) * u1[1]); w.w = cvtpk(silu_f(g1[2]) * u1[2], silu_f(g1[3]) * u1[3]);
                *(v4u*)rowp = w; }
    }
};
struct EpiScatter {
    static constexpr bool PERM = true, AFTER_DRAIN = false;
    bf16* Y2S; const int* perm; const float* tokw; const int* cnt; const LAS int* TB;
    __device__ __forceinline__ void operator()(const pg8::f32x4 (&acc)[2][2][4][2], const pg8::Unit& u, int wr, int wc, int fr, int fq) const {
        const int e = u.pn >> 2, lt = TB[164 + u.pm], ce = cnt[e];
        const int col0 = (u.pn & 3) * 256 + wc * 32 + 8 * fq;
#pragma unroll
        for (int ai = 0; ai < 2; ++ai)
#pragma unroll
            for (int m = 0; m < 4; ++m) { const int idx = 256 * lt + ai * 128 + wr * 64 + m * 16 + fr;
                if (idx < ce) { const int pr = perm[(size_t)e * 2 * T + idx]; const float w = tokw[pr];
                    bf16* rowp = Y2S + ((size_t)(pr & 1) * T + (pr >> 1)) * D + col0;
#pragma unroll
                    for (int bj = 0; bj < 2; ++bj) { const pg8::f32x4 v0 = acc[ai][bj][m][0], v1 = acc[ai][bj][m][1];
                        *(v4u*)(rowp + bj * 128) = (v4u){cvtpk(w * v0[0], w * v0[1]), cvtpk(w * v0[2], w * v0[3]), cvtpk(w * v1[0], w * v1[1]), cvtpk(w * v1[2], w * v1[3])}; } } }
    }
};
__device__ __forceinline__ void p10_final(const Args& a, int tid, int G, int bid) {
    const int lane = tid & 63, wave = tid >> 6;
    const float* gpost = a.in[14];
    const int t00 = bid * NWAVES + wave, tstep = G * NWAVES;
    v2u na[4], nb[4], nx[4];
    if (t00 < T) {
#pragma unroll
        for (int j = 0; j < 4; ++j) { na[j] = __builtin_nontemporal_load((const GAS v2u*)(a.Y2S + (size_t)t00 * D) + lane + 64 * j); nb[j] = __builtin_nontemporal_load((const GAS v2u*)(a.Y2S + ((size_t)T + t00) * D) + lane + 64 * j); nx[j] = __builtin_nontemporal_load((const GAS v2u*)(a.X1B + (size_t)t00 * D) + lane + 64 * j); } }
    for (int t = t00; t < T; t += tstep) {
        const float* ad = a.ada + (t / S) * 6 * D + 5 * D;
        v2u pa[4], pb[4], xin[4];
#pragma unroll
        for (int j = 0; j < 4; ++j) { pa[j] = na[j]; pb[j] = nb[j]; xin[j] = nx[j]; }
        if (t + tstep < T) { const size_t tn = (size_t)t + tstep;
#pragma unroll
            for (int j = 0; j < 4; ++j) { na[j] = __builtin_nontemporal_load((const GAS v2u*)(a.Y2S + tn * D) + lane + 64 * j); nb[j] = __builtin_nontemporal_load((const GAS v2u*)(a.Y2S + ((size_t)T + tn) * D) + lane + 64 * j); nx[j] = __builtin_nontemporal_load((const GAS v2u*)(a.X1B + tn * D) + lane + 64 * j); } }
        f32x4 yv[4]; float ss = 0.f;
#pragma unroll
        for (int j = 0; j < 4; ++j) { const v2u p = pa[j], q = pb[j];
            yv[j].x = bflo(p.x) + bflo(q.x); yv[j].y = bfhi(p.x) + bfhi(q.x); yv[j].z = bflo(p.y) + bflo(q.y); yv[j].w = bfhi(p.y) + bfhi(q.y);
            ss += (yv[j].x * yv[j].x + yv[j].y * yv[j].y) + (yv[j].z * yv[j].z + yv[j].w * yv[j].w); }
        const float rstd = rsqrtf(wave_sum(ss) * (1.f / D) + EPS);
        GAS f32x4* xo = (GAS f32x4*)(a.out + (size_t)t * D) + lane;
#pragma unroll
        for (int j = 0; j < 4; ++j) { const int k = 4 * lane + 256 * j; const f32x4 gp = *(const f32x4*)(gpost + k), gt = *(const f32x4*)(ad + k); f32x4 x = (f32x4){bflo(xin[j].x), bfhi(xin[j].x), bflo(xin[j].y), bfhi(xin[j].y)};
            x.x += gt.x * (yv[j].x * rstd * gp.x); x.y += gt.y * (yv[j].y * rstd * gp.y); x.z += gt.z * (yv[j].z * rstd * gp.z); x.w += gt.w * (yv[j].w * rstd * gp.w);
            __builtin_nontemporal_store(x, xo + 64 * j); }
    }
}


namespace cg = cooperative_groups;
__global__ void __launch_bounds__(NTHR, 2) mega(Args args) {
    extern __shared__ __attribute__((aligned(16))) unsigned char lds_raw[];
    LAS unsigned char* lds = (LAS unsigned char*)lds_raw;
    const int tid = threadIdx.x, G = gridDim.x, bid = blockIdx.x;
    const int lo = args.ph_lo, hi = args.ph_hi;
    cg::grid_group grid = cg::this_grid();
#define IN(k) (lo <= (k) && (k) < hi)
    volatile LAS unsigned* bst = (volatile LAS unsigned*)(lds + LDS_BYTES - 16);
    if (tid == 0) { bst[0] = 0u; bst[1] = 0u; }
    __syncthreads();
    const XcdBarrier xb = xcd_barrier_post(args.bar, bst);
#ifndef CG_SEAM
#define CG_SEAM 99
#endif
#define SEAM(k) do { if (IN(k) && IN((k) + 1)) { if ((k) == CG_SEAM) grid.sync(); else xcd_barrier(xb); } } while (0)
    if (IN(0)) { p0_prologue(args, lds, tid, G, bid); }
    SEAM(0);
    if (IN(1)) { p1_rows(args, tid, G, bid); }
    SEAM(1);
    if (IN(2)) {
        pg8::Gemm g{args.H, args.WinT, T, NIN, D}; pg8::StaticOrder So; So.init(T, NIN, G, bid);
        EpiG1 E{args.QKV, args.Z, args.NAQ, args.NAK, args.NAVT, args.GATES};
        pg8::gemm_phase<EpiG1, pg8::StaticOrder, true, true>(lds, g, So, E);
    }
    SEAM(2);
    if (IN(3)) { p3_dnprep2(args, lds, tid, G, bid); __syncthreads(); p3_na(args, lds, tid, G, bid); }
    SEAM(3);
    if (IN(4)) {
        if ((tid >> 6) == 0) { for (int id = bid; id < 256; id += G) p4_scan_wave(args, lds, id, tid & 63); }
        else p4_moe_weights(args, (LAS float*)(lds + (tid >> 6) * 8704), bid * 7 + (tid >> 6) - 1, G * 7, tid & 63);
    }
    SEAM(4);
    if (IN(5)) { p4b_dnout(args, tid, G, bid); }
    SEAM(5);
    if (IN(6)) {
        pg8::Gemm g{args.MIX, args.WoutT, T, D, D}; pg8::StaticOrder So; So.init(T, D, G, bid);
        EpiY E{args.YB, D};
        pg8::gemm_phase<EpiY, pg8::StaticOrder, true, true>(lds, g, So, E);
    }
    SEAM(6);
    if (IN(7)) { p7_mid(args, lds, tid, G, bid); }
    SEAM(7);
    if (IN(8)) {
        moe_setup(args, lds, tid, G, bid, true);
        pg8::Gemm g{args.H2, args.WguT, 0, 0, D}; MoeOrder Mo; Mo.init((const LAS int*)(lds + MOE_TB_OFF), G, bid);
        EpiSwiglu E{args.HE};
        pg8::gemm_phase_gather<EpiSwiglu, MoeOrder, true>(lds, g, (const LAS int*)(lds + MOE_TOK_OFF), Mo, E);
    }
    SEAM(8);
    if (IN(9)) {
        moe_setup(args, lds, tid, G, bid, false);
        pg8::Gemm g{args.HE, args.WdT, 0, 0, DE}; MoeOrder Mo; Mo.init((const LAS int*)(lds + MOE_TB_OFF), G, bid);
        EpiScatter E{args.Y2S, args.perm, args.tok_w, args.cnt, (const LAS int*)(lds + MOE_TB_OFF)};
        pg8::gemm_phase<EpiScatter, MoeOrder, true, true>(lds, g, Mo, E);
    }
    SEAM(9);
    if (IN(10)) { p10_final(args, tid, G, bid); }
#undef IN
#undef SEAM
}


static void fill_args(Args& a, void* const* d_in, void* d_out, void* d_ws) {
    const size_t MiB = 1u << 20; unsigned char* ws = (unsigned char*)d_ws;
    for (int i = 0; i < 22; ++i) a.in[i] = (const float*)d_in[i];
    a.out = (float*)d_out; a.ws = ws;
    a.bar = (unsigned*)(ws + 4096); a.cnt = (int*)ws;
    a.ada = (float*)(ws + 1 * MiB); a.tok_w = (float*)(ws + 1 * MiB + 256 * 1024); a.tok_e = (int*)(ws + 1 * MiB + 384 * 1024); a.tok_pos = (int*)(ws + 1 * MiB + 512 * 1024);
    a.WinT = (bf16*)(ws + 2 * MiB); a.WoutT = (bf16*)(ws + 10 * MiB); a.WrT = (bf16*)(ws + 1 * MiB + 640 * 1024);
    a.H = (bf16*)(ws + 12 * MiB); a.PREP = (bf16*)(ws + 12 * MiB); a.HE = (bf16*)(ws + 12 * MiB); a.Y2S = (bf16*)(ws + 52 * MiB);
    a.QKV = (bf16*)(ws + 140 * MiB); a.NAQ = (bf16*)(ws + 188 * MiB); a.NAK = (bf16*)(ws + 204 * MiB); a.NAVT = (bf16*)(ws + 220 * MiB);
    a.WguT = (bf16*)(ws + 140 * MiB); a.WdT = (bf16*)(ws + 204 * MiB);
    a.Z = (bf16*)(ws + 236 * MiB); a.GATES = (float*)(ws + 252 * MiB); a.MIX = (bf16*)(ws + 254 * MiB); a.H2 = (bf16*)(ws + 236 * MiB);
    a.perm = (int*)(ws + 286 * MiB);
    a.Y = (float*)d_out; a.YB = (bf16*)(ws + 12 * MiB); a.X1B = (bf16*)(ws + 236 * MiB); a.H2 = (bf16*)d_out;
}
extern "C" void kernel_launch(void* const* d_in, const int* in_sizes, int n_in, void* d_out, int out_size, void* d_ws, size_t ws_size, hipStream_t stream) {
    const size_t MiB = 1u << 20;
    if (ws_size < (size_t)290 * MiB) { fprintf(stderr, "kernel_launch: workspace too small: %zu\n", ws_size); return; }
    static int attr_done = 0;
    if (!attr_done) { (void)hipFuncSetAttribute((const void*)mega, hipFuncAttributeMaxDynamicSharedMemorySize, LDS_BYTES); attr_done = 1; }
    (void)hipMemsetAsync(d_ws, 0, 1 * MiB, stream);
    Args a{};
    fill_args(a, d_in, d_out, d_ws);
    a.ph_lo = 0; a.ph_hi = 11;
    static int grid_blocks = 0;
    if (!grid_blocks) { int dev = 0, cus = 0, per_cu = 0; (void)hipGetDevice(&dev); (void)hipDeviceGetAttribute(&cus, hipDeviceAttributeMultiprocessorCount, dev);
        (void)hipOccupancyMaxActiveBlocksPerMultiprocessor(&per_cu, (const void*)mega, NTHR, LDS_BYTES);
        if (per_cu < 1) { fprintf(stderr, "kernel_launch: occupancy query says %d blocks per CU\n", per_cu); per_cu = 1; }
        if (per_cu > 1) per_cu = 1;
        grid_blocks = cus * per_cu; if (grid_blocks % 8) grid_blocks -= grid_blocks % 8; }
    void* kargs[] = {&a};
    hipError_t e = hipLaunchCooperativeKernel((const void*)mega, dim3(grid_blocks), dim3(NTHR), kargs, LDS_BYTES, stream);
    if (e != hipSuccess) fprintf(stderr, "kernel_launch: cooperative launch failed: %s (grid %d)\n", hipGetErrorString(e), grid_blocks);
}
```
